# Optimizing an MI355X kernel written in HIP

```python
import math
import functools
import jax
import jax.numpy as jnp
from jax import lax
import numpy as np

D_MODEL = 2048
BATCH = 8
SEQ = 2048
DEPTH = 4

CHUNK = 64
N_MIXERS = 3
EPS = 1e-6

HG_F_DIM = 128
HG_HEADS = D_MODEL // HG_F_DIM
HG_I_DIM = D_MODEL // HG_HEADS
HG_FORGET = HG_HEADS * HG_F_DIM
HG_WIDTH = HG_HEADS * HG_I_DIM
HG_IN = 2 * HG_FORGET + 2 * HG_WIDTH

MLA_NOPE = 128
MLA_ROPE = 64
MLA_V = 128
MLA_QK = MLA_NOPE + MLA_ROPE
MLA_HEADS = D_MODEL // MLA_V
MLA_Q_RANK = D_MODEL // 4
MLA_KV_RANK = D_MODEL // 4
MLA_WIDTH = MLA_HEADS * MLA_V
MLA_IN = MLA_Q_RANK + MLA_KV_RANK + MLA_ROPE + MLA_WIDTH
ROPE_THETA = 10000.0
Q_BLOCK = 128

GDN_DK = 128
GDN_DV = 128
GDN_QK_HEADS = D_MODEL // GDN_DK
GDN_V_HEADS = 2 * GDN_QK_HEADS
GDN_KEY_WIDTH = GDN_QK_HEADS * GDN_DK
GDN_WIDTH = GDN_V_HEADS * GDN_DV
GDN_CONV_CH = 2 * GDN_KEY_WIDTH + GDN_WIDTH
GDN_IN = GDN_CONV_CH + GDN_WIDTH + 2 * GDN_V_HEADS
CONV_WIDTH = 4

kernel_name = 'hybrid_hgrn2_mla_gdn_sandwich_trunk'


def rms_norm(x, w):
    xf = x.astype(jnp.float32)
    y = xf * lax.rsqrt(jnp.mean(xf * xf, axis=-1, keepdims=True) + EPS)
    return (y * w.astype(jnp.float32)).astype(x.dtype)


def to_chunks(t):
    b, s, h, d = t.shape
    return t.reshape(b, s // CHUNK, CHUNK, h, d).transpose(1, 0, 3, 2, 4)


def from_chunks(t):
    nc, b, h, c, d = t.shape
    return t.transpose(1, 0, 3, 2, 4).reshape(b, nc * c, h, d)


def hgrn_lower_bounds(lb_param):
    p = jax.nn.softmax(lb_param.astype(jnp.float32), axis=0)
    c = lax.cumsum(p, axis=0)
    return c - c[0:1]


def gla_chunked(q, k, v, log_f):
    f32 = jnp.float32
    qc, kc, vc, gc = (to_chunks(t.astype(f32)) for t in (q, k, v, log_f))
    bcum = lax.cumsum(gc, axis=3)
    tri = jnp.tril(jnp.ones((CHUNK, CHUNK), dtype=bool))

    def step(state, inp):
        qi, ki, vi, bi = inp
        rel = jnp.where(tri[:, :, None], bi[:, :, :, None, :] - bi[:, :, None, :, :], -jnp.inf)
        scores = jnp.einsum('bhtk,bhsk,bhtsk->bhts', qi, ki, jnp.exp(rel))
        b_last = bi[:, :, -1, :]
        out = (jnp.einsum('bhts,bhsv->bhtv', scores, vi)
               + jnp.einsum('bhtk,bhkv->bhtv', qi * jnp.exp(bi), state))
        new_state = (state * jnp.exp(b_last)[..., None]
                     + jnp.einsum('bhsk,bhsv->bhkv', ki * jnp.exp(b_last[:, :, None, :] - bi), vi))
        return new_state, out

    b, h = q.shape[0], q.shape[2]
    state0 = jnp.zeros((b, h, q.shape[-1], v.shape[-1]), f32)
    _, out = lax.scan(step, state0, (qc, kc, vc, bcum))
    return from_chunks(out)


def gated_delta_chunked(q, k, v, g, beta):
    f32 = jnp.float32
    qc, kc, vc = (to_chunks(t.astype(f32)) for t in (q, k, v))
    gc = to_chunks(g.astype(f32)[..., None])[..., 0]
    bc = to_chunks(beta.astype(f32)[..., None])[..., 0]
    gcum = lax.cumsum(gc, axis=3)
    tri = jnp.tril(jnp.ones((CHUNK, CHUNK), dtype=bool))
    strict = jnp.tril(jnp.ones((CHUNK, CHUNK), dtype=bool), k=-1)
    decay = jnp.exp(jnp.where(tri, gcum[..., :, None] - gcum[..., None, :], -jnp.inf))
    k_beta = kc * bc[..., None]
    lower = jnp.where(strict, jnp.einsum('nbhtk,nbhsk->nbhts', k_beta, kc) * decay, 0.0)
    a_mat = lower + jnp.eye(CHUNK, dtype=f32)
    solve = functools.partial(lax.linalg.triangular_solve, left_side=True, lower=True,
                              unit_diagonal=True)
    u = solve(a_mat, vc * bc[..., None])
    w = solve(a_mat, k_beta * jnp.exp(gcum)[..., None])

    def step(state, inp):
        qi, ki, ui, wi, gi, di = inp
        v_new = ui - jnp.einsum('bhtk,bhkv->bhtv', wi, state)
        attn = jnp.einsum('bhtk,bhsk->bhts', qi, ki) * di
        out = (jnp.einsum('bhtk,bhkv->bhtv', qi * jnp.exp(gi)[..., None], state)
               + jnp.einsum('bhts,bhsv->bhtv', attn, v_new))
        g_last = gi[:, :, -1]
        new_state = (state * jnp.exp(g_last)[..., None, None]
                     + jnp.einsum('bhsk,bhsv->bhkv',
                                  ki * jnp.exp(g_last[..., None] - gi)[..., None], v_new))
        return new_state, out

    b, h = q.shape[0], q.shape[2]
    state0 = jnp.zeros((b, h, q.shape[-1], v.shape[-1]), f32)
    _, out = lax.scan(step, state0, (qc, kc, u, w, gcum, decay))
    return from_chunks(out)


def apply_rope(t, cos, sin):
    half = t.shape[-1] // 2
    t1, t2 = t[..., :half], t[..., half:]
    return jnp.concatenate([t1 * cos - t2 * sin, t2 * cos + t1 * sin], axis=-1)


def causal_conv(x, w):
    s = x.shape[1]
    xp = jnp.pad(x, ((0, 0), (CONV_WIDTH - 1, 0), (0, 0)))
    y = xp[:, 0:s] * w[0]
    for j in range(1, CONV_WIDTH):
        y = y + xp[:, j:j + s] * w[j]
    return y


def hgrn2_mixer(u, w_in, head_norm, w_out, lower_bound):
    b, s, _ = u.shape
    proj = u @ w_in
    q, f, i, z = jnp.split(proj, [HG_FORGET, 2 * HG_FORGET, 2 * HG_FORGET + HG_WIDTH], axis=-1)
    f = f.astype(jnp.float32)
    lb = lower_bound.astype(jnp.float32)
    log_forget = jnp.logaddexp(jnp.log(lb), jnp.log1p(-lb) + jax.nn.log_sigmoid(f))
    k = (1.0 - lb) * jax.nn.sigmoid(-f)
    q = jax.nn.silu(q).reshape(b, s, HG_HEADS, HG_F_DIM) * HG_F_DIM ** -0.5
    o = gla_chunked(q, k.reshape(b, s, HG_HEADS, HG_F_DIM),
                    i.reshape(b, s, HG_HEADS, HG_I_DIM),
                    log_forget.reshape(b, s, HG_HEADS, HG_F_DIM))
    o = rms_norm(o, head_norm).astype(u.dtype).reshape(b, s, HG_WIDTH)
    return (o * jax.nn.silu(z)) @ w_out


def mla_mixer(u, positions, w_in, q_norm, kv_norm, w_uq, w_ukv, w_out):
    b, s, _ = u.shape
    proj = u @ w_in
    c_q, c_kv, k_rope, z = jnp.split(
        proj, [MLA_Q_RANK, MLA_Q_RANK + MLA_KV_RANK, MLA_Q_RANK + MLA_KV_RANK + MLA_ROPE], axis=-1)
    q = (rms_norm(c_q, q_norm) @ w_uq).reshape(b, s, MLA_HEADS, MLA_QK)
    kv = (rms_norm(c_kv, kv_norm) @ w_ukv).reshape(b, s, MLA_HEADS, MLA_NOPE + MLA_V)
    q_nope, q_rope = q[..., :MLA_NOPE], q[..., MLA_NOPE:]
    k_nope, v = kv[..., :MLA_NOPE], kv[..., MLA_NOPE:]
    inv_freq = ROPE_THETA ** (-jnp.arange(0, MLA_ROPE, 2, dtype=jnp.float32) / MLA_ROPE)
    ang = positions.astype(jnp.float32)[..., None] * inv_freq
    cos, sin = jnp.cos(ang), jnp.sin(ang)
    q_rope = apply_rope(q_rope, cos[:, :, None, :], sin[:, :, None, :])
    k_rope = apply_rope(k_rope, cos, sin)
    scale = MLA_QK ** -0.5
    n_blocks = s // Q_BLOCK
    key_chunk = jnp.arange(s) // CHUNK

    def blocks(t):
        return t.reshape(b, n_blocks, Q_BLOCK, MLA_HEADS, t.shape[-1]).transpose(1, 0, 2, 3, 4)

    def attend(args):
        blk, qn, qr = args
        scores = (jnp.einsum('bqhd,bkhd->bhqk', qn, k_nope)
                  + jnp.einsum('bqhr,bkr->bhqk', qr, k_rope)) * scale
        q_chunk = (blk * Q_BLOCK + jnp.arange(Q_BLOCK)) // CHUNK
        mask = key_chunk[None, :] <= q_chunk[:, None]
        scores = jnp.where(mask, scores.astype(jnp.float32), -jnp.inf)
        p = jax.nn.softmax(scores, axis=-1).astype(v.dtype)
        return jnp.einsum('bhqk,bkhd->bqhd', p, v)

    out = lax.map(attend, (jnp.arange(n_blocks), blocks(q_nope), blocks(q_rope)))
    o = out.transpose(1, 0, 2, 3, 4).reshape(b, s, MLA_WIDTH)
    return (o * jax.nn.silu(z)) @ w_out


def gdn_mixer(u, w_in, conv_w, a_log, dt_bias, head_norm, w_out):
    b, s, _ = u.shape
    proj = u @ w_in
    qkv, z, a, beta_logit = jnp.split(
        proj, [GDN_CONV_CH, GDN_CONV_CH + GDN_WIDTH, GDN_CONV_CH + GDN_WIDTH + GDN_V_HEADS], axis=-1)
    qkv = jax.nn.silu(causal_conv(qkv, conv_w))
    q, k, v = jnp.split(qkv, [GDN_KEY_WIDTH, 2 * GDN_KEY_WIDTH], axis=-1)
    rep = GDN_V_HEADS // GDN_QK_HEADS

    def l2n(t):
        tf = t.astype(jnp.float32).reshape(b, s, GDN_QK_HEADS, GDN_DK)
        tf = tf * lax.rsqrt(jnp.sum(tf * tf, axis=-1, keepdims=True) + EPS)
        return jnp.repeat(tf, rep, axis=2)

    q = l2n(q) * GDN_DK ** -0.5
    k = l2n(k)
    v = v.reshape(b, s, GDN_V_HEADS, GDN_DV)
    beta = jax.nn.sigmoid(beta_logit.astype(jnp.float32))
    g = -jnp.exp(a_log.astype(jnp.float32)) * jax.nn.softplus(
        a.astype(jnp.float32) + dt_bias.astype(jnp.float32))
    o = gated_delta_chunked(q, k, v, g, beta)
    o = rms_norm(o, head_norm).astype(u.dtype)
    o = o * jax.nn.silu(z.reshape(b, s, GDN_V_HEADS, GDN_DV))
    return o.reshape(b, s, GDN_WIDTH) @ w_out


def setup_inputs(seed: int = 0) -> dict:
    key = jax.random.key(seed)
    keys = iter(jax.random.split(key, 64))

    def nrm(shape, scale):
        return jax.random.normal(next(keys), shape, jnp.float32) * scale

    def gain(n):
        return 1.0 + nrm((n,), 0.02)

    inp = {}
    inp['x'] = nrm((BATCH, SEQ, D_MODEL), 1.0)
    offset = jax.random.randint(next(keys), (BATCH, 1), 0, 4096, dtype=jnp.int32)
    inp['positions'] = offset + jnp.arange(SEQ, dtype=jnp.int32)[None, :]
    inp['hgrn_lb'] = nrm((DEPTH, HG_FORGET), 0.1)
    for i in range(DEPTH):
        kind = i % N_MIXERS
        p = 'l%d_' % i
        inp[p + 'pre_norm'] = gain(D_MODEL)
        inp[p + 'post_norm'] = gain(D_MODEL)
        if kind == 0:
            inp[p + 'w_in'] = nrm((D_MODEL, HG_IN), D_MODEL ** -0.5)
            inp[p + 'head_norm'] = gain(HG_I_DIM)
            inp[p + 'w_out'] = nrm((HG_WIDTH, D_MODEL), HG_WIDTH ** -0.5)
        elif kind == 1:
            inp[p + 'w_in'] = nrm((D_MODEL, MLA_IN), D_MODEL ** -0.5)
            inp[p + 'q_norm'] = gain(MLA_Q_RANK)
            inp[p + 'kv_norm'] = gain(MLA_KV_RANK)
            inp[p + 'w_uq'] = nrm((MLA_Q_RANK, MLA_HEADS * MLA_QK), MLA_Q_RANK ** -0.5)
            inp[p + 'w_ukv'] = nrm((MLA_KV_RANK, MLA_HEADS * (MLA_NOPE + MLA_V)), MLA_KV_RANK ** -0.5)
            inp[p + 'w_out'] = nrm((MLA_WIDTH, D_MODEL), MLA_WIDTH ** -0.5)
        else:
            inp[p + 'w_in'] = nrm((D_MODEL, GDN_IN), D_MODEL ** -0.5)
            inp[p + 'conv_w'] = nrm((CONV_WIDTH, GDN_CONV_CH), CONV_WIDTH ** -0.5)
            inp[p + 'a_log'] = jnp.log(jax.random.uniform(next(keys), (GDN_V_HEADS,), jnp.float32, 1.0, 16.0))
            dt = jnp.exp(jax.random.uniform(next(keys), (GDN_V_HEADS,), jnp.float32,
                                            math.log(1e-3), math.log(1e-1)))
            inp[p + 'dt_bias'] = dt + jnp.log(-jnp.expm1(-dt))
            inp[p + 'head_norm'] = gain(GDN_DV)
            inp[p + 'w_out'] = nrm((GDN_WIDTH, D_MODEL), GDN_WIDTH ** -0.5)
    return inp


def reference(x, positions, hgrn_lb,
              l0_pre_norm, l0_post_norm, l0_w_in, l0_head_norm, l0_w_out,
              l1_pre_norm, l1_post_norm, l1_w_in, l1_q_norm, l1_kv_norm, l1_w_uq, l1_w_ukv, l1_w_out,
              l2_pre_norm, l2_post_norm, l2_w_in, l2_conv_w, l2_a_log, l2_dt_bias, l2_head_norm, l2_w_out,
              l3_pre_norm, l3_post_norm, l3_w_in, l3_head_norm, l3_w_out):
    lower_bounds = hgrn_lower_bounds(hgrn_lb)
    layers = [
        (l0_pre_norm, l0_post_norm, (l0_w_in, l0_head_norm, l0_w_out)),
        (l1_pre_norm, l1_post_norm, (l1_w_in, l1_q_norm, l1_kv_norm, l1_w_uq, l1_w_ukv, l1_w_out)),
        (l2_pre_norm, l2_post_norm, (l2_w_in, l2_conv_w, l2_a_log, l2_dt_bias, l2_head_norm, l2_w_out)),
        (l3_pre_norm, l3_post_norm, (l3_w_in, l3_head_norm, l3_w_out)),
    ]
    h = x
    for i in range(DEPTH):
        pre, post, params = layers[i]
        u = rms_norm(h, pre)
        kind = i % N_MIXERS
        if kind == 0:
            y = hgrn2_mixer(u, *params, lower_bound=lower_bounds[i])
        elif kind == 1:
            y = mla_mixer(u, positions, *params)
        else:
            y = gdn_mixer(u, *params)
        h = h + rms_norm(y, post)
    return h
```

```cpp
#include <hip/hip_runtime.h>
#include <hip/hip_cooperative_groups.h>
#include <cstdio>
namespace cg = cooperative_groups;
namespace pg8 {
#define PG8_LAS __attribute__((address_space(3)))
typedef unsigned short bf16_t;
typedef short bf16x8 __attribute__((ext_vector_type(8)));
typedef float f32x4 __attribute__((ext_vector_type(4)));
typedef unsigned u32x4 __attribute__((ext_vector_type(4)));
constexpr int BM = 256, BK = 64, HALF = 128, HTB = HALF * BK * 2  , STAGE_BYTES = 8 * HTB, NXCD = 8, WGM = 8;

__host__ __device__ __forceinline__ int lds_byte(int r, int c) { const int st = (r >> 4) * 2 + (c >> 5), rr = r & 15, cc = c & 31, ob = rr * 64 + cc * 2; return st * 1024 + (ob ^ (((ob >> 9) & 1) << 5)); }
__host__ __device__ __forceinline__ void stage_rc(int b, int& R, int& C) { const int st = b / 1024, sb = b % 1024, swz = sb ^ (((sb >> 9) & 1) << 5); R = (st >> 1) * 16 + swz / 64; C = (st & 1) * 32 + (swz % 64) / 2; }
__host__ __device__ __forceinline__ int perm32(int rho) { const int n = rho >> 4, i = rho & 15; return 8 * (i >> 2) + 4 * n + (i & 3); }

struct Unit { int pm, pn; };
struct Gemm { const bf16_t* A; const bf16_t* Bt; int M, N, K; };
struct StaticOrder {
    int nM, nN, nwg, G, c;
    __host__ __device__ void init(int M, int N, int G_, int c_) { nM = M / BM; nN = N / BM; nwg = nM * nN; G = G_; c = c_; }
    __host__ __device__ bool next(int i, Unit& u) const {
        const long L = (long)i * G + c; if (L >= nwg) return false;
        int wgid = (int)L; { const int q = nwg / NXCD, r = nwg % NXCD, xcd = wgid % NXCD, off = wgid / NXCD; wgid = (xcd < r ? xcd * (q + 1) : r * (q + 1) + (xcd - r) * q) + off; }
        const int nig = WGM * nN, gid = wgid / nig, fm = gid * WGM, gsz = (nM - fm) < WGM ? (nM - fm) : WGM;
        u.pm = fm + ((wgid % nig) % gsz); u.pn = (wgid % nig) / gsz; return true;
    }
    __device__ __forceinline__ void a_ready(const Unit&) const {}
    __device__ __forceinline__ void done(const Unit&) const {}
};
__device__ __forceinline__ unsigned cvt_pk_bf16(float lo, float hi) { unsigned r; asm volatile("v_cvt_pk_bf16_f32 %0, %1, %2" : "=v"(r) : "v"(lo), "v"(hi)); return r; }
template <class Epi, class Sched>
__device__ __forceinline__ void gemm_phase(PG8_LAS unsigned char* lds, const Gemm g, const Sched& S, const Epi& E) {
    const int tid = threadIdx.x, wid = __builtin_amdgcn_readfirstlane(tid >> 6), lane = tid & 63, wr = wid >> 2, wc = wid & 3, fr = lane & 15, fq = lane >> 4;
    const int K = g.K, nt = K / BK;
    unsigned voffA[2], voffB[2];
#pragma unroll
    for (int i = 0; i < 2; ++i) { int R, C; stage_rc(tid * 16 + i * 8192, R, C); const int Rb = Epi::PERM ? ((R & ~31) + perm32(R & 31)) : R;
        voffA[i] = (unsigned)(R * K + C) * 2u; voffB[i] = (unsigned)(Rb * K + C) * 2u; }
    const size_t kstep = (size_t)(BK * 2);
    const size_t hstep = (size_t)HALF * K * 2;
    const size_t tstep = 2 * hstep;
    const unsigned ldsw = (unsigned)wid * 1024u;
    const int aoff = lds_byte(wr * 64 + fr, fq * 8), boff = lds_byte(wc * 32 + fr, fq * 8);
#define PG8_SA(b, h) (((b) * 2 + (h)) * HTB)
#define PG8_SB(b, h) ((4 + (b) * 2 + (h)) * HTB)
#define PG8_STAGE(bufoff, gbase, voff) do { _Pragma("unroll") for (int _i = 0; _i < 2; ++_i) \
        __builtin_amdgcn_global_load_lds((const unsigned*)((const char*)(gbase) + (voff)[_i]), (PG8_LAS unsigned*)(lds + (bufoff) + ldsw + _i * 8192), 16, 0, 0); } while (0)
#define PG8_LDA(dst, b, h) do { _Pragma("unroll") for (int m = 0; m < 4; ++m) _Pragma("unroll") for (int k = 0; k < 2; ++k) dst[m][k] = *(const PG8_LAS bf16x8*)(lds + PG8_SA(b, h) + aoff + m * 2048 + k * 1024); } while (0)
#define PG8_LDB(dst, b, h) do { _Pragma("unroll") for (int n = 0; n < 2; ++n) _Pragma("unroll") for (int k = 0; k < 2; ++k) dst[n][k] = *(const PG8_LAS bf16x8*)(lds + PG8_SB(b, h) + boff + n * 2048 + k * 1024); } while (0)
#define PG8_MMA(ai, bj, At, Bt) do { __builtin_amdgcn_s_setprio(1); _Pragma("unroll") for (int m = 0; m < 4; ++m) _Pragma("unroll") for (int n = 0; n < 2; ++n) _Pragma("unroll") for (int k = 0; k < 2; ++k) \
        acc[ai][bj][m][n] = __builtin_amdgcn_mfma_f32_16x16x32_bf16(Bt[n][k], At[m][k], acc[ai][bj][m][n], 0, 0, 0); __builtin_amdgcn_s_setprio(0); } while (0)
#define PG8_WAIT_V(n) asm volatile("s_waitcnt vmcnt(" #n ")" ::: "memory")
#define PG8_WAIT_L(n) asm volatile("s_waitcnt lgkmcnt(" #n ")" ::: "memory")
#define PG8_BAR __builtin_amdgcn_s_barrier()
#define PG8_SCHED __builtin_amdgcn_sched_barrier(0)
    Unit cur, nxt; int ui = 0;
    if (!S.next(0, cur)) return;
    f32x4 acc[2][2][4][2];
#pragma unroll
    for (int a = 0; a < 2; ++a)
#pragma unroll
        for (int b = 0; b < 2; ++b)
#pragma unroll
            for (int m = 0; m < 4; ++m)
#pragma unroll
                for (int n = 0; n < 2; ++n) acc[a][b][m][n] = (f32x4){0.f, 0.f, 0.f, 0.f};
    bf16x8 At[4][2], B0[2][2], B1[2][2];
    const char* cA = (const char*)g.A + (size_t)cur.pm * tstep; const char* cB = (const char*)g.Bt + (size_t)cur.pn * tstep;
    S.a_ready(cur);
    PG8_STAGE(PG8_SB(0, 0), cB, voffB); PG8_STAGE(PG8_SA(0, 0), cA, voffA); PG8_STAGE(PG8_SB(0, 1), cB + hstep, voffB); PG8_STAGE(PG8_SA(0, 1), cA + hstep, voffA);
    if (wr == 1) PG8_BAR;
    PG8_WAIT_V(4); PG8_BAR;
    PG8_STAGE(PG8_SB(1, 0), cB + kstep, voffB); PG8_STAGE(PG8_SA(1, 0), cA + kstep, voffA); PG8_STAGE(PG8_SB(1, 1), cB + hstep + kstep, voffB);
    PG8_WAIT_V(6); PG8_BAR;
    for (;;) {
        const bool has_next = S.next(ui + 1, nxt);
        const char* nA = has_next ? (const char*)g.A + (size_t)nxt.pm * tstep : cA; const char* nB = has_next ? (const char*)g.Bt + (size_t)nxt.pn * tstep : cB;
        for (int t = 0; t < nt; t += 2) {
            const bool last = (t == nt - 2);
            const char* a1 = cA + (size_t)(t + 1) * kstep;
            const char* a2 = last ? nA : cA + (size_t)(t + 2) * kstep; const char* b2 = last ? nB : cB + (size_t)(t + 2) * kstep;
            const char* a3 = a2 + kstep; const char* b3 = b2 + kstep;
            if (last && has_next) S.a_ready(nxt);
            PG8_LDB(B0, 0, 0); PG8_SCHED; PG8_LDA(At, 0, 0); PG8_STAGE(PG8_SA(1, 1), a1 + hstep, voffA);
            PG8_WAIT_L(8); PG8_BAR; PG8_WAIT_L(0); PG8_MMA(0, 0, At, B0); PG8_BAR; PG8_SCHED;
            PG8_LDB(B1, 0, 1); PG8_STAGE(PG8_SB(0, 0), b2, voffB);
            PG8_BAR; PG8_WAIT_L(0); PG8_MMA(0, 1, At, B1); PG8_BAR;
            PG8_LDA(At, 0, 1); PG8_STAGE(PG8_SA(0, 0), a2, voffA);
            PG8_BAR; PG8_WAIT_L(0); PG8_MMA(1, 0, At, B0); PG8_BAR; PG8_SCHED;
            PG8_STAGE(PG8_SB(0, 1), b2 + hstep, voffB);
            PG8_WAIT_V(6); PG8_BAR; PG8_MMA(1, 1, At, B1); PG8_BAR;
            PG8_LDB(B0, 1, 0); PG8_SCHED; PG8_LDA(At, 1, 0); PG8_STAGE(PG8_SA(0, 1), a2 + hstep, voffA);
            PG8_WAIT_L(8); PG8_BAR; PG8_WAIT_L(0); PG8_MMA(0, 0, At, B0); PG8_BAR; PG8_SCHED;
            PG8_LDB(B1, 1, 1); PG8_STAGE(PG8_SB(1, 0), b3, voffB);
            PG8_BAR; PG8_WAIT_L(0); PG8_MMA(0, 1, At, B1); PG8_BAR;
            PG8_LDA(At, 1, 1); PG8_STAGE(PG8_SA(1, 0), a3, voffA);
            PG8_BAR; PG8_WAIT_L(0); PG8_MMA(1, 0, At, B0); PG8_BAR; PG8_SCHED;
            PG8_STAGE(PG8_SB(1, 1), b3 + hstep, voffB);
            PG8_WAIT_V(6); PG8_BAR; PG8_MMA(1, 1, At, B1); PG8_BAR;
        }
        if constexpr (!Epi::AFTER_DRAIN) { E(acc, cur, wr, wc, fr, fq); S.done(cur); }
        if (!has_next) break;
#pragma unroll
        for (int a = 0; a < 2; ++a)
#pragma unroll
            for (int b = 0; b < 2; ++b)
#pragma unroll
                for (int m = 0; m < 4; ++m)
#pragma unroll
                    for (int n = 0; n < 2; ++n) acc[a][b][m][n] = (f32x4){0.f, 0.f, 0.f, 0.f};
        cur = nxt; cA = nA; cB = nB; ++ui;
    }
    PG8_WAIT_V(0);
    if (wr == 0) PG8_BAR;
    PG8_BAR;
    if constexpr (Epi::AFTER_DRAIN) { E.fused(acc, cur, wr, wc, fr, fq, lds, wid, lane); S.done(cur); }
#undef PG8_SA
#undef PG8_SB
#undef PG8_STAGE
#undef PG8_LDA
#undef PG8_LDB
#undef PG8_MMA
#undef PG8_WAIT_V
#undef PG8_WAIT_L
#undef PG8_BAR
#undef PG8_SCHED
}
}

#ifndef PER_PHASE_LAUNCH
#define PER_PHASE_LAUNCH 0
#endif

#define LAS __attribute__((address_space(3)))
typedef unsigned short bf16_t;
typedef short bf16x8 __attribute__((ext_vector_type(8)));
typedef short s16x4 __attribute__((ext_vector_type(4)));
typedef float f32x4 __attribute__((ext_vector_type(4)));
typedef unsigned u32x4 __attribute__((ext_vector_type(4)));
typedef unsigned u32x2 __attribute__((ext_vector_type(2)));

constexpr int MTOK = 16384, DM = 2048, SEQ = 2048;
constexpr float EPS = 1e-6f;
constexpr size_t MiB = 1ull << 20;
constexpr size_t WS_RW = 0;
constexpr size_t WS_U = 50 * MiB;
constexpr size_t WS_BIG = 114 * MiB;
constexpr size_t WS_Z = 370 * MiB;
constexpr size_t WS_SM = 498 * MiB;
constexpr size_t WS_COS = WS_SM, WS_SIN = WS_SM + 2 * MiB, WS_GD = WS_SM + 4 * MiB, WS_BD = WS_SM + 6 * MiB;
constexpr size_t WS_SSQ = WS_SM + 8 * MiB;
constexpr size_t WS_LB = WS_SM + 9 * MiB;
constexpr size_t WS_END = WS_SM + 9 * MiB + 65536;
constexpr int LDS_BYTES = 131072;
constexpr int NPHASE = 19;

struct Params { const void* in[29]; float* out; unsigned char* ws; int ph_lo, ph_hi; };

__device__ __forceinline__ int fresh_tid() { int t = threadIdx.x; asm volatile("" : "+v"(t)); return t; }
__device__ __forceinline__ float bf2f(bf16_t v) { return __uint_as_float(((unsigned)v) << 16); }
__device__ __forceinline__ bf16_t f2bf(float f) { unsigned u = __float_as_uint(f); u += 0x7FFFu + ((u >> 16) & 1u); return (bf16_t)(u >> 16); }
__device__ __forceinline__ float siluf(float x) { return x / (1.f + __expf(-x)); }
__device__ __forceinline__ float sigmf(float x) { return 1.f / (1.f + __expf(-x)); }
__device__ __forceinline__ float wave_sum(float v) {
#pragma unroll
    for (int o = 32; o >= 1; o >>= 1) v += __shfl_xor(v, o);
    return v;
}
__device__ __forceinline__ u32x4 pack8(const f32x4 a, const f32x4 b) {
    u32x4 w; w.x = pg8::cvt_pk_bf16(a[0], a[1]); w.y = pg8::cvt_pk_bf16(a[2], a[3]); w.z = pg8::cvt_pk_bf16(b[0], b[1]); w.w = pg8::cvt_pk_bf16(b[2], b[3]); return w;
}

enum { MAP_ID = 0, MAP_MLAIN = 1, MAP_UQ = 2 };
__device__ __forceinline__ int map_src(int mode, int n, int nsrc) {
    if (mode == MAP_MLAIN) { if (n < 1024) return n; if (n < 3072) return n + 64; if (n < 3136) { const int j = n - 3072; return 1024 + (j >> 1) + 32 * (j & 1); } return -1; }
    if (mode == MAP_UQ) { const int hd = n / 192, c = n - hd * 192; if (c < 128) return n; const int j = c - 128; return hd * 192 + 128 + (j >> 1) + 32 * (j & 1); }
    return n < nsrc ? n : -1;
}
__device__ __forceinline__ void convert_w(float* tile, const float* W, int K, int Nsrc, bf16_t* Bt, int Ndst, int mode, const float* rowscale, float cscale, int bi, int nb) {
    const int tid = fresh_tid();
    const int tk = K / 64, tn = Ndst / 64;
    for (int t = bi; t < tk * tn; t += nb) {
        const int n0 = (t / tk) * 64, k0 = (t % tk) * 64;
        __syncthreads();
        {
            const int j = tid & 63, i0 = tid >> 6; const int sc = map_src(mode, n0 + j, Nsrc);
#pragma unroll
            for (int it = 0; it < 8; ++it) {
                const int k = k0 + i0 + 8 * it; float v = 0.f;
                if (sc >= 0) { v = W[(size_t)k * Nsrc + sc] * cscale; if (rowscale) v *= rowscale[k]; }
                tile[(i0 + 8 * it) * 65 + j] = v;
            }
        }
        __syncthreads();
        {
            const int n = tid >> 3, kk = (tid & 7) * 8; u32x4 w;
            w.x = pg8::cvt_pk_bf16(tile[(kk + 0) * 65 + n], tile[(kk + 1) * 65 + n]);
            w.y = pg8::cvt_pk_bf16(tile[(kk + 2) * 65 + n], tile[(kk + 3) * 65 + n]);
            w.z = pg8::cvt_pk_bf16(tile[(kk + 4) * 65 + n], tile[(kk + 5) * 65 + n]);
            w.w = pg8::cvt_pk_bf16(tile[(kk + 6) * 65 + n], tile[(kk + 7) * 65 + n]);
            *(u32x4*)(Bt + (size_t)(n0 + n) * K + k0 + kk) = w;
        }
    }
    __syncthreads();
}

__device__ __forceinline__ void row_phase(const float* hsrc, const float* Y, const float* postw, const float* prew, float* hout, bf16_t* U) {
    const int tid_ = fresh_tid(); const int lane = tid_ & 63, gw = blockIdx.x * 8 + (tid_ >> 6), nw = gridDim.x * 8;
    for (int row = gw; row < MTOK; row += nw) {
        f32x4 h[8]; const float* hp = hsrc + (size_t)row * DM + lane * 4;
#pragma unroll
        for (int i = 0; i < 8; ++i) h[i] = *(const f32x4*)(hp + 256 * i);
        if (Y) {
            f32x4 y[8]; const float* yp = Y + (size_t)row * DM + lane * 4; float ss = 0.f;
#pragma unroll
            for (int i = 0; i < 8; ++i) { y[i] = *(const f32x4*)(yp + 256 * i); ss += y[i][0] * y[i][0] + y[i][1] * y[i][1] + y[i][2] * y[i][2] + y[i][3] * y[i][3]; }
            ss = wave_sum(ss); const float ry = rsqrtf(ss * (1.f / 2048.f) + EPS);
            float* op = hout + (size_t)row * DM + lane * 4;
#pragma unroll
            for (int i = 0; i < 8; ++i) { const f32x4 pw = *(const f32x4*)(postw + lane * 4 + 256 * i); h[i] += y[i] * ry * pw; *(f32x4*)(op + 256 * i) = h[i]; }
        }
        if (prew) {
            float ss = 0.f;
#pragma unroll
            for (int i = 0; i < 8; ++i) ss += h[i][0] * h[i][0] + h[i][1] * h[i][1] + h[i][2] * h[i][2] + h[i][3] * h[i][3];
            ss = wave_sum(ss); const float r = rsqrtf(ss * (1.f / 2048.f) + EPS);
            bf16_t* up = U + (size_t)row * DM + lane * 4;
#pragma unroll
            for (int i = 0; i < 8; ++i) { const f32x4 pw = *(const f32x4*)(prew + lane * 4 + 256 * i); const f32x4 u = h[i] * r * pw;
                u32x2 w; w.x = pg8::cvt_pk_bf16(u[0], u[1]); w.y = pg8::cvt_pk_bf16(u[2], u[3]); *(u32x2*)(up + 256 * i) = w; }
        }
    }
}

enum { EM_HG = 0, EM_MLAIN = 1, EM_Q = 2, EM_KV = 3, EM_GDN = 4, EM_OUT = 5 };
struct Epi {
    static constexpr bool PERM = true, AFTER_DRAIN = false;
    int mode;
    unsigned char* ws;
    const float* lb;
    const float* alog; const float* dtb;
    __device__ __forceinline__ void operator()(const f32x4 (&acc)[2][2][4][2], const pg8::Unit& u, int wr, int wc, int fr, int fq) const {
        asm volatile("" : "+v"(fr), "+v"(fq));
        const int rowb = u.pm * 256 + wr * 64 + fr, colw = wc * 32 + 8 * fq;
#define EPI_LOOP for (int ai = 0; ai < 2; ++ai) for (int m = 0; m < 4; ++m) { const int row = rowb + ai * 128 + m * 16; (void)row; for (int bj = 0; bj < 2; ++bj) { const int col = colw + bj * 128; (void)col; f32x4 v0 = acc[ai][bj][m][0], v1 = acc[ai][bj][m][1];
#define EPI_END } }
        if (mode == EM_OUT) {
            float* Y = (float*)(ws + WS_BIG);
#pragma unroll
            EPI_LOOP float* p = Y + (size_t)row * 2048 + u.pn * 256 + col; *(f32x4*)p = v0; *(f32x4*)(p + 4) = v1; EPI_END
        } else if (mode == EM_KV) {
            bf16_t* KV = (bf16_t*)(ws + WS_BIG + 96 * MiB); const float* ssq = (const float*)(ws + WS_SSQ) + (size_t)MTOK * 8;
#pragma unroll
            for (int ai = 0; ai < 2; ++ai)
#pragma unroll
                for (int m = 0; m < 4; ++m) { const int row = rowb + ai * 128 + m * 16; const f32x4 p0 = *(const f32x4*)(ssq + (size_t)row * 8), p1 = *(const f32x4*)(ssq + (size_t)row * 8 + 4); const float r = rsqrtf((((p0[0] + p0[1]) + (p0[2] + p0[3])) + ((p1[0] + p1[1]) + (p1[2] + p1[3]))) * (1.f / 512.f) + EPS);
#pragma unroll
                    for (int bj = 0; bj < 2; ++bj) { const int col = colw + bj * 128; *(u32x4*)(KV + (size_t)row * 4096 + u.pn * 256 + col) = pack8(acc[ai][bj][m][0] * r, acc[ai][bj][m][1] * r); } }
        } else if (mode == EM_Q) {
            bf16_t* Q = (bf16_t*)(ws + WS_BIG); const float* ssq = (const float*)(ws + WS_SSQ);
            const float* COS = (const float*)(ws + WS_COS); const float* SIN = (const float*)(ws + WS_SIN);
#pragma unroll
            for (int ai = 0; ai < 2; ++ai)
#pragma unroll
                for (int m = 0; m < 4; ++m) { const int row = rowb + ai * 128 + m * 16; const f32x4 p0 = *(const f32x4*)(ssq + (size_t)row * 8), p1 = *(const f32x4*)(ssq + (size_t)row * 8 + 4); const float r = rsqrtf((((p0[0] + p0[1]) + (p0[2] + p0[3])) + ((p1[0] + p1[1]) + (p1[2] + p1[3]))) * (1.f / 512.f) + EPS);
#pragma unroll
                    for (int bj = 0; bj < 2; ++bj) { const int c = u.pn * 256 + colw + bj * 128; const int within = c % 192;
                        f32x4 v0 = acc[ai][bj][m][0] * r, v1 = acc[ai][bj][m][1] * r;
                        if (within >= 128) { const int j0 = (within - 128) >> 1; const f32x4 cs = *(const f32x4*)(COS + (size_t)row * 32 + j0), sn = *(const f32x4*)(SIN + (size_t)row * 32 + j0);
                            const f32x4 a = (f32x4){v0[0], v0[2], v1[0], v1[2]}, b = (f32x4){v0[1], v0[3], v1[1], v1[3]};
                            const f32x4 ra = a * cs - b * sn, rb = b * cs + a * sn;
                            v0 = (f32x4){ra[0], rb[0], ra[1], rb[1]}; v1 = (f32x4){ra[2], rb[2], ra[3], rb[3]}; }
                        *(u32x4*)(Q + (size_t)row * 3072 + c) = pack8(v0, v1); } }
        } else if (mode == EM_MLAIN) {
            if (u.pn < 4) {
                bf16_t* C = (bf16_t*)(ws + WS_Z + (u.pn < 2 ? 64 : 80) * MiB); float* ssq = (float*)(ws + WS_SSQ) + (u.pn < 2 ? (size_t)0 : (size_t)MTOK * 8); const int cb = (u.pn & 1) * 256;
#pragma unroll
                for (int ai = 0; ai < 2; ++ai)
#pragma unroll
                    for (int m = 0; m < 4; ++m) { const int row = rowb + ai * 128 + m * 16; float s = 0.f;
#pragma unroll
                        for (int bj = 0; bj < 2; ++bj) { const int col = colw + bj * 128; const f32x4 v0 = acc[ai][bj][m][0], v1 = acc[ai][bj][m][1];
                            s += v0[0] * v0[0] + v0[1] * v0[1] + v0[2] * v0[2] + v0[3] * v0[3] + v1[0] * v1[0] + v1[1] * v1[1] + v1[2] * v1[2] + v1[3] * v1[3];
                            *(u32x4*)(C + (size_t)row * 512 + cb + col) = pack8(v0, v1); }
                        s += __shfl_xor(s, 16); s += __shfl_xor(s, 32);
                        if (fq == 0) ssq[(size_t)row * 8 + (u.pn & 1) * 4 + wc] = s; }
            } else if (u.pn < 12) {
                bf16_t* Zs = (bf16_t*)(ws + WS_Z); const int cb = (u.pn - 4) * 256;
#pragma unroll
                EPI_LOOP
                    for (int e = 0; e < 4; ++e) { v0[e] = siluf(v0[e]); v1[e] = siluf(v1[e]); }
                    *(u32x4*)(Zs + (size_t)row * 2048 + cb + col) = pack8(v0, v1);
                EPI_END
            } else {
                if (colw < 64) {
                    bf16_t* KR = (bf16_t*)(ws + WS_Z + 96 * MiB); const float* COS = (const float*)(ws + WS_COS); const float* SIN = (const float*)(ws + WS_SIN);
#pragma unroll
                    for (int ai = 0; ai < 2; ++ai)
#pragma unroll
                        for (int m = 0; m < 4; ++m) { const int row = rowb + ai * 128 + m * 16; const int j0 = colw >> 1;
                            const f32x4 v0 = acc[ai][0][m][0], v1 = acc[ai][0][m][1];
                            const f32x4 cs = *(const f32x4*)(COS + (size_t)row * 32 + j0), sn = *(const f32x4*)(SIN + (size_t)row * 32 + j0);
                            const f32x4 a = (f32x4){v0[0], v0[2], v1[0], v1[2]}, b = (f32x4){v0[1], v0[3], v1[1], v1[3]};
                            const f32x4 ra = a * cs - b * sn, rb = b * cs + a * sn;
                            *(u32x4*)(KR + (size_t)row * 64 + colw) = pack8((f32x4){ra[0], rb[0], ra[1], rb[1]}, (f32x4){ra[2], rb[2], ra[3], rb[3]}); }
                }
            }
        } else if (mode == EM_HG) {
            const int region = u.pn >> 3, cb = (u.pn & 7) * 256;
            if (region == 0) {
                bf16_t* Q = (bf16_t*)(ws + WS_BIG);
#pragma unroll
                EPI_LOOP
                    for (int e = 0; e < 4; ++e) { v0[e] = siluf(v0[e]) * 0.08838834764831845f; v1[e] = siluf(v1[e]) * 0.08838834764831845f; }
                    *(u32x4*)(Q + (size_t)row * 2048 + cb + col) = pack8(v0, v1);
                EPI_END
            } else if (region == 1) {
                bf16_t* Kk = (bf16_t*)(ws + WS_BIG + 64 * MiB); float* G = (float*)(ws + WS_BIG + 128 * MiB);
#pragma unroll
                for (int bj = 0; bj < 2; ++bj) { const int col = colw + bj * 128; const f32x4 l0 = *(const f32x4*)(lb + cb + col), l1 = *(const f32x4*)(lb + cb + col + 4);
#pragma unroll
                    for (int ai = 0; ai < 2; ++ai)
#pragma unroll
                        for (int m = 0; m < 4; ++m) { const int row = rowb + ai * 128 + m * 16; const f32x4 v0 = acc[ai][bj][m][0], v1 = acc[ai][bj][m][1]; f32x4 g0, g1, k0, k1;
#pragma unroll
                            for (int e = 0; e < 4; ++e) {
                                { const float f = v0[e], l = l0[e], en = __expf(-fabsf(f)), ls = fminf(f, 0.f) - __logf(1.f + en), sg = __expf(ls);
                                  g0[e] = (l == 0.f) ? ls : __logf(l + (1.f - l) * sg); k0[e] = (1.f - l) * (1.f - sg); }
                                { const float f = v1[e], l = l1[e], en = __expf(-fabsf(f)), ls = fminf(f, 0.f) - __logf(1.f + en), sg = __expf(ls);
                                  g1[e] = (l == 0.f) ? ls : __logf(l + (1.f - l) * sg); k1[e] = (1.f - l) * (1.f - sg); } }
                            float* gp = G + (size_t)row * 2048 + cb + col; *(f32x4*)gp = g0; *(f32x4*)(gp + 4) = g1;
                            *(u32x4*)(Kk + (size_t)row * 2048 + cb + col) = pack8(k0, k1); } }
            } else if (region == 2) {
                bf16_t* V = (bf16_t*)(ws + WS_Z);
#pragma unroll
                EPI_LOOP *(u32x4*)(V + (size_t)row * 2048 + cb + col) = pack8(v0, v1); EPI_END
            } else {
                bf16_t* Zs = (bf16_t*)(ws + WS_Z + 64 * MiB);
#pragma unroll
                EPI_LOOP
                    for (int e = 0; e < 4; ++e) { v0[e] = siluf(v0[e]); v1[e] = siluf(v1[e]); }
                    *(u32x4*)(Zs + (size_t)row * 2048 + cb + col) = pack8(v0, v1);
                EPI_END
            }
        } else {
            if (u.pn < 32) {
                bf16_t* QKV = (bf16_t*)(ws + WS_BIG);
#pragma unroll
                EPI_LOOP *(u32x4*)(QKV + (size_t)row * 8192 + u.pn * 256 + col) = pack8(v0, v1); EPI_END
            } else if (u.pn < 48) {
                bf16_t* Zs = (bf16_t*)(ws + WS_Z); const int cb = (u.pn - 32) * 256;
#pragma unroll
                EPI_LOOP
                    for (int e = 0; e < 4; ++e) { v0[e] = siluf(v0[e]); v1[e] = siluf(v1[e]); }
                    *(u32x4*)(Zs + (size_t)row * 4096 + cb + col) = pack8(v0, v1);
                EPI_END
            } else {
                if (colw < 64) {
                    float* GD = (float*)(ws + WS_GD); float* BD = (float*)(ws + WS_BD);
#pragma unroll
                    for (int ai = 0; ai < 2; ++ai)
#pragma unroll
                        for (int m = 0; m < 4; ++m) { const int row = rowb + ai * 128 + m * 16; f32x4 v0 = acc[ai][0][m][0], v1 = acc[ai][0][m][1];
                            if (colw < 32) {
                                const f32x4 a0 = *(const f32x4*)(alog + colw), a1 = *(const f32x4*)(alog + colw + 4), d0 = *(const f32x4*)(dtb + colw), d1 = *(const f32x4*)(dtb + colw + 4);
#pragma unroll
                                for (int e = 0; e < 4; ++e) {
                                    { const float x = v0[e] + d0[e]; const float sp = fmaxf(x, 0.f) + __logf(1.f + __expf(-fabsf(x))); v0[e] = -__expf(a0[e]) * sp; }
                                    { const float x = v1[e] + d1[e]; const float sp = fmaxf(x, 0.f) + __logf(1.f + __expf(-fabsf(x))); v1[e] = -__expf(a1[e]) * sp; } }
                                float* p = GD + (size_t)row * 32 + colw; *(f32x4*)p = v0; *(f32x4*)(p + 4) = v1;
                            } else {
#pragma unroll
                                for (int e = 0; e < 4; ++e) { v0[e] = sigmf(v0[e]); v1[e] = sigmf(v1[e]); }
                                float* p = BD + (size_t)row * 32 + (colw - 32); *(f32x4*)p = v0; *(f32x4*)(p + 4) = v1;
                            } }
                }
            }
        }
#undef EPI_LOOP
#undef EPI_END
    }
};

__device__ __forceinline__ void run_gemm(LAS unsigned char* lds, const bf16_t* A, const bf16_t* Bt, int N, int K, const Epi E) {
    pg8::Gemm g{A, Bt, MTOK, N, K}; pg8::StaticOrder S; S.init(MTOK, N, (int)gridDim.x, (int)blockIdx.x);
    pg8::gemm_phase<Epi, pg8::StaticOrder>(lds, g, S, E);
    __syncthreads();
}

__device__ __forceinline__ void gla_naive(float* L, unsigned char* ws, const float* hn) {
    if (blockIdx.x >= 128) return;
    const int tid = fresh_tid(), lane = tid & 63, wv = tid >> 6;
    const int b = blockIdx.x >> 4, h = blockIdx.x & 15;
    const bf16_t* Q = (const bf16_t*)(ws + WS_BIG); const bf16_t* Kk = (const bf16_t*)(ws + WS_BIG + 64 * MiB); const float* G = (const float*)(ws + WS_BIG + 128 * MiB);
    const bf16_t* V = (const bf16_t*)(ws + WS_Z); bf16_t* Zs = (bf16_t*)(ws + WS_Z + 64 * MiB);
    float* sq = L; float* sk = L + 2048; float* sf = L + 4096; float* sv = L + 6144; float* so = L + 8192;
    float S[128];
#pragma unroll
    for (int k = 0; k < 128; ++k) S[k] = 0.f;
    for (int t0 = 0; t0 < SEQ; t0 += 16) {
        __syncthreads();
#pragma unroll
        for (int i = 0; i < 4; ++i) { const int e = tid + 512 * i, tt = e >> 7, c = e & 127; const size_t gi = (size_t)(b * SEQ + t0 + tt) * 2048 + h * 128 + c;
            sq[e] = bf2f(Q[gi]); sk[e] = bf2f(Kk[gi]); sf[e] = __expf(G[gi]); sv[e] = bf2f(V[gi]); }
        __syncthreads();
        if (tid < 128) {
            for (int tt = 0; tt < 16; ++tt) {
                const float vv = sv[tt * 128 + tid]; float o = 0.f;
                const float* pq = sq + tt * 128; const float* pk = sk + tt * 128; const float* pf = sf + tt * 128;
#pragma unroll
                for (int k = 0; k < 128; ++k) { S[k] = pf[k] * S[k] + pk[k] * vv; o += pq[k] * S[k]; }
                so[tt * 128 + tid] = o;
            }
        }
        __syncthreads();
#pragma unroll
        for (int r = 0; r < 2; ++r) { const int tt = wv * 2 + r; const float x0 = so[tt * 128 + lane], x1 = so[tt * 128 + 64 + lane];
            const float ss = wave_sum(x0 * x0 + x1 * x1); const float rn = rsqrtf(ss * (1.f / 128.f) + EPS);
            const size_t gi = (size_t)(b * SEQ + t0 + tt) * 2048 + h * 128;
            Zs[gi + lane] = f2bf(x0 * rn * hn[lane] * bf2f(Zs[gi + lane])); Zs[gi + 64 + lane] = f2bf(x1 * rn * hn[64 + lane] * bf2f(Zs[gi + 64 + lane])); }
    }
}

__device__ __forceinline__ void gdn_naive(float* L, unsigned char* ws, const float* cw, const float* hn) {
    const int tid = fresh_tid(), lane = tid & 63, wv = tid >> 6;
    const bf16_t* QKV = (const bf16_t*)(ws + WS_BIG); bf16_t* Zs = (bf16_t*)(ws + WS_Z); const float* GD = (const float*)(ws + WS_GD); const float* BD = (const float*)(ws + WS_BD);
    float* sq = L; float* sk = L + 2048; float* sv = L + 4096; float* so = L + 6144; float* sa = L + 8192; float* sb = L + 8192 + 16;
    for (int item = blockIdx.x; item < 256; item += gridDim.x) {
        const int b = item >> 5, vh = item & 31, hq = vh >> 1;
        float S[128];
#pragma unroll
        for (int k = 0; k < 128; ++k) S[k] = 0.f;
        for (int t0 = 0; t0 < SEQ; t0 += 16) {
            __syncthreads();
            for (int i = 0; i < 12; ++i) { const int e = tid + 512 * i, arr = e >> 11, r = e & 2047, tt = r >> 7, c = r & 127;
                const int ch = (arr == 0 ? hq * 128 : (arr == 1 ? 2048 + hq * 128 : 4096 + vh * 128)) + c; const int t = t0 + tt; float a = 0.f;
#pragma unroll
                for (int j = 0; j < 4; ++j) { const int ts = t - 3 + j; if (ts >= 0) a += cw[j * 8192 + ch] * bf2f(QKV[(size_t)(b * SEQ + ts) * 8192 + ch]); }
                L[e] = siluf(a); }
            if (tid < 16) { sa[tid] = __expf(GD[(size_t)(b * SEQ + t0 + tid) * 32 + vh]); sb[tid] = BD[(size_t)(b * SEQ + t0 + tid) * 32 + vh]; }
            __syncthreads();
#pragma unroll
            for (int r = 0; r < 4; ++r) { const int rr = wv * 4 + r; float* p = L + rr * 128; const float x0 = p[lane], x1 = p[64 + lane];
                const float ss = wave_sum(x0 * x0 + x1 * x1); const float rn = rsqrtf(ss + EPS) * (rr < 16 ? 0.08838834764831845f : 1.f);
                p[lane] = x0 * rn; p[64 + lane] = x1 * rn; }
            __syncthreads();
            if (tid < 128) {
                for (int tt = 0; tt < 16; ++tt) {
                    const float a = sa[tt], bt = sb[tt], vv = sv[tt * 128 + tid];
                    const float* pq = sq + tt * 128; const float* pk = sk + tt * 128;
                    float pred = 0.f;
#pragma unroll
                    for (int k = 0; k < 128; ++k) pred += pk[k] * S[k];
                    asm volatile("" ::: "memory");
                    const float d = bt * (vv - a * pred); float o = 0.f;
#pragma unroll
                    for (int k = 0; k < 128; ++k) { S[k] = a * S[k] + pk[k] * d; o += pq[k] * S[k]; }
                    so[tt * 128 + tid] = o;
                }
            }
            __syncthreads();
#pragma unroll
            for (int r = 0; r < 2; ++r) { const int tt = wv * 2 + r; const float x0 = so[tt * 128 + lane], x1 = so[tt * 128 + 64 + lane];
                const float ss = wave_sum(x0 * x0 + x1 * x1); const float rn = rsqrtf(ss * (1.f / 128.f) + EPS);
                const size_t gi = (size_t)(b * SEQ + t0 + tt) * 4096 + vh * 128;
                Zs[gi + lane] = f2bf(x0 * rn * hn[lane] * bf2f(Zs[gi + lane])); Zs[gi + 64 + lane] = f2bf(x1 * rn * hn[64 + lane] * bf2f(Zs[gi + 64 + lane])); }
        }
    }
}

constexpr int KS_STRIDE = 200, VS_STRIDE = 144;
__device__ __forceinline__ s16x4 tr_read(const bf16_t* p) {
    typedef short v4i16_t __attribute__((ext_vector_type(4)));
    return __builtin_bit_cast(s16x4, __builtin_amdgcn_ds_read_tr16_b64_v4i16((LAS v4i16_t*)p));
}
__device__ __forceinline__ void attn_tile(bf16_t* Ks, bf16_t* Vs, unsigned char* ws, int b, int h, int qt) {
    const int tid = fresh_tid(), lane = tid & 63, wv = __builtin_amdgcn_readfirstlane(tid >> 6), fr = lane & 15, fq = lane >> 4;
    const bf16_t* Q = (const bf16_t*)(ws + WS_BIG); const bf16_t* KV = (const bf16_t*)(ws + WS_BIG + 96 * MiB); const bf16_t* KR = (const bf16_t*)(ws + WS_Z + 96 * MiB);
    bf16_t* Zs = (bf16_t*)(ws + WS_Z);
    const int row = b * SEQ + qt * 128 + wv * 16 + fr;
    bf16x8 qf[6];
#pragma unroll
    for (int s = 0; s < 6; ++s) qf[s] = *(const bf16x8*)(Q + (size_t)row * 3072 + h * 192 + 32 * s + 8 * fq);
    f32x4 acc[8];
#pragma unroll
    for (int i = 0; i < 8; ++i) acc[i] = (f32x4){0.f, 0.f, 0.f, 0.f};
    float mrun = -INFINITY, lsum = 0.f;
    const int ntiles = 2 * qt + 2, myn = (wv < 4) ? 2 * qt + 1 : 2 * qt + 2;
    for (int kt = 0; kt < ntiles; ++kt) {
        __syncthreads();
        {
            const size_t krow0 = (size_t)(b * SEQ + kt * 64);
#pragma unroll
            for (int i = 0; i < 2; ++i) { const int ch = tid + 512 * i, r = ch >> 4, cc = ch & 15;
                *(u32x4*)(Ks + r * KS_STRIDE + cc * 8) = *(const u32x4*)(KV + (krow0 + r) * 4096 + h * 256 + cc * 8);
                *(u32x4*)(Vs + r * VS_STRIDE + cc * 8) = *(const u32x4*)(KV + (krow0 + r) * 4096 + h * 256 + 128 + cc * 8); }
            { const int r = tid >> 3, cc = tid & 7; *(u32x4*)(Ks + r * KS_STRIDE + 128 + cc * 8) = *(const u32x4*)(KR + (krow0 + r) * 64 + cc * 8); }
        }
        __syncthreads();
        if (kt < myn) {
            f32x4 s[4];
#pragma unroll
            for (int nt = 0; nt < 4; ++nt) { s[nt] = (f32x4){0.f, 0.f, 0.f, 0.f};
#pragma unroll
                for (int st = 0; st < 6; ++st) { const bf16x8 kf = *(const bf16x8*)(Ks + (16 * nt + fr) * KS_STRIDE + 32 * st + 8 * fq);
                    s[nt] = __builtin_amdgcn_mfma_f32_16x16x32_bf16(kf, qf[st], s[nt], 0, 0, 0); } }
            float mx = s[0][0];
#pragma unroll
            for (int nt = 0; nt < 4; ++nt)
#pragma unroll
                for (int j = 0; j < 4; ++j) mx = fmaxf(mx, s[nt][j]);
            mx = fmaxf(mx, __shfl_xor(mx, 16)); mx = fmaxf(mx, __shfl_xor(mx, 32));
            const float mnew = fmaxf(mrun, mx), alpha = __expf(mrun - mnew); mrun = mnew;
            float ps = 0.f;
#pragma unroll
            for (int nt = 0; nt < 4; ++nt)
#pragma unroll
                for (int j = 0; j < 4; ++j) { s[nt][j] = __expf(s[nt][j] - mnew); ps += s[nt][j]; }
            lsum = lsum * alpha + ps;
#pragma unroll
            for (int i = 0; i < 8; ++i) acc[i] *= alpha;
            bf16x8 pf[2];
#pragma unroll
            for (int s2 = 0; s2 < 2; ++s2) { const u32x4 w = pack8(s[2 * s2], s[2 * s2 + 1]); pf[s2] = __builtin_bit_cast(bf16x8, w); }
            const int tq = fr >> 2, tp = fr & 3;
#pragma unroll
            for (int vt = 0; vt < 8; ++vt)
#pragma unroll
                for (int s2 = 0; s2 < 2; ++s2) { const bf16_t* vp = Vs + (32 * s2 + 4 * fq + tq) * VS_STRIDE + 16 * vt + 4 * tp;
                    const s16x4 r0 = tr_read(vp), r1 = tr_read(vp + 16 * VS_STRIDE);
                    const bf16x8 vf = (bf16x8){r0[0], r0[1], r0[2], r0[3], r1[0], r1[1], r1[2], r1[3]};
                    acc[vt] = __builtin_amdgcn_mfma_f32_16x16x32_bf16(vf, pf[s2], acc[vt], 0, 0, 0); }
        }
    }
    lsum += __shfl_xor(lsum, 16); lsum += __shfl_xor(lsum, 32);
    const float inv = 1.f / lsum;
#pragma unroll
    for (int vt = 0; vt < 8; ++vt) { bf16_t* zp = Zs + (size_t)row * 2048 + h * 128 + 16 * vt + 4 * fq; const u32x2 zz = *(const u32x2*)zp;
        const float z0 = __uint_as_float(zz.x << 16), z1 = __uint_as_float(zz.x & 0xffff0000u), z2 = __uint_as_float(zz.y << 16), z3 = __uint_as_float(zz.y & 0xffff0000u);
        u32x2 w; w.x = pg8::cvt_pk_bf16(acc[vt][0] * inv * z0, acc[vt][1] * inv * z1); w.y = pg8::cvt_pk_bf16(acc[vt][2] * inv * z2, acc[vt][3] * inv * z3); *(u32x2*)zp = w; }
}
__device__ __forceinline__ void attn_phase(unsigned char* lds, unsigned char* ws) {
    bf16_t* Ks = (bf16_t*)lds; bf16_t* Vs = (bf16_t*)(lds + 64 * KS_STRIDE * 2);
    for (int p = blockIdx.x; p < 1024; p += gridDim.x) { const int bh = p >> 3, pr = p & 7;
        attn_tile(Ks, Vs, ws, bh >> 4, bh & 15, 15 - pr);
        attn_tile(Ks, Vs, ws, bh >> 4, bh & 15, pr); }
}

__device__ __forceinline__ void prep_tables(const Params& P) {
    unsigned char* ws = P.ws; const int gt = blockIdx.x * 512 + fresh_tid(), ng = gridDim.x * 512;
    const int* pos = (const int*)P.in[1]; float* COS = (float*)(ws + WS_COS); float* SIN = (float*)(ws + WS_SIN);
    for (int i = gt; i < MTOK * 32; i += ng) { const int row = i >> 5, j = i & 31;
        const float invf = __builtin_amdgcn_exp2f(-(float)j * (13.287712379549449f / 32.f));
        const float ang = (float)pos[row] * invf;
        double t = (double)ang * 0.15915494309189535; t -= floor(t); const float tf = (float)t;
        COS[i] = __builtin_amdgcn_cosf(tf); SIN[i] = __builtin_amdgcn_sinf(tf); }
    const float* lbp = (const float*)P.in[2]; float* LB = (float*)(ws + WS_LB);
    for (int c = gt; c < 2048; c += ng) { const float a0 = lbp[c], a1 = lbp[2048 + c], a2 = lbp[4096 + c], a3 = lbp[6144 + c];
        const float mx = fmaxf(fmaxf(a0, a1), fmaxf(a2, a3)); const float e0 = expf(a0 - mx), e1 = expf(a1 - mx), e2 = expf(a2 - mx), e3 = expf(a3 - mx); const float sm = e0 + e1 + e2 + e3;
        LB[c] = 0.f; LB[2048 + c] = (e1 + e2 + e3) / sm; }
}

struct CvM { const float* W; int K, Ns, Nd, mode; bf16_t* dst; const float* rs; float cs; };
__device__ __forceinline__ bool cv_get(const Params& P, int cv, int sub, CvM& m) {
#define FIN(i) ((const float*)P.in[i])
    bf16_t* RW = (bf16_t*)(P.ws + WS_RW); bf16_t* U = (bf16_t*)(P.ws + WS_U);
    m.rs = nullptr; m.cs = 1.f; m.mode = MAP_ID;
    if (sub > 0 && cv != 2) return false;
    switch (cv) {
        case 0: m.W = FIN(5);  m.K = 2048; m.Ns = 8192;  m.Nd = 8192;  m.dst = RW; return true;
        case 1: m.W = FIN(7);  m.K = 2048; m.Ns = 2048;  m.Nd = 2048;  m.dst = U;  return true;
        case 2:
            if (sub == 0) { m.W = FIN(10); m.K = 2048; m.Ns = 3136; m.Nd = 3328; m.mode = MAP_MLAIN; m.dst = RW; return true; }
            if (sub == 1) { m.W = FIN(13); m.K = 512; m.Ns = 3072; m.Nd = 3072; m.mode = MAP_UQ; m.dst = RW + (size_t)3328 * 2048; m.rs = FIN(11); m.cs = 0.07216878364870323f; return true; }
            if (sub == 2) { m.W = FIN(14); m.K = 512; m.Ns = 4096; m.Nd = 4096; m.dst = RW + (size_t)3328 * 2048 + (size_t)3072 * 512; m.rs = FIN(12); return true; }
            return false;
        case 3: m.W = FIN(15); m.K = 2048; m.Ns = 2048;  m.Nd = 2048;  m.dst = U;  return true;
        case 4: m.W = FIN(18); m.K = 2048; m.Ns = 12352; m.Nd = 12544; m.dst = RW; return true;
        case 5: m.W = FIN(23); m.K = 4096; m.Ns = 2048;  m.Nd = 2048;  m.dst = U;  return true;
        case 6: m.W = FIN(26); m.K = 2048; m.Ns = 8192;  m.Nd = 8192;  m.dst = RW; return true;
        case 7: m.W = FIN(28); m.K = 2048; m.Ns = 2048;  m.Nd = 2048;  m.dst = U;  return true;
        default: return false;
    }
}

__global__ void __launch_bounds__(512) trunk_fwd(Params P) {
    extern __shared__ __attribute__((aligned(16))) unsigned char lds[];
    cg::grid_group grid = cg::this_grid();
    unsigned char* ws = P.ws; LAS unsigned char* L3 = (LAS unsigned char*)lds; float* Lf = (float*)lds;
    const int bi = blockIdx.x, nb = gridDim.x;
    bf16_t* RW = (bf16_t*)(ws + WS_RW); bf16_t* U = (bf16_t*)(ws + WS_U);
    const bf16_t* Z0 = (const bf16_t*)(ws + WS_Z); const bf16_t* Z64 = (const bf16_t*)(ws + WS_Z + 64 * MiB); const bf16_t* Z80 = (const bf16_t*)(ws + WS_Z + 80 * MiB);
    const float* YB = (const float*)(ws + WS_BIG); const float* LB = (const float*)(ws + WS_LB);
    for (int st = P.ph_lo; st < P.ph_hi; ++st) {
        int cv = -1, rowk = 0, gm = -1, gN = 0, gK = 0, mix = 0; bool sync_after = true, tables = false;
        const float *r_h = nullptr, *r_y = nullptr, *r_post = nullptr, *r_pre = nullptr, *hn = nullptr, *lbp = LB;
        const bf16_t *gA = nullptr, *gB = nullptr;
        switch (st) {
            case 0:  tables = true; rowk = 1; r_h = FIN(0); r_pre = FIN(3); cv = 0; break;
            case 1:  gm = EM_HG; gA = U; gB = RW; gN = 8192; gK = 2048; lbp = LB; break;
            case 2:  cv = 1; mix = 1; hn = FIN(6); break;
            case 3:  gm = EM_OUT; gA = Z64; gB = U; gN = 2048; gK = 2048; break;
            case 4:  rowk = 1; r_h = FIN(0); r_y = YB; r_post = FIN(4); r_pre = FIN(8); cv = 2; break;
            case 5:  gm = EM_MLAIN; gA = U; gB = RW; gN = 3328; gK = 2048; break;
            case 6:  gm = EM_Q; gA = Z64; gB = RW + (size_t)3328 * 2048; gN = 3072; gK = 512; sync_after = false; break;
            case 7:  gm = EM_KV; gA = Z80; gB = RW + (size_t)3328 * 2048 + (size_t)3072 * 512; gN = 4096; gK = 512; break;
            case 8:  cv = 3; mix = 2; break;
            case 9:  gm = EM_OUT; gA = Z0; gB = U; gN = 2048; gK = 2048; break;
            case 10: rowk = 1; r_h = P.out; r_y = YB; r_post = FIN(9); r_pre = FIN(16); cv = 4; break;
            case 11: gm = EM_GDN; gA = U; gB = RW; gN = 12544; gK = 2048; break;
            case 12: cv = 5; mix = 3; hn = FIN(22); break;
            case 13: gm = EM_OUT; gA = Z0; gB = U; gN = 2048; gK = 4096; break;
            case 14: rowk = 1; r_h = P.out; r_y = YB; r_post = FIN(17); r_pre = FIN(24); cv = 6; break;
            case 15: gm = EM_HG; gA = U; gB = RW; gN = 8192; gK = 2048; lbp = LB + 2048; break;
            case 16: cv = 7; mix = 1; hn = FIN(27); break;
            case 17: gm = EM_OUT; gA = Z64; gB = U; gN = 2048; gK = 2048; break;
            default: rowk = 1; r_h = P.out; r_y = YB; r_post = FIN(25); r_pre = nullptr; break;
        }
        if (tables) prep_tables(P);
        if (rowk) row_phase(r_h, r_y, r_post, r_pre, P.out, U);
        if (cv >= 0) { for (int sub = 0; sub < 3; ++sub) { CvM m; if (!cv_get(P, cv, sub, m)) break; convert_w(Lf, m.W, m.K, m.Ns, m.dst, m.Nd, m.mode, m.rs, m.cs, bi, nb); } }
        if (gm >= 0) { Epi E; E.mode = gm;
#ifdef ONLY_MODE
            E.mode = ONLY_MODE;
#endif
 E.ws = ws; E.lb = lbp; E.alog = FIN(20); E.dtb = FIN(21); run_gemm(L3, gA, gB, gN, gK, E); }
#ifndef DIS_GLA
        if (mix == 1) gla_naive(Lf, ws, hn);
#endif
#ifndef DIS_ATTN
        if (mix == 2) attn_phase(lds, ws);
#endif
#ifndef DIS_GDN
        if (mix == 3) gdn_naive(Lf, ws, FIN(19), hn);
#endif
        if (sync_after && st + 1 < P.ph_hi) grid.sync();
    }
#ifdef PROBE_N
    grid.sync();
    { const unsigned short* U16 = (const unsigned short*)(ws + WS_U); const unsigned short* B16 = (const unsigned short*)(ws + WS_BIG); const unsigned short* Z16 = (const unsigned short*)(ws + WS_Z);
      const unsigned short* S16 = (const unsigned short*)(ws + WS_SM); const unsigned short* R16 = (const unsigned short*)(ws + WS_RW);
      const size_t n = (size_t)MTOK * DM; for (size_t i = (size_t)blockIdx.x * 512 + threadIdx.x; i < n; i += (size_t)gridDim.x * 512) {
        unsigned a = U16[i]; a = a * 2654435761u + B16[i]; a = a * 2654435761u + B16[i + n]; a = a * 2654435761u + B16[i + 2 * n]; a = a * 2654435761u + B16[i + 3 * n]; a = a * 2654435761u + Z16[i]; a = a * 2654435761u + Z16[i + n];
        if (i < 4 * MiB) a = a * 2654435761u + S16[i]; if (i < 25 * MiB) a = a * 2654435761u + R16[i];
        a ^= a >> 15; a *= 2246822519u; a ^= a >> 13;
        P.out[i] = (float)(a & 0xFFFFu); } }
#endif
#undef FIN
}

extern "C" void kernel_launch(void* const* d_in, const int* in_sizes, int n_in, void* d_out, int out_size, void* d_ws, size_t ws_size, hipStream_t stream) {
    static int grid_blocks = 0;
    if (grid_blocks == 0) {
        if (n_in != 29 || ws_size < WS_END) { fprintf(stderr, "kernel_launch: need 29 inputs and %zu bytes of workspace; got %d, %zu\n", (size_t)WS_END, n_in, ws_size); grid_blocks = -1; return; }
        int dev = 0, cus = 0, per_cu = 0;
        hipGetDevice(&dev); hipDeviceGetAttribute(&cus, hipDeviceAttributeMultiprocessorCount, dev);
        if (hipFuncSetAttribute((const void*)trunk_fwd, hipFuncAttributeMaxDynamicSharedMemorySize, LDS_BYTES) != hipSuccess) { fprintf(stderr, "hipFuncSetAttribute failed\n"); grid_blocks = -1; return; }
        if (hipOccupancyMaxActiveBlocksPerMultiprocessor(&per_cu, (const void*)trunk_fwd, 512, LDS_BYTES) != hipSuccess || per_cu < 1) { fprintf(stderr, "occupancy query failed (%d)\n", per_cu); per_cu = 1; }
        (void)hipGetLastError();
        grid_blocks = cus * 1;
    }
    if (grid_blocks < 0) return;
    Params p{};
    for (int i = 0; i < 29; ++i) p.in[i] = d_in[i];
    p.out = (float*)d_out; p.ws = (unsigned char*)d_ws;
#if PER_PHASE_LAUNCH
    for (int ph = 0; ph < NPHASE; ++ph) {
        p.ph_lo = ph; p.ph_hi = ph + 1; void* args[] = {&p};
        hipError_t e = hipLaunchCooperativeKernel((const void*)trunk_fwd, dim3(grid_blocks), dim3(512), args, LDS_BYTES, stream);
        if (e != hipSuccess) { fprintf(stderr, "launch failed: %s\n", hipGetErrorString(e)); break; }
    }
#else
#ifdef PROBE_N
    p.ph_lo = 0; p.ph_hi = PROBE_N; void* args[] = {&p};
#else
    p.ph_lo = 0; p.ph_hi = NPHASE; void* args[] = {&p};
#endif
    hipError_t e = hipLaunchCooperativeKernel((const void*)trunk_fwd, dim3(grid_blocks), dim3(512), args, LDS_BYTES, stream);
    if (e != hipSuccess) fprintf(stderr, "cooperative launch failed: %s (grid %d)\n", hipGetErrorString(e), grid_blocks);
#endif
}
```

```cpp
#include <hip/hip_runtime.h>
#include <hip/hip_cooperative_groups.h>
#include <cstdio>
namespace cg = cooperative_groups;
namespace pg8 {
#define PG8_LAS __attribute__((address_space(3)))
typedef unsigned short bf16_t;
typedef short bf16x8 __attribute__((ext_vector_type(8)));
typedef float f32x4 __attribute__((ext_vector_type(4)));
typedef unsigned u32x4 __attribute__((ext_vector_type(4)));
constexpr int BM = 256, BK = 64, HALF = 128, HTB = HALF * BK * 2  , STAGE_BYTES = 8 * HTB, NXCD = 8, WGM = 8;

__host__ __device__ __forceinline__ int lds_byte(int r, int c) { const int st = (r >> 4) * 2 + (c >> 5), rr = r & 15, cc = c & 31, ob = rr * 64 + cc * 2; return st * 1024 + (ob ^ (((ob >> 9) & 1) << 5)); }
__host__ __device__ __forceinline__ void stage_rc(int b, int& R, int& C) { const int st = b / 1024, sb = b % 1024, swz = sb ^ (((sb >> 9) & 1) << 5); R = (st >> 1) * 16 + swz / 64; C = (st & 1) * 32 + (swz % 64) / 2; }
__host__ __device__ __forceinline__ int perm32(int rho) { const int n = rho >> 4, i = rho & 15; return 8 * (i >> 2) + 4 * n + (i & 3); }

struct Unit { int pm, pn; };
struct Gemm { const bf16_t* A; const bf16_t* Bt; int M, N, K; };
struct StaticOrder {
    int nM, nN, nwg, G, c;
    __host__ __device__ void init(int M, int N, int G_, int c_) { nM = M / BM; nN = N / BM; nwg = nM * nN; G = G_; c = c_; }
    __host__ __device__ bool next(int i, Unit& u) const {
        const long L = (long)i * G + c; if (L >= nwg) return false;
        int wgid = (int)L; { const int q = nwg / NXCD, r = nwg % NXCD, xcd = wgid % NXCD, off = wgid / NXCD; wgid = (xcd < r ? xcd * (q + 1) : r * (q + 1) + (xcd - r) * q) + off; }
        const int nig = WGM * nN, gid = wgid / nig, fm = gid * WGM, gsz = (nM - fm) < WGM ? (nM - fm) : WGM;
        u.pm = fm + ((wgid % nig) % gsz); u.pn = (wgid % nig) / gsz; return true;
    }
    __device__ __forceinline__ void a_ready(const Unit&) const {}
    __device__ __forceinline__ void done(const Unit&) const {}
};
__device__ __forceinline__ unsigned cvt_pk_bf16(float lo, float hi) { unsigned r; asm volatile("v_cvt_pk_bf16_f32 %0, %1, %2" : "=v"(r) : "v"(lo), "v"(hi)); return r; }
template <class Epi, class Sched>
__device__ __forceinline__ void gemm_phase(PG8_LAS unsigned char* lds, const Gemm g, const Sched& S, const Epi& E) {
    const int tid = threadIdx.x, wid = __builtin_amdgcn_readfirstlane(tid >> 6), lane = tid & 63, wr = wid >> 2, wc = wid & 3, fr = lane & 15, fq = lane >> 4;
    const int K = g.K, nt = K / BK;
    unsigned voffA[2], voffB[2];
#pragma unroll
    for (int i = 0; i < 2; ++i) { int R, C; stage_rc(tid * 16 + i * 8192, R, C); const int Rb = Epi::PERM ? ((R & ~31) + perm32(R & 31)) : R;
        voffA[i] = (unsigned)(R * K + C) * 2u; voffB[i] = (unsigned)(Rb * K + C) * 2u; }
    const size_t kstep = (size_t)(BK * 2);
    const size_t hstep = (size_t)HALF * K * 2;
    const size_t tstep = 2 * hstep;
    const unsigned ldsw = (unsigned)wid * 1024u;
    const int aoff = lds_byte(wr * 64 + fr, fq * 8), boff = lds_byte(wc * 32 + fr, fq * 8);
#define PG8_SA(b, h) (((b) * 2 + (h)) * HTB)
#define PG8_SB(b, h) ((4 + (b) * 2 + (h)) * HTB)
#define PG8_STAGE(bufoff, gbase, voff) do { _Pragma("unroll") for (int _i = 0; _i < 2; ++_i) \
        __builtin_amdgcn_global_load_lds((const unsigned*)((const char*)(gbase) + (voff)[_i]), (PG8_LAS unsigned*)(lds + (bufoff) + ldsw + _i * 8192), 16, 0, 0); } while (0)
#define PG8_LDA(dst, b, h) do { _Pragma("unroll") for (int m = 0; m < 4; ++m) _Pragma("unroll") for (int k = 0; k < 2; ++k) dst[m][k] = *(const PG8_LAS bf16x8*)(lds + PG8_SA(b, h) + aoff + m * 2048 + k * 1024); } while (0)
#define PG8_LDB(dst, b, h) do { _Pragma("unroll") for (int n = 0; n < 2; ++n) _Pragma("unroll") for (int k = 0; k < 2; ++k) dst[n][k] = *(const PG8_LAS bf16x8*)(lds + PG8_SB(b, h) + boff + n * 2048 + k * 1024); } while (0)
#define PG8_MMA(ai, bj, At, Bt) do { __builtin_amdgcn_s_setprio(1); _Pragma("unroll") for (int m = 0; m < 4; ++m) _Pragma("unroll") for (int n = 0; n < 2; ++n) _Pragma("unroll") for (int k = 0; k < 2; ++k) \
        acc[ai][bj][m][n] = __builtin_amdgcn_mfma_f32_16x16x32_bf16(Bt[n][k], At[m][k], acc[ai][bj][m][n], 0, 0, 0); __builtin_amdgcn_s_setprio(0); } while (0)
#define PG8_WAIT_V(n) asm volatile("s_waitcnt vmcnt(" #n ")" ::: "memory")
#define PG8_WAIT_L(n) asm volatile("s_waitcnt lgkmcnt(" #n ")" ::: "memory")
#define PG8_BAR __builtin_amdgcn_s_barrier()
#define PG8_SCHED __builtin_amdgcn_sched_barrier(0)
    Unit cur, nxt; int ui = 0;
    if (!S.next(0, cur)) return;
    f32x4 acc[2][2][4][2];
#pragma unroll
    for (int a = 0; a < 2; ++a)
#pragma unroll
        for (int b = 0; b < 2; ++b)
#pragma unroll
            for (int m = 0; m < 4; ++m)
#pragma unroll
                for (int n = 0; n < 2; ++n) acc[a][b][m][n] = (f32x4){0.f, 0.f, 0.f, 0.f};
    bf16x8 At[4][2], B0[2][2], B1[2][2];
    const char* cA = (const char*)g.A + (size_t)cur.pm * tstep; const char* cB = (const char*)g.Bt + (size_t)cur.pn * tstep;
    S.a_ready(cur);
    PG8_STAGE(PG8_SB(0, 0), cB, voffB); PG8_STAGE(PG8_SA(0, 0), cA, voffA); PG8_STAGE(PG8_SB(0, 1), cB + hstep, voffB); PG8_STAGE(PG8_SA(0, 1), cA + hstep, voffA);
    if (wr == 1) PG8_BAR;
    PG8_WAIT_V(4); PG8_BAR;
    PG8_STAGE(PG8_SB(1, 0), cB + kstep, voffB); PG8_STAGE(PG8_SA(1, 0), cA + kstep, voffA); PG8_STAGE(PG8_SB(1, 1), cB + hstep + kstep, voffB);
    PG8_WAIT_V(6); PG8_BAR;
    for (;;) {
        const bool has_next = S.next(ui + 1, nxt);
        const char* nA = has_next ? (const char*)g.A + (size_t)nxt.pm * tstep : cA; const char* nB = has_next ? (const char*)g.Bt + (size_t)nxt.pn * tstep : cB;
        for (int t = 0; t < nt; t += 2) {
            const bool last = (t == nt - 2);
            const char* a1 = cA + (size_t)(t + 1) * kstep;
            const char* a2 = last ? nA : cA + (size_t)(t + 2) * kstep; const char* b2 = last ? nB : cB + (size_t)(t + 2) * kstep;
            const char* a3 = a2 + kstep; const char* b3 = b2 + kstep;
            if (last && has_next) S.a_ready(nxt);
            PG8_LDB(B0, 0, 0); PG8_SCHED; PG8_LDA(At, 0, 0); PG8_STAGE(PG8_SA(1, 1), a1 + hstep, voffA);
            PG8_WAIT_L(8); PG8_BAR; PG8_WAIT_L(0); PG8_MMA(0, 0, At, B0); PG8_BAR; PG8_SCHED;
            PG8_LDB(B1, 0, 1); PG8_STAGE(PG8_SB(0, 0), b2, voffB);
            PG8_BAR; PG8_WAIT_L(0); PG8_MMA(0, 1, At, B1); PG8_BAR;
            PG8_LDA(At, 0, 1); PG8_STAGE(PG8_SA(0, 0), a2, voffA);
            PG8_BAR; PG8_WAIT_L(0); PG8_MMA(1, 0, At, B0); PG8_BAR; PG8_SCHED;
            PG8_STAGE(PG8_SB(0, 1), b2 + hstep, voffB);
            PG8_WAIT_V(6); PG8_BAR; PG8_MMA(1, 1, At, B1); PG8_BAR;
            PG8_LDB(B0, 1, 0); PG8_SCHED; PG8_LDA(At, 1, 0); PG8_STAGE(PG8_SA(0, 1), a2 + hstep, voffA);
            PG8_WAIT_L(8); PG8_BAR; PG8_WAIT_L(0); PG8_MMA(0, 0, At, B0); PG8_BAR; PG8_SCHED;
            PG8_LDB(B1, 1, 1); PG8_STAGE(PG8_SB(1, 0), b3, voffB);
            PG8_BAR; PG8_WAIT_L(0); PG8_MMA(0, 1, At, B1); PG8_BAR;
            PG8_LDA(At, 1, 1); PG8_STAGE(PG8_SA(1, 0), a3, voffA);
            PG8_BAR; PG8_WAIT_L(0); PG8_MMA(1, 0, At, B0); PG8_BAR; PG8_SCHED;
            PG8_STAGE(PG8_SB(1, 1), b3 + hstep, voffB);
            PG8_WAIT_V(6); PG8_BAR; PG8_MMA(1, 1, At, B1); PG8_BAR;
        }
        if constexpr (!Epi::AFTER_DRAIN) { E(acc, cur, wr, wc, fr, fq); S.done(cur); }
        if (!has_next) break;
#pragma unroll
        for (int a = 0; a < 2; ++a)
#pragma unroll
            for (int b = 0; b < 2; ++b)
#pragma unroll
                for (int m = 0; m < 4; ++m)
#pragma unroll
                    for (int n = 0; n < 2; ++n) acc[a][b][m][n] = (f32x4){0.f, 0.f, 0.f, 0.f};
        cur = nxt; cA = nA; cB = nB; ++ui;
    }
    PG8_WAIT_V(0);
    if (wr == 0) PG8_BAR;
    PG8_BAR;
    if constexpr (Epi::AFTER_DRAIN) { E.fused(acc, cur, wr, wc, fr, fq, lds, wid, lane); S.done(cur); }
#undef PG8_SA
#undef PG8_SB
#undef PG8_STAGE
#undef PG8_LDA
#undef PG8_LDB
#undef PG8_MMA
#undef PG8_WAIT_V
#undef PG8_WAIT_L
#undef PG8_BAR
#undef PG8_SCHED
}
}

#ifndef PER_PHASE_LAUNCH
#define PER_PHASE_LAUNCH 0
#endif

#define LAS __attribute__((address_space(3)))
typedef unsigned short bf16_t;
typedef short bf16x8 __attribute__((ext_vector_type(8)));
typedef short s16x4 __attribute__((ext_vector_type(4)));
typedef float f32x4 __attribute__((ext_vector_type(4)));
typedef unsigned u32x4 __attribute__((ext_vector_type(4)));
typedef unsigned u32x2 __attribute__((ext_vector_type(2)));

constexpr int MTOK = 16384, DM = 2048, SEQ = 2048;
constexpr float EPS = 1e-6f;
constexpr size_t MiB = 1ull << 20;
constexpr size_t WS_RW = 0;
constexpr size_t WS_U = 50 * MiB;
constexpr size_t WS_BIG = 114 * MiB;
constexpr size_t WS_Z = 370 * MiB;
constexpr size_t WS_SM = 498 * MiB;
constexpr size_t WS_COS = WS_SM, WS_SIN = WS_SM + 2 * MiB, WS_GD = WS_SM + 4 * MiB, WS_BD = WS_SM + 6 * MiB;
constexpr size_t WS_SSQ = WS_SM + 8 * MiB;
constexpr size_t WS_LB = WS_SM + 9 * MiB;
constexpr size_t WS_END = WS_SM + 9 * MiB + 65536;
constexpr int LDS_BYTES = 131072;
constexpr int NPHASE = 19;

struct Params { const void* in[29]; float* out; unsigned char* ws; int ph_lo, ph_hi; };

__device__ __forceinline__ int fresh_tid() { int t = threadIdx.x; asm volatile("" : "+v"(t)); return t; }
__device__ __forceinline__ float bf2f(bf16_t v) { return __uint_as_float(((unsigned)v) << 16); }
__device__ __forceinline__ bf16_t f2bf(float f) { unsigned u = __float_as_uint(f); u += 0x7FFFu + ((u >> 16) & 1u); return (bf16_t)(u >> 16); }
__device__ __forceinline__ float siluf(float x) { return x / (1.f + __expf(-x)); }
__device__ __forceinline__ float sigmf(float x) { return 1.f / (1.f + __expf(-x)); }
__device__ __forceinline__ float wave_sum(float v) {
#pragma unroll
    for (int o = 32; o >= 1; o >>= 1) v += __shfl_xor(v, o);
    return v;
}
__device__ __forceinline__ u32x4 pack8(const f32x4 a, const f32x4 b) {
    u32x4 w; w.x = pg8::cvt_pk_bf16(a[0], a[1]); w.y = pg8::cvt_pk_bf16(a[2], a[3]); w.z = pg8::cvt_pk_bf16(b[0], b[1]); w.w = pg8::cvt_pk_bf16(b[2], b[3]); return w;
}

enum { MAP_ID = 0, MAP_MLAIN = 1, MAP_UQ = 2 };
__device__ __forceinline__ int map_src(int mode, int n, int nsrc) {
    if (mode == MAP_MLAIN) { if (n < 1024) return n; if (n < 3072) return n + 64; if (n < 3136) { const int j = n - 3072; return 1024 + (j >> 1) + 32 * (j & 1); } return -1; }
    if (mode == MAP_UQ) { const int hd = n / 192, c = n - hd * 192; if (c < 128) return n; const int j = c - 128; return hd * 192 + 128 + (j >> 1) + 32 * (j & 1); }
    return n < nsrc ? n : -1;
}
__device__ __forceinline__ void convert_w(float* tile, const float* W, int K, int Nsrc, bf16_t* Bt, int Ndst, int mode, const float* rowscale, float cscale, int bi, int nb) {
    const int tid = fresh_tid();
    const int tk = K / 64, tn = Ndst / 64;
    for (int t = bi; t < tk * tn; t += nb) {
        const int n0 = (t / tk) * 64, k0 = (t % tk) * 64;
        __syncthreads();
        {
            const int j = tid & 63, i0 = tid >> 6; const int sc = map_src(mode, n0 + j, Nsrc);
#pragma unroll
            for (int it = 0; it < 8; ++it) {
                const int k = k0 + i0 + 8 * it; float v = 0.f;
                if (sc >= 0) { v = W[(size_t)k * Nsrc + sc] * cscale; if (rowscale) v *= rowscale[k]; }
                tile[(i0 + 8 * it) * 65 + j] = v;
            }
        }
        __syncthreads();
        {
            const int n = tid >> 3, kk = (tid & 7) * 8; u32x4 w;
            w.x = pg8::cvt_pk_bf16(tile[(kk + 0) * 65 + n], tile[(kk + 1) * 65 + n]);
            w.y = pg8::cvt_pk_bf16(tile[(kk + 2) * 65 + n], tile[(kk + 3) * 65 + n]);
            w.z = pg8::cvt_pk_bf16(tile[(kk + 4) * 65 + n], tile[(kk + 5) * 65 + n]);
            w.w = pg8::cvt_pk_bf16(tile[(kk + 6) * 65 + n], tile[(kk + 7) * 65 + n]);
            *(u32x4*)(Bt + (size_t)(n0 + n) * K + k0 + kk) = w;
        }
    }
    __syncthreads();
}

__device__ __forceinline__ void row_phase(const float* hsrc, const float* Y, const float* postw, const float* prew, float* hout, bf16_t* U) {
    const int tid_ = fresh_tid(); const int lane = tid_ & 63, gw = blockIdx.x * 8 + (tid_ >> 6), nw = gridDim.x * 8;
    for (int row = gw; row < MTOK; row += nw) {
        f32x4 h[8]; const float* hp = hsrc + (size_t)row * DM + lane * 4;
#pragma unroll
        for (int i = 0; i < 8; ++i) h[i] = *(const f32x4*)(hp + 256 * i);
        if (Y) {
            f32x4 y[8]; const float* yp = Y + (size_t)row * DM + lane * 4; float ss = 0.f;
#pragma unroll
            for (int i = 0; i < 8; ++i) { y[i] = *(const f32x4*)(yp + 256 * i); ss += y[i][0] * y[i][0] + y[i][1] * y[i][1] + y[i][2] * y[i][2] + y[i][3] * y[i][3]; }
            ss = wave_sum(ss); const float ry = rsqrtf(ss * (1.f / 2048.f) + EPS);
            float* op = hout + (size_t)row * DM + lane * 4;
#pragma unroll
            for (int i = 0; i < 8; ++i) { const f32x4 pw = *(const f32x4*)(postw + lane * 4 + 256 * i); h[i] += y[i] * ry * pw; *(f32x4*)(op + 256 * i) = h[i]; }
        }
        if (prew) {
            float ss = 0.f;
#pragma unroll
            for (int i = 0; i < 8; ++i) ss += h[i][0] * h[i][0] + h[i][1] * h[i][1] + h[i][2] * h[i][2] + h[i][3] * h[i][3];
            ss = wave_sum(ss); const float r = rsqrtf(ss * (1.f / 2048.f) + EPS);
            bf16_t* up = U + (size_t)row * DM + lane * 4;
#pragma unroll
            for (int i = 0; i < 8; ++i) { const f32x4 pw = *(const f32x4*)(prew + lane * 4 + 256 * i); const f32x4 u = h[i] * r * pw;
                u32x2 w; w.x = pg8::cvt_pk_bf16(u[0], u[1]); w.y = pg8::cvt_pk_bf16(u[2], u[3]); *(u32x2*)(up + 256 * i) = w; }
        }
    }
}

enum { EM_HG = 0, EM_MLAIN = 1, EM_Q = 2, EM_KV = 3, EM_GDN = 4, EM_OUT = 5 };
struct Epi {
    static constexpr bool PERM = true, AFTER_DRAIN = false;
    int mode;
    unsigned char* ws;
    const float* lb;
    const float* alog; const float* dtb;
    __device__ __forceinline__ void operator()(const f32x4 (&acc)[2][2][4][2], const pg8::Unit& u, int wr, int wc, int fr, int fq) const {
        asm volatile("" : "+v"(fr), "+v"(fq));
        const int rowb = u.pm * 256 + wr * 64 + fr, colw = wc * 32 + 8 * fq;
#define EPI_LOOP for (int ai = 0; ai < 2; ++ai) for (int m = 0; m < 4; ++m) { const int row = rowb + ai * 128 + m * 16; (void)row; for (int bj = 0; bj < 2; ++bj) { const int col = colw + bj * 128; (void)col; f32x4 v0 = acc[ai][bj][m][0], v1 = acc[ai][bj][m][1];
#define EPI_END } }
        if (mode == EM_OUT) {
            float* Y = (float*)(ws + WS_BIG);
#pragma unroll
            EPI_LOOP float* p = Y + (size_t)row * 2048 + u.pn * 256 + col; *(f32x4*)p = v0; *(f32x4*)(p + 4) = v1; EPI_END
        } else if (mode == EM_KV) {
            bf16_t* KV = (bf16_t*)(ws + WS_BIG + 96 * MiB); const float* ssq = (const float*)(ws + WS_SSQ) + (size_t)MTOK * 8;
#pragma unroll
            for (int ai = 0; ai < 2; ++ai)
#pragma unroll
                for (int m = 0; m < 4; ++m) { const int row = rowb + ai * 128 + m * 16; const f32x4 p0 = *(const f32x4*)(ssq + (size_t)row * 8), p1 = *(const f32x4*)(ssq + (size_t)row * 8 + 4); const float r = rsqrtf((((p0[0] + p0[1]) + (p0[2] + p0[3])) + ((p1[0] + p1[1]) + (p1[2] + p1[3]))) * (1.f / 512.f) + EPS);
#pragma unroll
                    for (int bj = 0; bj < 2; ++bj) { const int col = colw + bj * 128; *(u32x4*)(KV + (size_t)row * 4096 + u.pn * 256 + col) = pack8(acc[ai][bj][m][0] * r, acc[ai][bj][m][1] * r); } }
        } else if (mode == EM_Q) {
            bf16_t* Q = (bf16_t*)(ws + WS_BIG); const float* ssq = (const float*)(ws + WS_SSQ);
            const float* COS = (const float*)(ws + WS_COS); const float* SIN = (const float*)(ws + WS_SIN);
#pragma unroll
            for (int ai = 0; ai < 2; ++ai)
#pragma unroll
                for (int m = 0; m < 4; ++m) { const int row = rowb + ai * 128 + m * 16; const f32x4 p0 = *(const f32x4*)(ssq + (size_t)row * 8), p1 = *(const f32x4*)(ssq + (size_t)row * 8 + 4); const float r = rsqrtf((((p0[0] + p0[1]) + (p0[2] + p0[3])) + ((p1[0] + p1[1]) + (p1[2] + p1[3]))) * (1.f / 512.f) + EPS);
#pragma unroll
                    for (int bj = 0; bj < 2; ++bj) { const int c = u.pn * 256 + colw + bj * 128; const int within = c % 192;
                        f32x4 v0 = acc[ai][bj][m][0] * r, v1 = acc[ai][bj][m][1] * r;
                        if (within >= 128) { const int j0 = (within - 128) >> 1; const f32x4 cs = *(const f32x4*)(COS + (size_t)row * 32 + j0), sn = *(const f32x4*)(SIN + (size_t)row * 32 + j0);
                            const f32x4 a = (f32x4){v0[0], v0[2], v1[0], v1[2]}, b = (f32x4){v0[1], v0[3], v1[1], v1[3]};
                            const f32x4 ra = a * cs - b * sn, rb = b * cs + a * sn;
                            v0 = (f32x4){ra[0], rb[0], ra[1], rb[1]}; v1 = (f32x4){ra[2], rb[2], ra[3], rb[3]}; }
                        *(u32x4*)(Q + (size_t)row * 3072 + c) = pack8(v0, v1); } }
        } else if (mode == EM_MLAIN) {
            if (u.pn < 4) {
                bf16_t* C = (bf16_t*)(ws + WS_Z + (u.pn < 2 ? 64 : 80) * MiB); float* ssq = (float*)(ws + WS_SSQ) + (u.pn < 2 ? (size_t)0 : (size_t)MTOK * 8); const int cb = (u.pn & 1) * 256;
#pragma unroll
                for (int ai = 0; ai < 2; ++ai)
#pragma unroll
                    for (int m = 0; m < 4; ++m) { const int row = rowb + ai * 128 + m * 16; float s = 0.f;
#pragma unroll
                        for (int bj = 0; bj < 2; ++bj) { const int col = colw + bj * 128; const f32x4 v0 = acc[ai][bj][m][0], v1 = acc[ai][bj][m][1];
                            s += v0[0] * v0[0] + v0[1] * v0[1] + v0[2] * v0[2] + v0[3] * v0[3] + v1[0] * v1[0] + v1[1] * v1[1] + v1[2] * v1[2] + v1[3] * v1[3];
                            *(u32x4*)(C + (size_t)row * 512 + cb + col) = pack8(v0, v1); }
                        s += __shfl_xor(s, 16); s += __shfl_xor(s, 32);
                        if (fq == 0) ssq[(size_t)row * 8 + (u.pn & 1) * 4 + wc] = s; }
            } else if (u.pn < 12) {
                bf16_t* Zs = (bf16_t*)(ws + WS_Z); const int cb = (u.pn - 4) * 256;
#pragma unroll
                EPI_LOOP
                    for (int e = 0; e < 4; ++e) { v0[e] = siluf(v0[e]); v1[e] = siluf(v1[e]); }
                    *(u32x4*)(Zs + (size_t)row * 2048 + cb + col) = pack8(v0, v1);
                EPI_END
            } else {
                if (colw < 64) {
                    bf16_t* KR = (bf16_t*)(ws + WS_Z + 96 * MiB); const float* COS = (const float*)(ws + WS_COS); const float* SIN = (const float*)(ws + WS_SIN);
#pragma unroll
                    for (int ai = 0; ai < 2; ++ai)
#pragma unroll
                        for (int m = 0; m < 4; ++m) { const int row = rowb + ai * 128 + m * 16; const int j0 = colw >> 1;
                            const f32x4 v0 = acc[ai][0][m][0], v1 = acc[ai][0][m][1];
                            const f32x4 cs = *(const f32x4*)(COS + (size_t)row * 32 + j0), sn = *(const f32x4*)(SIN + (size_t)row * 32 + j0);
                            const f32x4 a = (f32x4){v0[0], v0[2], v1[0], v1[2]}, b = (f32x4){v0[1], v0[3], v1[1], v1[3]};
                            const f32x4 ra = a * cs - b * sn, rb = b * cs + a * sn;
                            *(u32x4*)(KR + (size_t)row * 64 + colw) = pack8((f32x4){ra[0], rb[0], ra[1], rb[1]}, (f32x4){ra[2], rb[2], ra[3], rb[3]}); }
                }
            }
        } else if (mode == EM_HG) {
            const int region = u.pn >> 3, cb = (u.pn & 7) * 256;
            if (region == 0) {
                bf16_t* Q = (bf16_t*)(ws + WS_BIG);
#pragma unroll
                EPI_LOOP
                    for (int e = 0; e < 4; ++e) { v0[e] = siluf(v0[e]) * 0.08838834764831845f; v1[e] = siluf(v1[e]) * 0.08838834764831845f; }
                    *(u32x4*)(Q + (size_t)row * 2048 + cb + col) = pack8(v0, v1);
                EPI_END
            } else if (region == 1) {
                bf16_t* Kk = (bf16_t*)(ws + WS_BIG + 64 * MiB); float* G = (float*)(ws + WS_BIG + 128 * MiB);
#pragma unroll
                for (int bj = 0; bj < 2; ++bj) { const int col = colw + bj * 128; const f32x4 l0 = *(const f32x4*)(lb + cb + col), l1 = *(const f32x4*)(lb + cb + col + 4);
#pragma unroll
                    for (int ai = 0; ai < 2; ++ai)
#pragma unroll
                        for (int m = 0; m < 4; ++m) { const int row = rowb + ai * 128 + m * 16; const f32x4 v0 = acc[ai][bj][m][0], v1 = acc[ai][bj][m][1]; f32x4 g0, g1, k0, k1;
#pragma unroll
                            for (int e = 0; e < 4; ++e) {
                                { const float f = v0[e], l = l0[e], en = __expf(-fabsf(f)), ls = fminf(f, 0.f) - __logf(1.f + en), sg = __expf(ls);
                                  g0[e] = (l == 0.f) ? ls : __logf(l + (1.f - l) * sg); k0[e] = (1.f - l) * (1.f - sg); }
                                { const float f = v1[e], l = l1[e], en = __expf(-fabsf(f)), ls = fminf(f, 0.f) - __logf(1.f + en), sg = __expf(ls);
                                  g1[e] = (l == 0.f) ? ls : __logf(l + (1.f - l) * sg); k1[e] = (1.f - l) * (1.f - sg); } }
                            float* gp = G + (size_t)row * 2048 + cb + col; *(f32x4*)gp = g0; *(f32x4*)(gp + 4) = g1;
                            *(u32x4*)(Kk + (size_t)row * 2048 + cb + col) = pack8(k0, k1); } }
            } else if (region == 2) {
                bf16_t* V = (bf16_t*)(ws + WS_Z);
#pragma unroll
                EPI_LOOP *(u32x4*)(V + (size_t)row * 2048 + cb + col) = pack8(v0, v1); EPI_END
            } else {
                bf16_t* Zs = (bf16_t*)(ws + WS_Z + 64 * MiB);
#pragma unroll
                EPI_LOOP
                    for (int e = 0; e < 4; ++e) { v0[e] = siluf(v0[e]); v1[e] = siluf(v1[e]); }
                    *(u32x4*)(Zs + (size_t)row * 2048 + cb + col) = pack8(v0, v1);
                EPI_END
            }
        } else {
            if (u.pn < 32) {
                bf16_t* QKV = (bf16_t*)(ws + WS_BIG);
#pragma unroll
                EPI_LOOP *(u32x4*)(QKV + (size_t)row * 8192 + u.pn * 256 + col) = pack8(v0, v1); EPI_END
            } else if (u.pn < 48) {
                bf16_t* Zs = (bf16_t*)(ws + WS_Z); const int cb = (u.pn - 32) * 256;
#pragma unroll
                EPI_LOOP
                    for (int e = 0; e < 4; ++e) { v0[e] = siluf(v0[e]); v1[e] = siluf(v1[e]); }
                    *(u32x4*)(Zs + (size_t)row * 4096 + cb + col) = pack8(v0, v1);
                EPI_END
            } else {
                if (colw < 64) {
                    float* GD = (float*)(ws + WS_GD); float* BD = (float*)(ws + WS_BD);
#pragma unroll
                    for (int ai = 0; ai < 2; ++ai)
#pragma unroll
                        for (int m = 0; m < 4; ++m) { const int row = rowb + ai * 128 + m * 16; f32x4 v0 = acc[ai][0][m][0], v1 = acc[ai][0][m][1];
                            if (colw < 32) {
                                const f32x4 a0 = *(const f32x4*)(alog + colw), a1 = *(const f32x4*)(alog + colw + 4), d0 = *(const f32x4*)(dtb + colw), d1 = *(const f32x4*)(dtb + colw + 4);
#pragma unroll
                                for (int e = 0; e < 4; ++e) {
                                    { const float x = v0[e] + d0[e]; const float sp = fmaxf(x, 0.f) + __logf(1.f + __expf(-fabsf(x))); v0[e] = -__expf(a0[e]) * sp; }
                                    { const float x = v1[e] + d1[e]; const float sp = fmaxf(x, 0.f) + __logf(1.f + __expf(-fabsf(x))); v1[e] = -__expf(a1[e]) * sp; } }
                                float* p = GD + (size_t)row * 32 + colw; *(f32x4*)p = v0; *(f32x4*)(p + 4) = v1;
                            } else {
#pragma unroll
                                for (int e = 0; e < 4; ++e) { v0[e] = sigmf(v0[e]); v1[e] = sigmf(v1[e]); }
                                float* p = BD + (size_t)row * 32 + (colw - 32); *(f32x4*)p = v0; *(f32x4*)(p + 4) = v1;
                            } }
                }
            }
        }
#undef EPI_LOOP
#undef EPI_END
    }
};

__device__ __forceinline__ void run_gemm(LAS unsigned char* lds, const bf16_t* A, const bf16_t* Bt, int N, int K, const Epi E) {
    pg8::Gemm g{A, Bt, MTOK, N, K}; pg8::StaticOrder S; S.init(MTOK, N, (int)gridDim.x, (int)blockIdx.x);
    pg8::gemm_phase<Epi, pg8::StaticOrder>(lds, g, S, E);
    __syncthreads();
}

__device__ __forceinline__ s16x4 tr_read(const bf16_t* p) {
    typedef short v4i16_t __attribute__((ext_vector_type(4)));
    return __builtin_bit_cast(s16x4, __builtin_amdgcn_ds_read_tr16_b64_v4i16((LAS v4i16_t*)p));
}
__device__ __forceinline__ bf16x8 frag_tr(const bf16_t* base, int stride, int k0, int c0, int fr, int fq) {
    const bf16_t* p = base + (k0 + 8 * fq + (fr >> 2)) * stride + c0 + 4 * (fr & 3);
    const s16x4 r0 = tr_read(p), r1 = tr_read(p + 4 * stride);
    return (bf16x8){r0[0], r0[1], r0[2], r0[3], r1[0], r1[1], r1[2], r1[3]};
}
__device__ __forceinline__ bf16x8 frag_row(const bf16_t* base, int stride, int r0, int k0, int fr, int fq) { return *(const bf16x8*)(base + (r0 + fr) * stride + k0 + 8 * fq); }

__device__ __forceinline__ void gla_chunked(unsigned char* lds, unsigned char* ws, const float* hn) {
    if (blockIdx.x >= 128) return;
    const int tid = fresh_tid(), lane = tid & 63, w = __builtin_amdgcn_readfirstlane(tid >> 6), fr = lane & 15, fq = lane >> 4;
    const int b = blockIdx.x >> 4, h = blockIdx.x & 15;
    const bf16_t* Q = (const bf16_t*)(ws + WS_BIG); const bf16_t* Kk = (const bf16_t*)(ws + WS_BIG + 64 * MiB); const float* G = (const float*)(ws + WS_BIG + 128 * MiB);
    const bf16_t* V = (const bf16_t*)(ws + WS_Z); bf16_t* Zs = (bf16_t*)(ws + WS_Z + 64 * MiB);
    bf16_t* QD = (bf16_t*)lds; bf16_t* KD = (bf16_t*)(lds + 17408); bf16_t* VV = (bf16_t*)(lds + 35840); bf16_t* PP = (bf16_t*)(lds + 54272);
    bf16_t* SB = (bf16_t*)(lds + 63488); float* OT = (float*)(lds + 63488); float* TOT = (float*)(lds + 100352);
    const int c = tid & 127, part = tid >> 7;
    f32x4 S[8];
#pragma unroll
    for (int i = 0; i < 8; ++i) S[i] = (f32x4){0.f, 0.f, 0.f, 0.f};
    for (int ch = 0; ch < 32; ++ch) {
        const int trow0 = b * SEQ + ch * 64;
        float g[16], qv[16], kv[16];
#pragma unroll
        for (int i = 0; i < 16; ++i) { const size_t gi = (size_t)(trow0 + 16 * part + i) * 2048 + h * 128 + c; g[i] = G[gi]; qv[i] = bf2f(Q[gi]); kv[i] = bf2f(Kk[gi]); }
#pragma unroll
        for (int i = 1; i < 16; ++i) g[i] += g[i - 1];
        TOT[part * 128 + c] = g[15];
#pragma unroll
        for (int i = 0; i < 2; ++i) { const int idx = tid + 512 * i, r = idx >> 4, cc = idx & 15; *(u32x4*)(VV + r * 144 + cc * 8) = *(const u32x4*)(V + (size_t)(trow0 + r) * 2048 + h * 128 + cc * 8); }
        __syncthreads();
        {
            const float t0 = TOT[c], t1 = TOT[128 + c], t2 = TOT[256 + c];
            const float off = (part > 0 ? t0 : 0.f) + (part > 1 ? t1 : 0.f) + (part > 2 ? t2 : 0.f), bref = t0 + t1;
#pragma unroll
            for (int i = 0; i < 16; ++i) { const float bt = g[i] + off;
                QD[(16 * part + i) * 136 + c] = f2bf(qv[i] * __expf(fminf(bt - bref, 80.f))); KD[(16 * part + i) * 144 + c] = f2bf(kv[i] * __expf(fminf(bref - bt, 80.f))); }
#pragma unroll
            for (int j = 0; j < 4; ++j) { const int kk = 16 * w + 4 * fq + j; const float er = __expf(TOT[kk] + TOT[128 + kk]);
#pragma unroll
                for (int vt = 0; vt < 8; ++vt) SB[kk * 144 + 16 * vt + fr] = f2bf(S[vt][j] * er); }
        }
        __syncthreads();
        {
            const int tt = w >> 1;
#pragma unroll
            for (int x = 0; x < 2; ++x) { const int st = (w & 1) * 2 + x; f32x4 acc = (f32x4){0.f, 0.f, 0.f, 0.f};
                if (st <= tt) {
#pragma unroll
                    for (int ks = 0; ks < 4; ++ks) acc = __builtin_amdgcn_mfma_f32_16x16x32_bf16(frag_row(QD, 136, 16 * tt, 32 * ks, fr, fq), frag_row(KD, 144, 16 * st, 32 * ks, fr, fq), acc, 0, 0, 0);
                }
#pragma unroll
                for (int j = 0; j < 4; ++j) { const int t = 16 * tt + 4 * fq + j, sx = 16 * st + fr; PP[t * 72 + sx] = (st <= tt && sx <= t) ? f2bf(acc[j]) : (bf16_t)0; } }
        }
        __syncthreads();
        f32x4 oacc[4];
        {
            const int tt = w >> 1;
#pragma unroll
            for (int x = 0; x < 4; ++x) { const int vt = (w & 1) * 4 + x; f32x4 acc = (f32x4){0.f, 0.f, 0.f, 0.f};
#pragma unroll
                for (int ks = 0; ks < 2; ++ks) acc = __builtin_amdgcn_mfma_f32_16x16x32_bf16(frag_row(PP, 72, 16 * tt, 32 * ks, fr, fq), frag_tr(VV, 144, 32 * ks, 16 * vt, fr, fq), acc, 0, 0, 0);
#pragma unroll
                for (int ks = 0; ks < 4; ++ks) acc = __builtin_amdgcn_mfma_f32_16x16x32_bf16(frag_row(QD, 136, 16 * tt, 32 * ks, fr, fq), frag_tr(SB, 144, 32 * ks, 16 * vt, fr, fq), acc, 0, 0, 0);
                oacc[x] = acc; }
            float el[4], e2[4];
#pragma unroll
            for (int j = 0; j < 4; ++j) { const int kk = 16 * w + 4 * fq + j; const float hi = TOT[256 + kk] + TOT[384 + kk]; e2[j] = __expf(hi); el[j] = __expf(TOT[kk] + TOT[128 + kk] + hi); }
            const bf16x8 ka0 = frag_tr(KD, 144, 0, 16 * w, fr, fq), ka1 = frag_tr(KD, 144, 32, 16 * w, fr, fq);
#pragma unroll
            for (int vt = 0; vt < 8; ++vt) { f32x4 a2 = (f32x4){0.f, 0.f, 0.f, 0.f};
                a2 = __builtin_amdgcn_mfma_f32_16x16x32_bf16(ka0, frag_tr(VV, 144, 0, 16 * vt, fr, fq), a2, 0, 0, 0);
                a2 = __builtin_amdgcn_mfma_f32_16x16x32_bf16(ka1, frag_tr(VV, 144, 32, 16 * vt, fr, fq), a2, 0, 0, 0);
#pragma unroll
                for (int j = 0; j < 4; ++j) S[vt][j] = el[j] * S[vt][j] + e2[j] * a2[j]; }
        }
        __syncthreads();
        {
            const int tt = w >> 1;
#pragma unroll
            for (int x = 0; x < 4; ++x) { const int vt = (w & 1) * 4 + x;
#pragma unroll
                for (int j = 0; j < 4; ++j) OT[(16 * tt + 4 * fq + j) * 132 + 16 * vt + fr] = oacc[x][j]; }
        }
        __syncthreads();
        {
            const int r = tid >> 3, seg = tid & 7; const float* op = OT + r * 132 + seg * 16;
            f32x4 v[4]; float ss = 0.f;
#pragma unroll
            for (int i = 0; i < 4; ++i) { v[i] = *(const f32x4*)(op + 4 * i); ss += v[i][0] * v[i][0] + v[i][1] * v[i][1] + v[i][2] * v[i][2] + v[i][3] * v[i][3]; }
            ss += __shfl_xor(ss, 1); ss += __shfl_xor(ss, 2); ss += __shfl_xor(ss, 4);
            const float rn = rsqrtf(ss * (1.f / 128.f) + EPS);
            bf16_t* zp = Zs + (size_t)(trow0 + r) * 2048 + h * 128 + seg * 16;
#pragma unroll
            for (int i = 0; i < 2; ++i) { const u32x4 zz = *(const u32x4*)(zp + 8 * i); const f32x4 h0 = *(const f32x4*)(hn + seg * 16 + 8 * i), h1 = *(const f32x4*)(hn + seg * 16 + 8 * i + 4);
                f32x4 o0 = v[2 * i] * rn * h0, o1 = v[2 * i + 1] * rn * h1;
                o0[0] *= __uint_as_float(zz.x << 16); o0[1] *= __uint_as_float(zz.x & 0xffff0000u); o0[2] *= __uint_as_float(zz.y << 16); o0[3] *= __uint_as_float(zz.y & 0xffff0000u);
                o1[0] *= __uint_as_float(zz.z << 16); o1[1] *= __uint_as_float(zz.z & 0xffff0000u); o1[2] *= __uint_as_float(zz.w << 16); o1[3] *= __uint_as_float(zz.w & 0xffff0000u);
                *(u32x4*)(zp + 8 * i) = pack8(o0, o1); }
        }
    }
}

__device__ __forceinline__ void gdn_naive(float* L, unsigned char* ws, const float* cw, const float* hn) {
    const int tid = fresh_tid(), lane = tid & 63, wv = tid >> 6;
    const bf16_t* QKV = (const bf16_t*)(ws + WS_BIG); bf16_t* Zs = (bf16_t*)(ws + WS_Z); const float* GD = (const float*)(ws + WS_GD); const float* BD = (const float*)(ws + WS_BD);
    float* sq = L; float* sk = L + 2048; float* sv = L + 4096; float* so = L + 6144; float* sa = L + 8192; float* sb = L + 8192 + 16;
    for (int item = blockIdx.x; item < 256; item += gridDim.x) {
        const int b = item >> 5, vh = item & 31, hq = vh >> 1;
        float S[128];
#pragma unroll
        for (int k = 0; k < 128; ++k) S[k] = 0.f;
        for (int t0 = 0; t0 < SEQ; t0 += 16) {
            __syncthreads();
            for (int i = 0; i < 12; ++i) { const int e = tid + 512 * i, arr = e >> 11, r = e & 2047, tt = r >> 7, c = r & 127;
                const int ch = (arr == 0 ? hq * 128 : (arr == 1 ? 2048 + hq * 128 : 4096 + vh * 128)) + c; const int t = t0 + tt; float a = 0.f;
#pragma unroll
                for (int j = 0; j < 4; ++j) { const int ts = t - 3 + j; if (ts >= 0) a += cw[j * 8192 + ch] * bf2f(QKV[(size_t)(b * SEQ + ts) * 8192 + ch]); }
                L[e] = siluf(a); }
            if (tid < 16) { sa[tid] = __expf(GD[(size_t)(b * SEQ + t0 + tid) * 32 + vh]); sb[tid] = BD[(size_t)(b * SEQ + t0 + tid) * 32 + vh]; }
            __syncthreads();
#pragma unroll
            for (int r = 0; r < 4; ++r) { const int rr = wv * 4 + r; float* p = L + rr * 128; const float x0 = p[lane], x1 = p[64 + lane];
                const float ss = wave_sum(x0 * x0 + x1 * x1); const float rn = rsqrtf(ss + EPS) * (rr < 16 ? 0.08838834764831845f : 1.f);
                p[lane] = x0 * rn; p[64 + lane] = x1 * rn; }
            __syncthreads();
            if (tid < 128) {
                for (int tt = 0; tt < 16; ++tt) {
                    const float a = sa[tt], bt = sb[tt], vv = sv[tt * 128 + tid];
                    const float* pq = sq + tt * 128; const float* pk = sk + tt * 128;
                    float pred = 0.f;
#pragma unroll
                    for (int k = 0; k < 128; ++k) pred += pk[k] * S[k];
                    asm volatile("" ::: "memory");
                    const float d = bt * (vv - a * pred); float o = 0.f;
#pragma unroll
                    for (int k = 0; k < 128; ++k) { S[k] = a * S[k] + pk[k] * d; o += pq[k] * S[k]; }
                    so[tt * 128 + tid] = o;
                }
            }
            __syncthreads();
#pragma unroll
            for (int r = 0; r < 2; ++r) { const int tt = wv * 2 + r; const float x0 = so[tt * 128 + lane], x1 = so[tt * 128 + 64 + lane];
                const float ss = wave_sum(x0 * x0 + x1 * x1); const float rn = rsqrtf(ss * (1.f / 128.f) + EPS);
                const size_t gi = (size_t)(b * SEQ + t0 + tt) * 4096 + vh * 128;
                Zs[gi + lane] = f2bf(x0 * rn * hn[lane] * bf2f(Zs[gi + lane])); Zs[gi + 64 + lane] = f2bf(x1 * rn * hn[64 + lane] * bf2f(Zs[gi + 64 + lane])); }
        }
    }
}

constexpr int KS_STRIDE = 200, VS_STRIDE = 144;
__device__ __forceinline__ void attn_tile(bf16_t* Ks, bf16_t* Vs, unsigned char* ws, int b, int h, int qt) {
    const int tid = fresh_tid(), lane = tid & 63, wv = __builtin_amdgcn_readfirstlane(tid >> 6), fr = lane & 15, fq = lane >> 4;
    const bf16_t* Q = (const bf16_t*)(ws + WS_BIG); const bf16_t* KV = (const bf16_t*)(ws + WS_BIG + 96 * MiB); const bf16_t* KR = (const bf16_t*)(ws + WS_Z + 96 * MiB);
    bf16_t* Zs = (bf16_t*)(ws + WS_Z);
    const int row = b * SEQ + qt * 128 + wv * 16 + fr;
    bf16x8 qf[6];
#pragma unroll
    for (int s = 0; s < 6; ++s) qf[s] = *(const bf16x8*)(Q + (size_t)row * 3072 + h * 192 + 32 * s + 8 * fq);
    f32x4 acc[8];
#pragma unroll
    for (int i = 0; i < 8; ++i) acc[i] = (f32x4){0.f, 0.f, 0.f, 0.f};
    float mrun = -INFINITY, lsum = 0.f;
    const int ntiles = 2 * qt + 2, myn = (wv < 4) ? 2 * qt + 1 : 2 * qt + 2;
    for (int kt = 0; kt < ntiles; ++kt) {
        __syncthreads();
        {
            const size_t krow0 = (size_t)(b * SEQ + kt * 64);
#pragma unroll
            for (int i = 0; i < 2; ++i) { const int ch = tid + 512 * i, r = ch >> 4, cc = ch & 15;
                *(u32x4*)(Ks + r * KS_STRIDE + cc * 8) = *(const u32x4*)(KV + (krow0 + r) * 4096 + h * 256 + cc * 8);
                *(u32x4*)(Vs + r * VS_STRIDE + cc * 8) = *(const u32x4*)(KV + (krow0 + r) * 4096 + h * 256 + 128 + cc * 8); }
            { const int r = tid >> 3, cc = tid & 7; *(u32x4*)(Ks + r * KS_STRIDE + 128 + cc * 8) = *(const u32x4*)(KR + (krow0 + r) * 64 + cc * 8); }
        }
        __syncthreads();
        if (kt < myn) {
            f32x4 s[4];
#pragma unroll
            for (int nt = 0; nt < 4; ++nt) { s[nt] = (f32x4){0.f, 0.f, 0.f, 0.f};
#pragma unroll
                for (int st = 0; st < 6; ++st) { const bf16x8 kf = *(const bf16x8*)(Ks + (16 * nt + fr) * KS_STRIDE + 32 * st + 8 * fq);
                    s[nt] = __builtin_amdgcn_mfma_f32_16x16x32_bf16(kf, qf[st], s[nt], 0, 0, 0); } }
            float mx = s[0][0];
#pragma unroll
            for (int nt = 0; nt < 4; ++nt)
#pragma unroll
                for (int j = 0; j < 4; ++j) mx = fmaxf(mx, s[nt][j]);
            mx = fmaxf(mx, __shfl_xor(mx, 16)); mx = fmaxf(mx, __shfl_xor(mx, 32));
            const float mnew = fmaxf(mrun, mx), alpha = __expf(mrun - mnew); mrun = mnew;
            float ps = 0.f;
#pragma unroll
            for (int nt = 0; nt < 4; ++nt)
#pragma unroll
                for (int j = 0; j < 4; ++j) { s[nt][j] = __expf(s[nt][j] - mnew); ps += s[nt][j]; }
            lsum = lsum * alpha + ps;
#pragma unroll
            for (int i = 0; i < 8; ++i) acc[i] *= alpha;
            bf16x8 pf[2];
#pragma unroll
            for (int s2 = 0; s2 < 2; ++s2) { const u32x4 w = pack8(s[2 * s2], s[2 * s2 + 1]); pf[s2] = __builtin_bit_cast(bf16x8, w); }
            const int tq = fr >> 2, tp = fr & 3;
#pragma unroll
            for (int vt = 0; vt < 8; ++vt)
#pragma unroll
                for (int s2 = 0; s2 < 2; ++s2) { const bf16_t* vp = Vs + (32 * s2 + 4 * fq + tq) * VS_STRIDE + 16 * vt + 4 * tp;
                    const s16x4 r0 = tr_read(vp), r1 = tr_read(vp + 16 * VS_STRIDE);
                    const bf16x8 vf = (bf16x8){r0[0], r0[1], r0[2], r0[3], r1[0], r1[1], r1[2], r1[3]};
                    acc[vt] = __builtin_amdgcn_mfma_f32_16x16x32_bf16(vf, pf[s2], acc[vt], 0, 0, 0); }
        }
    }
    lsum += __shfl_xor(lsum, 16); lsum += __shfl_xor(lsum, 32);
    const float inv = 1.f / lsum;
#pragma unroll
    for (int vt = 0; vt < 8; ++vt) { bf16_t* zp = Zs + (size_t)row * 2048 + h * 128 + 16 * vt + 4 * fq; const u32x2 zz = *(const u32x2*)zp;
        const float z0 = __uint_as_float(zz.x << 16), z1 = __uint_as_float(zz.x & 0xffff0000u), z2 = __uint_as_float(zz.y << 16), z3 = __uint_as_float(zz.y & 0xffff0000u);
        u32x2 w; w.x = pg8::cvt_pk_bf16(acc[vt][0] * inv * z0, acc[vt][1] * inv * z1); w.y = pg8::cvt_pk_bf16(acc[vt][2] * inv * z2, acc[vt][3] * inv * z3); *(u32x2*)zp = w; }
}
__device__ __forceinline__ void attn_phase(unsigned char* lds, unsigned char* ws) {
    bf16_t* Ks = (bf16_t*)lds; bf16_t* Vs = (bf16_t*)(lds + 64 * KS_STRIDE * 2);
    for (int p = blockIdx.x; p < 1024; p += gridDim.x) { const int bh = p >> 3, pr = p & 7;
        attn_tile(Ks, Vs, ws, bh >> 4, bh & 15, 15 - pr);
        attn_tile(Ks, Vs, ws, bh >> 4, bh & 15, pr); }
}

__device__ __forceinline__ void prep_tables(const Params& P) {
    unsigned char* ws = P.ws; const int gt = blockIdx.x * 512 + fresh_tid(), ng = gridDim.x * 512;
    const int* pos = (const int*)P.in[1]; float* COS = (float*)(ws + WS_COS); float* SIN = (float*)(ws + WS_SIN);
    for (int i = gt; i < MTOK * 32; i += ng) { const int row = i >> 5, j = i & 31;
        const float invf = __builtin_amdgcn_exp2f(-(float)j * (13.287712379549449f / 32.f));
        const float ang = (float)pos[row] * invf;
        double t = (double)ang * 0.15915494309189535; t -= floor(t); const float tf = (float)t;
        COS[i] = __builtin_amdgcn_cosf(tf); SIN[i] = __builtin_amdgcn_sinf(tf); }
    const float* lbp = (const float*)P.in[2]; float* LB = (float*)(ws + WS_LB);
    for (int c = gt; c < 2048; c += ng) { const float a0 = lbp[c], a1 = lbp[2048 + c], a2 = lbp[4096 + c], a3 = lbp[6144 + c];
        const float mx = fmaxf(fmaxf(a0, a1), fmaxf(a2, a3)); const float e0 = expf(a0 - mx), e1 = expf(a1 - mx), e2 = expf(a2 - mx), e3 = expf(a3 - mx); const float sm = e0 + e1 + e2 + e3;
        LB[c] = 0.f; LB[2048 + c] = (e1 + e2 + e3) / sm; }
}

struct CvM { const float* W; int K, Ns, Nd, mode; bf16_t* dst; const float* rs; float cs; };
__device__ __forceinline__ bool cv_get(const Params& P, int cv, int sub, CvM& m) {
#define FIN(i) ((const float*)P.in[i])
    bf16_t* RW = (bf16_t*)(P.ws + WS_RW); bf16_t* U = (bf16_t*)(P.ws + WS_U);
    m.rs = nullptr; m.cs = 1.f; m.mode = MAP_ID;
    if (sub > 0 && cv != 2) return false;
    switch (cv) {
        case 0: m.W = FIN(5);  m.K = 2048; m.Ns = 8192;  m.Nd = 8192;  m.dst = RW; return true;
        case 1: m.W = FIN(7);  m.K = 2048; m.Ns = 2048;  m.Nd = 2048;  m.dst = U;  return true;
        case 2:
            if (sub == 0) { m.W = FIN(10); m.K = 2048; m.Ns = 3136; m.Nd = 3328; m.mode = MAP_MLAIN; m.dst = RW; return true; }
            if (sub == 1) { m.W = FIN(13); m.K = 512; m.Ns = 3072; m.Nd = 3072; m.mode = MAP_UQ; m.dst = RW + (size_t)3328 * 2048; m.rs = FIN(11); m.cs = 0.07216878364870323f; return true; }
            if (sub == 2) { m.W = FIN(14); m.K = 512; m.Ns = 4096; m.Nd = 4096; m.dst = RW + (size_t)3328 * 2048 + (size_t)3072 * 512; m.rs = FIN(12); return true; }
            return false;
        case 3: m.W = FIN(15); m.K = 2048; m.Ns = 2048;  m.Nd = 2048;  m.dst = U;  return true;
        case 4: m.W = FIN(18); m.K = 2048; m.Ns = 12352; m.Nd = 12544; m.dst = RW; return true;
        case 5: m.W = FIN(23); m.K = 4096; m.Ns = 2048;  m.Nd = 2048;  m.dst = U;  return true;
        case 6: m.W = FIN(26); m.K = 2048; m.Ns = 8192;  m.Nd = 8192;  m.dst = RW; return true;
        case 7: m.W = FIN(28); m.K = 2048; m.Ns = 2048;  m.Nd = 2048;  m.dst = U;  return true;
        default: return false;
    }
}

__global__ void __launch_bounds__(512) trunk_fwd(Params P) {
    extern __shared__ __attribute__((aligned(16))) unsigned char lds[];
    cg::grid_group grid = cg::this_grid();
    unsigned char* ws = P.ws; LAS unsigned char* L3 = (LAS unsigned char*)lds; float* Lf = (float*)lds;
    const int bi = blockIdx.x, nb = gridDim.x;
    bf16_t* RW = (bf16_t*)(ws + WS_RW); bf16_t* U = (bf16_t*)(ws + WS_U);
    const bf16_t* Z0 = (const bf16_t*)(ws + WS_Z); const bf16_t* Z64 = (const bf16_t*)(ws + WS_Z + 64 * MiB); const bf16_t* Z80 = (const bf16_t*)(ws + WS_Z + 80 * MiB);
    const float* YB = (const float*)(ws + WS_BIG); const float* LB = (const float*)(ws + WS_LB);
    for (int st = P.ph_lo; st < P.ph_hi; ++st) {
        int cv = -1, rowk = 0, gm = -1, gN = 0, gK = 0, mix = 0; bool sync_after = true, tables = false;
        const float *r_h = nullptr, *r_y = nullptr, *r_post = nullptr, *r_pre = nullptr, *hn = nullptr, *lbp = LB;
        const bf16_t *gA = nullptr, *gB = nullptr;
        switch (st) {
            case 0:  tables = true; rowk = 1; r_h = FIN(0); r_pre = FIN(3); cv = 0; break;
            case 1:  gm = EM_HG; gA = U; gB = RW; gN = 8192; gK = 2048; lbp = LB; break;
            case 2:  cv = 1; mix = 1; hn = FIN(6); break;
            case 3:  gm = EM_OUT; gA = Z64; gB = U; gN = 2048; gK = 2048; break;
            case 4:  rowk = 1; r_h = FIN(0); r_y = YB; r_post = FIN(4); r_pre = FIN(8); cv = 2; break;
            case 5:  gm = EM_MLAIN; gA = U; gB = RW; gN = 3328; gK = 2048; break;
            case 6:  gm = EM_Q; gA = Z64; gB = RW + (size_t)3328 * 2048; gN = 3072; gK = 512; sync_after = false; break;
            case 7:  gm = EM_KV; gA = Z80; gB = RW + (size_t)3328 * 2048 + (size_t)3072 * 512; gN = 4096; gK = 512; break;
            case 8:  cv = 3; mix = 2; break;
            case 9:  gm = EM_OUT; gA = Z0; gB = U; gN = 2048; gK = 2048; break;
            case 10: rowk = 1; r_h = P.out; r_y = YB; r_post = FIN(9); r_pre = FIN(16); cv = 4; break;
            case 11: gm = EM_GDN; gA = U; gB = RW; gN = 12544; gK = 2048; break;
            case 12: cv = 5; mix = 3; hn = FIN(22); break;
            case 13: gm = EM_OUT; gA = Z0; gB = U; gN = 2048; gK = 4096; break;
            case 14: rowk = 1; r_h = P.out; r_y = YB; r_post = FIN(17); r_pre = FIN(24); cv = 6; break;
            case 15: gm = EM_HG; gA = U; gB = RW; gN = 8192; gK = 2048; lbp = LB + 2048; break;
            case 16: cv = 7; mix = 1; hn = FIN(27); break;
            case 17: gm = EM_OUT; gA = Z64; gB = U; gN = 2048; gK = 2048; break;
            default: rowk = 1; r_h = P.out; r_y = YB; r_post = FIN(25); r_pre = nullptr; break;
        }
        if (tables) prep_tables(P);
        if (rowk) row_phase(r_h, r_y, r_post, r_pre, P.out, U);
        if (cv >= 0) { for (int sub = 0; sub < 3; ++sub) { CvM m; if (!cv_get(P, cv, sub, m)) break; convert_w(Lf, m.W, m.K, m.Ns, m.dst, m.Nd, m.mode, m.rs, m.cs, bi, nb); } }
        if (gm >= 0) { Epi E; E.mode = gm;
#ifdef ONLY_MODE
            E.mode = ONLY_MODE;
#endif
 E.ws = ws; E.lb = lbp; E.alog = FIN(20); E.dtb = FIN(21); run_gemm(L3, gA, gB, gN, gK, E); }
#ifndef DIS_GLA
        if (mix == 1) gla_chunked(lds, ws, hn);
#endif
#ifndef DIS_ATTN
        if (mix == 2) attn_phase(lds, ws);
#endif
#ifndef DIS_GDN
        if (mix == 3) gdn_naive(Lf, ws, FIN(19), hn);
#endif
        if (sync_after && st + 1 < P.ph_hi) grid.sync();
    }
#ifdef PROBE_N
    grid.sync();
    { const unsigned short* U16 = (const unsigned short*)(ws + WS_U); const unsigned short* B16 = (const unsigned short*)(ws + WS_BIG); const unsigned short* Z16 = (const unsigned short*)(ws + WS_Z);
      const unsigned short* S16 = (const unsigned short*)(ws + WS_SM); const unsigned short* R16 = (const unsigned short*)(ws + WS_RW);
      const size_t n = (size_t)MTOK * DM; for (size_t i = (size_t)blockIdx.x * 512 + threadIdx.x; i < n; i += (size_t)gridDim.x * 512) {
        unsigned a = U16[i]; a = a * 2654435761u + B16[i]; a = a * 2654435761u + B16[i + n]; a = a * 2654435761u + B16[i + 2 * n]; a = a * 2654435761u + B16[i + 3 * n]; a = a * 2654435761u + Z16[i]; a = a * 2654435761u + Z16[i + n];
        if (i < 4 * MiB) a = a * 2654435761u + S16[i]; if (i < 25 * MiB) a = a * 2654435761u + R16[i];
        a ^= a >> 15; a *= 2246822519u; a ^= a >> 13;
        P.out[i] = (float)(a & 0xFFFFu); } }
#endif
#undef FIN
}

extern "C" void kernel_launch(void* const* d_in, const int* in_sizes, int n_in, void* d_out, int out_size, void* d_ws, size_t ws_size, hipStream_t stream) {
    static int grid_blocks = 0;
    if (grid_blocks == 0) {
        if (n_in != 29 || ws_size < WS_END) { fprintf(stderr, "kernel_launch: need 29 inputs and %zu bytes of workspace; got %d, %zu\n", (size_t)WS_END, n_in, ws_size); grid_blocks = -1; return; }
        int dev = 0, cus = 0, per_cu = 0;
        hipGetDevice(&dev); hipDeviceGetAttribute(&cus, hipDeviceAttributeMultiprocessorCount, dev);
        if (hipFuncSetAttribute((const void*)trunk_fwd, hipFuncAttributeMaxDynamicSharedMemorySize, LDS_BYTES) != hipSuccess) { fprintf(stderr, "hipFuncSetAttribute failed\n"); grid_blocks = -1; return; }
        if (hipOccupancyMaxActiveBlocksPerMultiprocessor(&per_cu, (const void*)trunk_fwd, 512, LDS_BYTES) != hipSuccess || per_cu < 1) { fprintf(stderr, "occupancy query failed (%d)\n", per_cu); per_cu = 1; }
        (void)hipGetLastError();
        grid_blocks = cus * 1;
    }
    if (grid_blocks < 0) return;
    Params p{};
    for (int i = 0; i < 29; ++i) p.in[i] = d_in[i];
    p.out = (float*)d_out; p.ws = (unsigned char*)d_ws;
#if PER_PHASE_LAUNCH
    for (int ph = 0; ph < NPHASE; ++ph) {
        p.ph_lo = ph; p.ph_hi = ph + 1; void* args[] = {&p};
        hipError_t e = hipLaunchCooperativeKernel((const void*)trunk_fwd, dim3(grid_blocks), dim3(512), args, LDS_BYTES, stream);
        if (e != hipSuccess) { fprintf(stderr, "launch failed: %s\n", hipGetErrorString(e)); break; }
    }
#else
#ifdef PROBE_N
    p.ph_lo = 0; p.ph_hi = PROBE_N; void* args[] = {&p};
#else
    p.ph_lo = 0; p.ph_hi = NPHASE; void* args[] = {&p};
#endif
    hipError_t e = hipLaunchCooperativeKernel((const void*)trunk_fwd, dim3(grid_blocks), dim3(512), args, LDS_BYTES, stream);
    if (e != hipSuccess) fprintf(stderr, "cooperative launch failed: %s (grid %d)\n", hipGetErrorString(e), grid_blocks);
#endif
}
```

```cpp
#include <hip/hip_runtime.h>
#include <hip/hip_cooperative_groups.h>
#include <cstdio>
namespace cg = cooperative_groups;
namespace pg8 {
#define PG8_LAS __attribute__((address_space(3)))
typedef unsigned short bf16_t;
typedef short bf16x8 __attribute__((ext_vector_type(8)));
typedef float f32x4 __attribute__((ext_vector_type(4)));
typedef unsigned u32x4 __attribute__((ext_vector_type(4)));
constexpr int BM = 256, BK = 64, HALF = 128, HTB = HALF * BK * 2  , STAGE_BYTES = 8 * HTB, NXCD = 8, WGM = 8;

__host__ __device__ __forceinline__ int lds_byte(int r, int c) { const int st = (r >> 4) * 2 + (c >> 5), rr = r & 15, cc = c & 31, ob = rr * 64 + cc * 2; return st * 1024 + (ob ^ (((ob >> 9) & 1) << 5)); }
__host__ __device__ __forceinline__ void stage_rc(int b, int& R, int& C) { const int st = b / 1024, sb = b % 1024, swz = sb ^ (((sb >> 9) & 1) << 5); R = (st >> 1) * 16 + swz / 64; C = (st & 1) * 32 + (swz % 64) / 2; }
__host__ __device__ __forceinline__ int perm32(int rho) { const int n = rho >> 4, i = rho & 15; return 8 * (i >> 2) + 4 * n + (i & 3); }

struct Unit { int pm, pn; };
struct Gemm { const bf16_t* A; const bf16_t* Bt; int M, N, K; };
struct StaticOrder {
    int nM, nN, nwg, G, c;
    __host__ __device__ void init(int M, int N, int G_, int c_) { nM = M / BM; nN = N / BM; nwg = nM * nN; G = G_; c = c_; }
    __host__ __device__ bool next(int i, Unit& u) const {
        const long L = (long)i * G + c; if (L >= nwg) return false;
        int wgid = (int)L; { const int q = nwg / NXCD, r = nwg % NXCD, xcd = wgid % NXCD, off = wgid / NXCD; wgid = (xcd < r ? xcd * (q + 1) : r * (q + 1) + (xcd - r) * q) + off; }
        const int nig = WGM * nN, gid = wgid / nig, fm = gid * WGM, gsz = (nM - fm) < WGM ? (nM - fm) : WGM;
        u.pm = fm + ((wgid % nig) % gsz); u.pn = (wgid % nig) / gsz; return true;
    }
    __device__ __forceinline__ void a_ready(const Unit&) const {}
    __device__ __forceinline__ void done(const Unit&) const {}
};
__device__ __forceinline__ unsigned cvt_pk_bf16(float lo, float hi) { unsigned r; asm volatile("v_cvt_pk_bf16_f32 %0, %1, %2" : "=v"(r) : "v"(lo), "v"(hi)); return r; }
template <class Epi, class Sched>
__device__ __forceinline__ void gemm_phase(PG8_LAS unsigned char* lds, const Gemm g, const Sched& S, const Epi& E) {
    const int tid = threadIdx.x, wid = __builtin_amdgcn_readfirstlane(tid >> 6), lane = tid & 63, wr = wid >> 2, wc = wid & 3, fr = lane & 15, fq = lane >> 4;
    const int K = g.K, nt = K / BK;
    unsigned voffA[2], voffB[2];
#pragma unroll
    for (int i = 0; i < 2; ++i) { int R, C; stage_rc(tid * 16 + i * 8192, R, C); const int Rb = Epi::PERM ? ((R & ~31) + perm32(R & 31)) : R;
        voffA[i] = (unsigned)(R * K + C) * 2u; voffB[i] = (unsigned)(Rb * K + C) * 2u; }
    const size_t kstep = (size_t)(BK * 2);
    const size_t hstep = (size_t)HALF * K * 2;
    const size_t tstep = 2 * hstep;
    const unsigned ldsw = (unsigned)wid * 1024u;
    const int aoff = lds_byte(wr * 64 + fr, fq * 8), boff = lds_byte(wc * 32 + fr, fq * 8);
#define PG8_SA(b, h) (((b) * 2 + (h)) * HTB)
#define PG8_SB(b, h) ((4 + (b) * 2 + (h)) * HTB)
#define PG8_STAGE(bufoff, gbase, voff) do { _Pragma("unroll") for (int _i = 0; _i < 2; ++_i) \
        __builtin_amdgcn_global_load_lds((const unsigned*)((const char*)(gbase) + (voff)[_i]), (PG8_LAS unsigned*)(lds + (bufoff) + ldsw + _i * 8192), 16, 0, 0); } while (0)
#define PG8_LDA(dst, b, h) do { _Pragma("unroll") for (int m = 0; m < 4; ++m) _Pragma("unroll") for (int k = 0; k < 2; ++k) dst[m][k] = *(const PG8_LAS bf16x8*)(lds + PG8_SA(b, h) + aoff + m * 2048 + k * 1024); } while (0)
#define PG8_LDB(dst, b, h) do { _Pragma("unroll") for (int n = 0; n < 2; ++n) _Pragma("unroll") for (int k = 0; k < 2; ++k) dst[n][k] = *(const PG8_LAS bf16x8*)(lds + PG8_SB(b, h) + boff + n * 2048 + k * 1024); } while (0)
#define PG8_MMA(ai, bj, At, Bt) do { __builtin_amdgcn_s_setprio(1); _Pragma("unroll") for (int m = 0; m < 4; ++m) _Pragma("unroll") for (int n = 0; n < 2; ++n) _Pragma("unroll") for (int k = 0; k < 2; ++k) \
        acc[ai][bj][m][n] = __builtin_amdgcn_mfma_f32_16x16x32_bf16(Bt[n][k], At[m][k], acc[ai][bj][m][n], 0, 0, 0); __builtin_amdgcn_s_setprio(0); } while (0)
#define PG8_WAIT_V(n) asm volatile("s_waitcnt vmcnt(" #n ")" ::: "memory")
#define PG8_WAIT_L(n) asm volatile("s_waitcnt lgkmcnt(" #n ")" ::: "memory")
#define PG8_BAR __builtin_amdgcn_s_barrier()
#define PG8_SCHED __builtin_amdgcn_sched_barrier(0)
    Unit cur, nxt; int ui = 0;
    if (!S.next(0, cur)) return;
    f32x4 acc[2][2][4][2];
#pragma unroll
    for (int a = 0; a < 2; ++a)
#pragma unroll
        for (int b = 0; b < 2; ++b)
#pragma unroll
            for (int m = 0; m < 4; ++m)
#pragma unroll
                for (int n = 0; n < 2; ++n) acc[a][b][m][n] = (f32x4){0.f, 0.f, 0.f, 0.f};
    bf16x8 At[4][2], B0[2][2], B1[2][2];
    const char* cA = (const char*)g.A + (size_t)cur.pm * tstep; const char* cB = (const char*)g.Bt + (size_t)cur.pn * tstep;
    S.a_ready(cur);
    PG8_STAGE(PG8_SB(0, 0), cB, voffB); PG8_STAGE(PG8_SA(0, 0), cA, voffA); PG8_STAGE(PG8_SB(0, 1), cB + hstep, voffB); PG8_STAGE(PG8_SA(0, 1), cA + hstep, voffA);
    if (wr == 1) PG8_BAR;
    PG8_WAIT_V(4); PG8_BAR;
    PG8_STAGE(PG8_SB(1, 0), cB + kstep, voffB); PG8_STAGE(PG8_SA(1, 0), cA + kstep, voffA); PG8_STAGE(PG8_SB(1, 1), cB + hstep + kstep, voffB);
    PG8_WAIT_V(6); PG8_BAR;
    for (;;) {
        const bool has_next = S.next(ui + 1, nxt);
        const char* nA = has_next ? (const char*)g.A + (size_t)nxt.pm * tstep : cA; const char* nB = has_next ? (const char*)g.Bt + (size_t)nxt.pn * tstep : cB;
        for (int t = 0; t < nt; t += 2) {
            const bool last = (t == nt - 2);
            const char* a1 = cA + (size_t)(t + 1) * kstep;
            const char* a2 = last ? nA : cA + (size_t)(t + 2) * kstep; const char* b2 = last ? nB : cB + (size_t)(t + 2) * kstep;
            const char* a3 = a2 + kstep; const char* b3 = b2 + kstep;
            if (last && has_next) S.a_ready(nxt);
            PG8_LDB(B0, 0, 0); PG8_SCHED; PG8_LDA(At, 0, 0); PG8_STAGE(PG8_SA(1, 1), a1 + hstep, voffA);
            PG8_WAIT_L(8); PG8_BAR; PG8_WAIT_L(0); PG8_MMA(0, 0, At, B0); PG8_BAR; PG8_SCHED;
            PG8_LDB(B1, 0, 1); PG8_STAGE(PG8_SB(0, 0), b2, voffB);
            PG8_BAR; PG8_WAIT_L(0); PG8_MMA(0, 1, At, B1); PG8_BAR;
            PG8_LDA(At, 0, 1); PG8_STAGE(PG8_SA(0, 0), a2, voffA);
            PG8_BAR; PG8_WAIT_L(0); PG8_MMA(1, 0, At, B0); PG8_BAR; PG8_SCHED;
            PG8_STAGE(PG8_SB(0, 1), b2 + hstep, voffB);
            PG8_WAIT_V(6); PG8_BAR; PG8_MMA(1, 1, At, B1); PG8_BAR;
            PG8_LDB(B0, 1, 0); PG8_SCHED; PG8_LDA(At, 1, 0); PG8_STAGE(PG8_SA(0, 1), a2 + hstep, voffA);
            PG8_WAIT_L(8); PG8_BAR; PG8_WAIT_L(0); PG8_MMA(0, 0, At, B0); PG8_BAR; PG8_SCHED;
            PG8_LDB(B1, 1, 1); PG8_STAGE(PG8_SB(1, 0), b3, voffB);
            PG8_BAR; PG8_WAIT_L(0); PG8_MMA(0, 1, At, B1); PG8_BAR;
            PG8_LDA(At, 1, 1); PG8_STAGE(PG8_SA(1, 0), a3, voffA);
            PG8_BAR; PG8_WAIT_L(0); PG8_MMA(1, 0, At, B0); PG8_BAR; PG8_SCHED;
            PG8_STAGE(PG8_SB(1, 1), b3 + hstep, voffB);
            PG8_WAIT_V(6); PG8_BAR; PG8_MMA(1, 1, At, B1); PG8_BAR;
        }
        if constexpr (!Epi::AFTER_DRAIN) { E(acc, cur, wr, wc, fr, fq); S.done(cur); }
        if (!has_next) break;
#pragma unroll
        for (int a = 0; a < 2; ++a)
#pragma unroll
            for (int b = 0; b < 2; ++b)
#pragma unroll
                for (int m = 0; m < 4; ++m)
#pragma unroll
                    for (int n = 0; n < 2; ++n) acc[a][b][m][n] = (f32x4){0.f, 0.f, 0.f, 0.f};
        cur = nxt; cA = nA; cB = nB; ++ui;
    }
    PG8_WAIT_V(0);
    if (wr == 0) PG8_BAR;
    PG8_BAR;
    if constexpr (Epi::AFTER_DRAIN) { E.fused(acc, cur, wr, wc, fr, fq, lds, wid, lane); S.done(cur); }
#undef PG8_SA
#undef PG8_SB
#undef PG8_STAGE
#undef PG8_LDA
#undef PG8_LDB
#undef PG8_MMA
#undef PG8_WAIT_V
#undef PG8_WAIT_L
#undef PG8_BAR
#undef PG8_SCHED
}
}

#ifndef PER_PHASE_LAUNCH
#define PER_PHASE_LAUNCH 0
#endif

#define LAS __attribute__((address_space(3)))
typedef unsigned short bf16_t;
typedef short bf16x8 __attribute__((ext_vector_type(8)));
typedef short s16x4 __attribute__((ext_vector_type(4)));
typedef float f32x4 __attribute__((ext_vector_type(4)));
typedef unsigned u32x4 __attribute__((ext_vector_type(4)));
typedef unsigned u32x2 __attribute__((ext_vector_type(2)));

constexpr int MTOK = 16384, DM = 2048, SEQ = 2048;
constexpr float EPS = 1e-6f;
constexpr size_t MiB = 1ull << 20;
constexpr size_t WS_RW = 0;
constexpr size_t WS_U = 50 * MiB;
constexpr size_t WS_BIG = 114 * MiB;
constexpr size_t WS_Z = 370 * MiB;
constexpr size_t WS_SM = 498 * MiB;
constexpr size_t WS_COS = WS_SM, WS_SIN = WS_SM + 2 * MiB, WS_GD = WS_SM + 4 * MiB, WS_BD = WS_SM + 6 * MiB;
constexpr size_t WS_SSQ = WS_SM + 8 * MiB;
constexpr size_t WS_LB = WS_SM + 9 * MiB;
constexpr size_t WS_END = WS_SM + 9 * MiB + 65536;
constexpr int LDS_BYTES = 155648;
constexpr int NPHASE = 19;

struct Params { const void* in[29]; float* out; unsigned char* ws; int ph_lo, ph_hi; };

__device__ __forceinline__ int fresh_tid() { int t = threadIdx.x; asm volatile("" : "+v"(t)); return t; }
__device__ __forceinline__ float bf2f(bf16_t v) { return __uint_as_float(((unsigned)v) << 16); }
__device__ __forceinline__ bf16_t f2bf(float f) { unsigned u = __float_as_uint(f); u += 0x7FFFu + ((u >> 16) & 1u); return (bf16_t)(u >> 16); }
__device__ __forceinline__ float siluf(float x) { return x / (1.f + __expf(-x)); }
__device__ __forceinline__ float sigmf(float x) { return 1.f / (1.f + __expf(-x)); }
__device__ __forceinline__ float wave_sum(float v) {
#pragma unroll
    for (int o = 32; o >= 1; o >>= 1) v += __shfl_xor(v, o);
    return v;
}
__device__ __forceinline__ u32x4 pack8(const f32x4 a, const f32x4 b) {
    u32x4 w; w.x = pg8::cvt_pk_bf16(a[0], a[1]); w.y = pg8::cvt_pk_bf16(a[2], a[3]); w.z = pg8::cvt_pk_bf16(b[0], b[1]); w.w = pg8::cvt_pk_bf16(b[2], b[3]); return w;
}

enum { MAP_ID = 0, MAP_MLAIN = 1, MAP_UQ = 2 };
__device__ __forceinline__ int map_src(int mode, int n, int nsrc) {
    if (mode == MAP_MLAIN) { if (n < 1024) return n; if (n < 3072) return n + 64; if (n < 3136) { const int j = n - 3072; return 1024 + (j >> 1) + 32 * (j & 1); } return -1; }
    if (mode == MAP_UQ) { const int hd = n / 192, c = n - hd * 192; if (c < 128) return n; const int j = c - 128; return hd * 192 + 128 + (j >> 1) + 32 * (j & 1); }
    return n < nsrc ? n : -1;
}
__device__ __forceinline__ void convert_w(float* tile, const float* W, int K, int Nsrc, bf16_t* Bt, int Ndst, int mode, const float* rowscale, float cscale, int bi, int nb) {
    const int tid = fresh_tid();
    const int tk = K / 64, tn = Ndst / 64;
    for (int t = bi; t < tk * tn; t += nb) {
        const int n0 = (t / tk) * 64, k0 = (t % tk) * 64;
        __syncthreads();
        {
            const int j = tid & 63, i0 = tid >> 6; const int sc = map_src(mode, n0 + j, Nsrc);
#pragma unroll
            for (int it = 0; it < 8; ++it) {
                const int k = k0 + i0 + 8 * it; float v = 0.f;
                if (sc >= 0) { v = W[(size_t)k * Nsrc + sc] * cscale; if (rowscale) v *= rowscale[k]; }
                tile[(i0 + 8 * it) * 65 + j] = v;
            }
        }
        __syncthreads();
        {
            const int n = tid >> 3, kk = (tid & 7) * 8; u32x4 w;
            w.x = pg8::cvt_pk_bf16(tile[(kk + 0) * 65 + n], tile[(kk + 1) * 65 + n]);
            w.y = pg8::cvt_pk_bf16(tile[(kk + 2) * 65 + n], tile[(kk + 3) * 65 + n]);
            w.z = pg8::cvt_pk_bf16(tile[(kk + 4) * 65 + n], tile[(kk + 5) * 65 + n]);
            w.w = pg8::cvt_pk_bf16(tile[(kk + 6) * 65 + n], tile[(kk + 7) * 65 + n]);
            *(u32x4*)(Bt + (size_t)(n0 + n) * K + k0 + kk) = w;
        }
    }
    __syncthreads();
}

__device__ __forceinline__ void row_phase(const float* hsrc, const float* Y, const float* postw, const float* prew, float* hout, bf16_t* U) {
    const int tid_ = fresh_tid(); const int lane = tid_ & 63, gw = blockIdx.x * 8 + (tid_ >> 6), nw = gridDim.x * 8;
    for (int row = gw; row < MTOK; row += nw) {
        f32x4 h[8]; const float* hp = hsrc + (size_t)row * DM + lane * 4;
#pragma unroll
        for (int i = 0; i < 8; ++i) h[i] = *(const f32x4*)(hp + 256 * i);
        if (Y) {
            f32x4 y[8]; const float* yp = Y + (size_t)row * DM + lane * 4; float ss = 0.f;
#pragma unroll
            for (int i = 0; i < 8; ++i) { y[i] = *(const f32x4*)(yp + 256 * i); ss += y[i][0] * y[i][0] + y[i][1] * y[i][1] + y[i][2] * y[i][2] + y[i][3] * y[i][3]; }
            ss = wave_sum(ss); const float ry = rsqrtf(ss * (1.f / 2048.f) + EPS);
            float* op = hout + (size_t)row * DM + lane * 4;
#pragma unroll
            for (int i = 0; i < 8; ++i) { const f32x4 pw = *(const f32x4*)(postw + lane * 4 + 256 * i); h[i] += y[i] * ry * pw; *(f32x4*)(op + 256 * i) = h[i]; }
        }
        if (prew) {
            float ss = 0.f;
#pragma unroll
            for (int i = 0; i < 8; ++i) ss += h[i][0] * h[i][0] + h[i][1] * h[i][1] + h[i][2] * h[i][2] + h[i][3] * h[i][3];
            ss = wave_sum(ss); const float r = rsqrtf(ss * (1.f / 2048.f) + EPS);
            bf16_t* up = U + (size_t)row * DM + lane * 4;
#pragma unroll
            for (int i = 0; i < 8; ++i) { const f32x4 pw = *(const f32x4*)(prew + lane * 4 + 256 * i); const f32x4 u = h[i] * r * pw;
                u32x2 w; w.x = pg8::cvt_pk_bf16(u[0], u[1]); w.y = pg8::cvt_pk_bf16(u[2], u[3]); *(u32x2*)(up + 256 * i) = w; }
        }
    }
}

enum { EM_HG = 0, EM_MLAIN = 1, EM_Q = 2, EM_KV = 3, EM_GDN = 4, EM_OUT = 5 };
struct Epi {
    static constexpr bool PERM = true, AFTER_DRAIN = false;
    int mode;
    unsigned char* ws;
    const float* lb;
    const float* alog; const float* dtb;
    __device__ __forceinline__ void operator()(const f32x4 (&acc)[2][2][4][2], const pg8::Unit& u, int wr, int wc, int fr, int fq) const {
        asm volatile("" : "+v"(fr), "+v"(fq));
        const int rowb = u.pm * 256 + wr * 64 + fr, colw = wc * 32 + 8 * fq;
#define EPI_LOOP for (int ai = 0; ai < 2; ++ai) for (int m = 0; m < 4; ++m) { const int row = rowb + ai * 128 + m * 16; (void)row; for (int bj = 0; bj < 2; ++bj) { const int col = colw + bj * 128; (void)col; f32x4 v0 = acc[ai][bj][m][0], v1 = acc[ai][bj][m][1];
#define EPI_END } }
        if (mode == EM_OUT) {
            float* Y = (float*)(ws + WS_BIG);
#pragma unroll
            EPI_LOOP float* p = Y + (size_t)row * 2048 + u.pn * 256 + col; *(f32x4*)p = v0; *(f32x4*)(p + 4) = v1; EPI_END
        } else if (mode == EM_KV) {
            bf16_t* KV = (bf16_t*)(ws + WS_BIG + 96 * MiB); const float* ssq = (const float*)(ws + WS_SSQ) + (size_t)MTOK * 8;
#pragma unroll
            for (int ai = 0; ai < 2; ++ai)
#pragma unroll
                for (int m = 0; m < 4; ++m) { const int row = rowb + ai * 128 + m * 16; const f32x4 p0 = *(const f32x4*)(ssq + (size_t)row * 8), p1 = *(const f32x4*)(ssq + (size_t)row * 8 + 4); const float r = rsqrtf((((p0[0] + p0[1]) + (p0[2] + p0[3])) + ((p1[0] + p1[1]) + (p1[2] + p1[3]))) * (1.f / 512.f) + EPS);
#pragma unroll
                    for (int bj = 0; bj < 2; ++bj) { const int col = colw + bj * 128; *(u32x4*)(KV + (size_t)row * 4096 + u.pn * 256 + col) = pack8(acc[ai][bj][m][0] * r, acc[ai][bj][m][1] * r); } }
        } else if (mode == EM_Q) {
            bf16_t* Q = (bf16_t*)(ws + WS_BIG); const float* ssq = (const float*)(ws + WS_SSQ);
            const float* COS = (const float*)(ws + WS_COS); const float* SIN = (const float*)(ws + WS_SIN);
#pragma unroll
            for (int ai = 0; ai < 2; ++ai)
#pragma unroll
                for (int m = 0; m < 4; ++m) { const int row = rowb + ai * 128 + m * 16; const f32x4 p0 = *(const f32x4*)(ssq + (size_t)row * 8), p1 = *(const f32x4*)(ssq + (size_t)row * 8 + 4); const float r = rsqrtf((((p0[0] + p0[1]) + (p0[2] + p0[3])) + ((p1[0] + p1[1]) + (p1[2] + p1[3]))) * (1.f / 512.f) + EPS);
#pragma unroll
                    for (int bj = 0; bj < 2; ++bj) { const int c = u.pn * 256 + colw + bj * 128; const int within = c % 192;
                        f32x4 v0 = acc[ai][bj][m][0] * r, v1 = acc[ai][bj][m][1] * r;
                        if (within >= 128) { const int j0 = (within - 128) >> 1; const f32x4 cs = *(const f32x4*)(COS + (size_t)row * 32 + j0), sn = *(const f32x4*)(SIN + (size_t)row * 32 + j0);
                            const f32x4 a = (f32x4){v0[0], v0[2], v1[0], v1[2]}, b = (f32x4){v0[1], v0[3], v1[1], v1[3]};
                            const f32x4 ra = a * cs - b * sn, rb = b * cs + a * sn;
                            v0 = (f32x4){ra[0], rb[0], ra[1], rb[1]}; v1 = (f32x4){ra[2], rb[2], ra[3], rb[3]}; }
                        *(u32x4*)(Q + (size_t)row * 3072 + c) = pack8(v0, v1); } }
        } else if (mode == EM_MLAIN) {
            if (u.pn < 4) {
                bf16_t* C = (bf16_t*)(ws + WS_Z + (u.pn < 2 ? 64 : 80) * MiB); float* ssq = (float*)(ws + WS_SSQ) + (u.pn < 2 ? (size_t)0 : (size_t)MTOK * 8); const int cb = (u.pn & 1) * 256;
#pragma unroll
                for (int ai = 0; ai < 2; ++ai)
#pragma unroll
                    for (int m = 0; m < 4; ++m) { const int row = rowb + ai * 128 + m * 16; float s = 0.f;
#pragma unroll
                        for (int bj = 0; bj < 2; ++bj) { const int col = colw + bj * 128; const f32x4 v0 = acc[ai][bj][m][0], v1 = acc[ai][bj][m][1];
                            s += v0[0] * v0[0] + v0[1] * v0[1] + v0[2] * v0[2] + v0[3] * v0[3] + v1[0] * v1[0] + v1[1] * v1[1] + v1[2] * v1[2] + v1[3] * v1[3];
                            *(u32x4*)(C + (size_t)row * 512 + cb + col) = pack8(v0, v1); }
                        s += __shfl_xor(s, 16); s += __shfl_xor(s, 32);
                        if (fq == 0) ssq[(size_t)row * 8 + (u.pn & 1) * 4 + wc] = s; }
            } else if (u.pn < 12) {
                bf16_t* Zs = (bf16_t*)(ws + WS_Z); const int cb = (u.pn - 4) * 256;
#pragma unroll
                EPI_LOOP
                    for (int e = 0; e < 4; ++e) { v0[e] = siluf(v0[e]); v1[e] = siluf(v1[e]); }
                    *(u32x4*)(Zs + (size_t)row * 2048 + cb + col) = pack8(v0, v1);
                EPI_END
            } else {
                if (colw < 64) {
                    bf16_t* KR = (bf16_t*)(ws + WS_Z + 96 * MiB); const float* COS = (const float*)(ws + WS_COS); const float* SIN = (const float*)(ws + WS_SIN);
#pragma unroll
                    for (int ai = 0; ai < 2; ++ai)
#pragma unroll
                        for (int m = 0; m < 4; ++m) { const int row = rowb + ai * 128 + m * 16; const int j0 = colw >> 1;
                            const f32x4 v0 = acc[ai][0][m][0], v1 = acc[ai][0][m][1];
                            const f32x4 cs = *(const f32x4*)(COS + (size_t)row * 32 + j0), sn = *(const f32x4*)(SIN + (size_t)row * 32 + j0);
                            const f32x4 a = (f32x4){v0[0], v0[2], v1[0], v1[2]}, b = (f32x4){v0[1], v0[3], v1[1], v1[3]};
                            const f32x4 ra = a * cs - b * sn, rb = b * cs + a * sn;
                            *(u32x4*)(KR + (size_t)row * 64 + colw) = pack8((f32x4){ra[0], rb[0], ra[1], rb[1]}, (f32x4){ra[2], rb[2], ra[3], rb[3]}); }
                }
            }
        } else if (mode == EM_HG) {
            const int region = u.pn >> 3, cb = (u.pn & 7) * 256;
            if (region == 0) {
                bf16_t* Q = (bf16_t*)(ws + WS_BIG);
#pragma unroll
                EPI_LOOP
                    for (int e = 0; e < 4; ++e) { v0[e] = siluf(v0[e]) * 0.08838834764831845f; v1[e] = siluf(v1[e]) * 0.08838834764831845f; }
                    *(u32x4*)(Q + (size_t)row * 2048 + cb + col) = pack8(v0, v1);
                EPI_END
            } else if (region == 1) {
                bf16_t* Kk = (bf16_t*)(ws + WS_BIG + 64 * MiB); float* G = (float*)(ws + WS_BIG + 128 * MiB);
#pragma unroll
                for (int bj = 0; bj < 2; ++bj) { const int col = colw + bj * 128; const f32x4 l0 = *(const f32x4*)(lb + cb + col), l1 = *(const f32x4*)(lb + cb + col + 4);
#pragma unroll
                    for (int ai = 0; ai < 2; ++ai)
#pragma unroll
                        for (int m = 0; m < 4; ++m) { const int row = rowb + ai * 128 + m * 16; const f32x4 v0 = acc[ai][bj][m][0], v1 = acc[ai][bj][m][1]; f32x4 g0, g1, k0, k1;
#pragma unroll
                            for (int e = 0; e < 4; ++e) {
                                { const float f = v0[e], l = l0[e], en = __expf(-fabsf(f)), ls = fminf(f, 0.f) - __logf(1.f + en), sg = __expf(ls);
                                  g0[e] = (l == 0.f) ? ls : __logf(l + (1.f - l) * sg); k0[e] = (1.f - l) * (1.f - sg); }
                                { const float f = v1[e], l = l1[e], en = __expf(-fabsf(f)), ls = fminf(f, 0.f) - __logf(1.f + en), sg = __expf(ls);
                                  g1[e] = (l == 0.f) ? ls : __logf(l + (1.f - l) * sg); k1[e] = (1.f - l) * (1.f - sg); } }
                            float* gp = G + (size_t)row * 2048 + cb + col; *(f32x4*)gp = g0; *(f32x4*)(gp + 4) = g1;
                            *(u32x4*)(Kk + (size_t)row * 2048 + cb + col) = pack8(k0, k1); } }
            } else if (region == 2) {
                bf16_t* V = (bf16_t*)(ws + WS_Z);
#pragma unroll
                EPI_LOOP *(u32x4*)(V + (size_t)row * 2048 + cb + col) = pack8(v0, v1); EPI_END
            } else {
                bf16_t* Zs = (bf16_t*)(ws + WS_Z + 64 * MiB);
#pragma unroll
                EPI_LOOP
                    for (int e = 0; e < 4; ++e) { v0[e] = siluf(v0[e]); v1[e] = siluf(v1[e]); }
                    *(u32x4*)(Zs + (size_t)row * 2048 + cb + col) = pack8(v0, v1);
                EPI_END
            }
        } else {
            if (u.pn < 32) {
                bf16_t* QKV = (bf16_t*)(ws + WS_BIG);
#pragma unroll
                EPI_LOOP *(u32x4*)(QKV + (size_t)row * 8192 + u.pn * 256 + col) = pack8(v0, v1); EPI_END
            } else if (u.pn < 48) {
                bf16_t* Zs = (bf16_t*)(ws + WS_Z); const int cb = (u.pn - 32) * 256;
#pragma unroll
                EPI_LOOP
                    for (int e = 0; e < 4; ++e) { v0[e] = siluf(v0[e]); v1[e] = siluf(v1[e]); }
                    *(u32x4*)(Zs + (size_t)row * 4096 + cb + col) = pack8(v0, v1);
                EPI_END
            } else {
                if (colw < 64) {
                    float* GD = (float*)(ws + WS_GD); float* BD = (float*)(ws + WS_BD);
#pragma unroll
                    for (int ai = 0; ai < 2; ++ai)
#pragma unroll
                        for (int m = 0; m < 4; ++m) { const int row = rowb + ai * 128 + m * 16; f32x4 v0 = acc[ai][0][m][0], v1 = acc[ai][0][m][1];
                            if (colw < 32) {
                                const f32x4 a0 = *(const f32x4*)(alog + colw), a1 = *(const f32x4*)(alog + colw + 4), d0 = *(const f32x4*)(dtb + colw), d1 = *(const f32x4*)(dtb + colw + 4);
#pragma unroll
                                for (int e = 0; e < 4; ++e) {
                                    { const float x = v0[e] + d0[e]; const float sp = fmaxf(x, 0.f) + __logf(1.f + __expf(-fabsf(x))); v0[e] = -__expf(a0[e]) * sp; }
                                    { const float x = v1[e] + d1[e]; const float sp = fmaxf(x, 0.f) + __logf(1.f + __expf(-fabsf(x))); v1[e] = -__expf(a1[e]) * sp; } }
                                float* p = GD + (size_t)row * 32 + colw; *(f32x4*)p = v0; *(f32x4*)(p + 4) = v1;
                            } else {
#pragma unroll
                                for (int e = 0; e < 4; ++e) { v0[e] = sigmf(v0[e]); v1[e] = sigmf(v1[e]); }
                                float* p = BD + (size_t)row * 32 + (colw - 32); *(f32x4*)p = v0; *(f32x4*)(p + 4) = v1;
                            } }
                }
            }
        }
#undef EPI_LOOP
#undef EPI_END
    }
};

__device__ __forceinline__ void run_gemm(LAS unsigned char* lds, const bf16_t* A, const bf16_t* Bt, int N, int K, const Epi E) {
    pg8::Gemm g{A, Bt, MTOK, N, K}; pg8::StaticOrder S; S.init(MTOK, N, (int)gridDim.x, (int)blockIdx.x);
    pg8::gemm_phase<Epi, pg8::StaticOrder>(lds, g, S, E);
    __syncthreads();
}

__device__ __forceinline__ s16x4 tr_read(const bf16_t* p) {
    typedef short v4i16_t __attribute__((ext_vector_type(4)));
    return __builtin_bit_cast(s16x4, __builtin_amdgcn_ds_read_tr16_b64_v4i16((LAS v4i16_t*)p));
}
__device__ __forceinline__ bf16x8 frag_tr(const bf16_t* base, int stride, int k0, int c0, int fr, int fq) {
    const bf16_t* p = base + (k0 + 8 * fq + (fr >> 2)) * stride + c0 + 4 * (fr & 3);
    const s16x4 r0 = tr_read(p), r1 = tr_read(p + 4 * stride);
    return (bf16x8){r0[0], r0[1], r0[2], r0[3], r1[0], r1[1], r1[2], r1[3]};
}
__device__ __forceinline__ bf16x8 frag_row(const bf16_t* base, int stride, int r0, int k0, int fr, int fq) { return *(const bf16x8*)(base + (r0 + fr) * stride + k0 + 8 * fq); }

__device__ __forceinline__ void gla_chunked(unsigned char* lds, unsigned char* ws, const float* hn) {
    if (blockIdx.x >= 128) return;
    const int tid = fresh_tid(), lane = tid & 63, w = __builtin_amdgcn_readfirstlane(tid >> 6), fr = lane & 15, fq = lane >> 4;
    const int b = blockIdx.x >> 4, h = blockIdx.x & 15;
    const bf16_t* Q = (const bf16_t*)(ws + WS_BIG); const bf16_t* Kk = (const bf16_t*)(ws + WS_BIG + 64 * MiB); const float* G = (const float*)(ws + WS_BIG + 128 * MiB);
    const bf16_t* V = (const bf16_t*)(ws + WS_Z); bf16_t* Zs = (bf16_t*)(ws + WS_Z + 64 * MiB);
    bf16_t* QD = (bf16_t*)lds; bf16_t* KD = (bf16_t*)(lds + 17408); bf16_t* VV = (bf16_t*)(lds + 35840); bf16_t* PP = (bf16_t*)(lds + 54272);
    bf16_t* SB = (bf16_t*)(lds + 63488); float* OT = (float*)(lds + 63488); float* TOT = (float*)(lds + 100352);
    const int c = tid & 127, part = tid >> 7;
    f32x4 S[8];
#pragma unroll
    for (int i = 0; i < 8; ++i) S[i] = (f32x4){0.f, 0.f, 0.f, 0.f};
    for (int ch = 0; ch < 32; ++ch) {
        const int trow0 = b * SEQ + ch * 64;
        float g[16], qv[16], kv[16];
#pragma unroll
        for (int i = 0; i < 16; ++i) { const size_t gi = (size_t)(trow0 + 16 * part + i) * 2048 + h * 128 + c; g[i] = G[gi]; qv[i] = bf2f(Q[gi]); kv[i] = bf2f(Kk[gi]); }
#pragma unroll
        for (int i = 1; i < 16; ++i) g[i] += g[i - 1];
        TOT[part * 128 + c] = g[15];
#pragma unroll
        for (int i = 0; i < 2; ++i) { const int idx = tid + 512 * i, r = idx >> 4, cc = idx & 15; *(u32x4*)(VV + r * 144 + cc * 8) = *(const u32x4*)(V + (size_t)(trow0 + r) * 2048 + h * 128 + cc * 8); }
        __syncthreads();
        {
            const float t0 = TOT[c], t1 = TOT[128 + c], t2 = TOT[256 + c];
            const float off = (part > 0 ? t0 : 0.f) + (part > 1 ? t1 : 0.f) + (part > 2 ? t2 : 0.f), bref = t0 + t1;
#pragma unroll
            for (int i = 0; i < 16; ++i) { const float bt = g[i] + off;
                QD[(16 * part + i) * 136 + c] = f2bf(qv[i] * __expf(fminf(bt - bref, 80.f))); KD[(16 * part + i) * 144 + c] = f2bf(kv[i] * __expf(fminf(bref - bt, 80.f))); }
#pragma unroll
            for (int j = 0; j < 4; ++j) { const int kk = 16 * w + 4 * fq + j; const float er = __expf(TOT[kk] + TOT[128 + kk]);
#pragma unroll
                for (int vt = 0; vt < 8; ++vt) SB[kk * 144 + 16 * vt + fr] = f2bf(S[vt][j] * er); }
        }
        __syncthreads();
        {
            const int tt = w >> 1;
#pragma unroll
            for (int x = 0; x < 2; ++x) { const int st = (w & 1) * 2 + x; f32x4 acc = (f32x4){0.f, 0.f, 0.f, 0.f};
                if (st <= tt) {
#pragma unroll
                    for (int ks = 0; ks < 4; ++ks) acc = __builtin_amdgcn_mfma_f32_16x16x32_bf16(frag_row(QD, 136, 16 * tt, 32 * ks, fr, fq), frag_row(KD, 144, 16 * st, 32 * ks, fr, fq), acc, 0, 0, 0);
                }
#pragma unroll
                for (int j = 0; j < 4; ++j) { const int t = 16 * tt + 4 * fq + j, sx = 16 * st + fr; PP[t * 72 + sx] = (st <= tt && sx <= t) ? f2bf(acc[j]) : (bf16_t)0; } }
        }
        __syncthreads();
        f32x4 oacc[4];
        {
            const int tt = w >> 1;
#pragma unroll
            for (int x = 0; x < 4; ++x) { const int vt = (w & 1) * 4 + x; f32x4 acc = (f32x4){0.f, 0.f, 0.f, 0.f};
#pragma unroll
                for (int ks = 0; ks < 2; ++ks) acc = __builtin_amdgcn_mfma_f32_16x16x32_bf16(frag_row(PP, 72, 16 * tt, 32 * ks, fr, fq), frag_tr(VV, 144, 32 * ks, 16 * vt, fr, fq), acc, 0, 0, 0);
#pragma unroll
                for (int ks = 0; ks < 4; ++ks) acc = __builtin_amdgcn_mfma_f32_16x16x32_bf16(frag_row(QD, 136, 16 * tt, 32 * ks, fr, fq), frag_tr(SB, 144, 32 * ks, 16 * vt, fr, fq), acc, 0, 0, 0);
                oacc[x] = acc; }
            float el[4], e2[4];
#pragma unroll
            for (int j = 0; j < 4; ++j) { const int kk = 16 * w + 4 * fq + j; const float hi = TOT[256 + kk] + TOT[384 + kk]; e2[j] = __expf(hi); el[j] = __expf(TOT[kk] + TOT[128 + kk] + hi); }
            const bf16x8 ka0 = frag_tr(KD, 144, 0, 16 * w, fr, fq), ka1 = frag_tr(KD, 144, 32, 16 * w, fr, fq);
#pragma unroll
            for (int vt = 0; vt < 8; ++vt) { f32x4 a2 = (f32x4){0.f, 0.f, 0.f, 0.f};
                a2 = __builtin_amdgcn_mfma_f32_16x16x32_bf16(ka0, frag_tr(VV, 144, 0, 16 * vt, fr, fq), a2, 0, 0, 0);
                a2 = __builtin_amdgcn_mfma_f32_16x16x32_bf16(ka1, frag_tr(VV, 144, 32, 16 * vt, fr, fq), a2, 0, 0, 0);
#pragma unroll
                for (int j = 0; j < 4; ++j) S[vt][j] = el[j] * S[vt][j] + e2[j] * a2[j]; }
        }
        __syncthreads();
        {
            const int tt = w >> 1;
#pragma unroll
            for (int x = 0; x < 4; ++x) { const int vt = (w & 1) * 4 + x;
#pragma unroll
                for (int j = 0; j < 4; ++j) OT[(16 * tt + 4 * fq + j) * 132 + 16 * vt + fr] = oacc[x][j]; }
        }
        __syncthreads();
        {
            const int r = tid >> 3, seg = tid & 7; const float* op = OT + r * 132 + seg * 16;
            f32x4 v[4]; float ss = 0.f;
#pragma unroll
            for (int i = 0; i < 4; ++i) { v[i] = *(const f32x4*)(op + 4 * i); ss += v[i][0] * v[i][0] + v[i][1] * v[i][1] + v[i][2] * v[i][2] + v[i][3] * v[i][3]; }
            ss += __shfl_xor(ss, 1); ss += __shfl_xor(ss, 2); ss += __shfl_xor(ss, 4);
            const float rn = rsqrtf(ss * (1.f / 128.f) + EPS);
            bf16_t* zp = Zs + (size_t)(trow0 + r) * 2048 + h * 128 + seg * 16;
#pragma unroll
            for (int i = 0; i < 2; ++i) { const u32x4 zz = *(const u32x4*)(zp + 8 * i); const f32x4 h0 = *(const f32x4*)(hn + seg * 16 + 8 * i), h1 = *(const f32x4*)(hn + seg * 16 + 8 * i + 4);
                f32x4 o0 = v[2 * i] * rn * h0, o1 = v[2 * i + 1] * rn * h1;
                o0[0] *= __uint_as_float(zz.x << 16); o0[1] *= __uint_as_float(zz.x & 0xffff0000u); o0[2] *= __uint_as_float(zz.y << 16); o0[3] *= __uint_as_float(zz.y & 0xffff0000u);
                o1[0] *= __uint_as_float(zz.z << 16); o1[1] *= __uint_as_float(zz.z & 0xffff0000u); o1[2] *= __uint_as_float(zz.w << 16); o1[3] *= __uint_as_float(zz.w & 0xffff0000u);
                *(u32x4*)(zp + 8 * i) = pack8(o0, o1); }
        }
    }
}

constexpr int GD_KK = 0, GD_QQ = 18432, GD_AW = 35840, GD_AT = 53248, GD_UU = 62464, GD_VN = 80896, GD_SB = 99328, GD_SM = 136192, GD_W = 138240, GD_END = 155648;
__device__ __forceinline__ void gdn_chunked(unsigned char* lds, unsigned char* ws, const float* cw, const float* hn) {
    const int tid = fresh_tid(), lane = tid & 63, w = __builtin_amdgcn_readfirstlane(tid >> 6), fr = lane & 15, fq = lane >> 4;
    const bf16_t* QKV = (const bf16_t*)(ws + WS_BIG); bf16_t* Zs = (bf16_t*)(ws + WS_Z); const float* GDp = (const float*)(ws + WS_GD); const float* BDp = (const float*)(ws + WS_BD);
    bf16_t* KK = (bf16_t*)(lds + GD_KK); bf16_t* QQ = (bf16_t*)(lds + GD_QQ); float* AW = (float*)(lds + GD_AW); bf16_t* W = (bf16_t*)(lds + GD_W); bf16_t* AT = (bf16_t*)(lds + GD_AT);
    bf16_t* UU = (bf16_t*)(lds + GD_UU); bf16_t* VN = (bf16_t*)(lds + GD_VN); bf16_t* SB = (bf16_t*)(lds + GD_SB); float* OT = (float*)(lds + GD_AW);
    float* gcs = (float*)(lds + GD_SM); float* egs = gcs + 64; float* bts = gcs + 128; float* nrm = gcs + 192;
    const int c = tid & 127, part = tid >> 7;
    for (int item = blockIdx.x; item < 256; item += gridDim.x) {
        const int b = item >> 5, vh = item & 31, hq = vh >> 1;
        const int chq = hq * 128 + c, chk = 2048 + hq * 128 + c, chv = 4096 + vh * 128 + c;
        f32x4 S[8];
#pragma unroll
        for (int i = 0; i < 8; ++i) S[i] = (f32x4){0.f, 0.f, 0.f, 0.f};
        for (int ch = 0; ch < 32; ++ch) {
            const int trow0 = b * SEQ + ch * 64, tl0 = ch * 64 + 16 * part;
            float qv[16], kv[16], vv[16];
            {
                const float wq0 = cw[chq], wq1 = cw[8192 + chq], wq2 = cw[16384 + chq], wq3 = cw[24576 + chq];
                const float wk0 = cw[chk], wk1 = cw[8192 + chk], wk2 = cw[16384 + chk], wk3 = cw[24576 + chk];
                const float wv0 = cw[chv], wv1 = cw[8192 + chv], wv2 = cw[16384 + chv], wv3 = cw[24576 + chv];
                float x0, x1, x2;
#define GD_CONV(dst, chn, w0, w1, w2, w3) \
                x0 = (tl0 - 3 >= 0) ? bf2f(QKV[(size_t)(b * SEQ + tl0 - 3) * 8192 + chn]) : 0.f; x1 = (tl0 - 2 >= 0) ? bf2f(QKV[(size_t)(b * SEQ + tl0 - 2) * 8192 + chn]) : 0.f; x2 = (tl0 - 1 >= 0) ? bf2f(QKV[(size_t)(b * SEQ + tl0 - 1) * 8192 + chn]) : 0.f; \
                _Pragma("unroll") for (int i = 0; i < 16; ++i) { const float x3 = bf2f(QKV[(size_t)(b * SEQ + tl0 + i) * 8192 + chn]); dst[i] = siluf(w0 * x0 + w1 * x1 + w2 * x2 + w3 * x3); x0 = x1; x1 = x2; x2 = x3; }
                GD_CONV(qv, chq, wq0, wq1, wq2, wq3)
                GD_CONV(kv, chk, wk0, wk1, wk2, wk3)
                GD_CONV(vv, chv, wv0, wv1, wv2, wv3)
#undef GD_CONV
            }
            if (w == 0) {
                float gsum = GDp[(size_t)(trow0 + lane) * 32 + vh];
#pragma unroll
                for (int o = 1; o < 64; o <<= 1) { const float t = __shfl_up(gsum, o); if (lane >= o) gsum += t; }
                gcs[lane] = gsum; egs[lane] = __expf(gsum); bts[lane] = BDp[(size_t)(trow0 + lane) * 32 + vh];
            }
#pragma unroll
            for (int i = 0; i < 16; ++i) { const float sq = wave_sum(qv[i] * qv[i]), sk = wave_sum(kv[i] * kv[i]); if (lane == 0) { nrm[((16 * part + i) * 2 + 0) * 2 + (w & 1)] = sq; nrm[((16 * part + i) * 2 + 1) * 2 + (w & 1)] = sk; } }
            { const int lt_ = fresh_tid(); const int fr = lt_ & 15, fq = (lt_ & 63) >> 4; (void)fr; (void)fq;
#pragma unroll
            for (int j = 0; j < 4; ++j) { const int kk = 16 * w + 4 * fq + j;
#pragma unroll
                for (int vt = 0; vt < 8; ++vt) SB[kk * 144 + 16 * vt + fr] = f2bf(S[vt][j]); } }
            __syncthreads();
#pragma unroll
            for (int i = 0; i < 16; ++i) { const int t = 16 * part + i;
                const float rq = rsqrtf(nrm[(t * 2 + 0) * 2] + nrm[(t * 2 + 0) * 2 + 1] + EPS) * 0.08838834764831845f, rk = rsqrtf(nrm[(t * 2 + 1) * 2] + nrm[(t * 2 + 1) * 2 + 1] + EPS);
                QQ[t * 136 + c] = f2bf(qv[i] * rq); KK[t * 144 + c] = f2bf(kv[i] * rk); VN[t * 144 + c] = f2bf(vv[i] * bts[t]); }
            __syncthreads();
            {
                const int lt_ = fresh_tid(); const int fr = lt_ & 15, fq = (lt_ & 63) >> 4; (void)fr; (void)fq;
                const int tt = w >> 1;
#pragma unroll
                for (int x = 0; x < 2; ++x) { const int st = (w & 1) * 2 + x; f32x4 a1 = (f32x4){0.f, 0.f, 0.f, 0.f}, a2 = (f32x4){0.f, 0.f, 0.f, 0.f};
                    if (st <= tt) {
#pragma unroll
                        for (int ks = 0; ks < 4; ++ks) { const bf16x8 kb = frag_row(KK, 144, 16 * st, 32 * ks, fr, fq);
                            a1 = __builtin_amdgcn_mfma_f32_16x16x32_bf16(frag_row(KK, 144, 16 * tt, 32 * ks, fr, fq), kb, a1, 0, 0, 0);
                            a2 = __builtin_amdgcn_mfma_f32_16x16x32_bf16(frag_row(QQ, 136, 16 * tt, 32 * ks, fr, fq), kb, a2, 0, 0, 0); }
                    }
#pragma unroll
                    for (int j = 0; j < 4; ++j) { const int t = 16 * tt + 4 * fq + j, sx = 16 * st + fr; const float dec = __expf(fminf(gcs[t] - gcs[sx], 0.f));
                        if (st <= tt) AW[t * 68 + sx] = (sx < t) ? bts[t] * a1[j] * dec : 0.f;
                        AT[t * 72 + sx] = (st <= tt && sx <= t) ? f2bf(a2[j] * dec) : (bf16_t)0; } }
            }
            __syncthreads();
            if (w < 4) {
                const int c = fresh_tid() & 127;
                const bf16_t* src = (w < 2) ? VN : KK;
                float X[64];
                if (w < 2) {
#pragma unroll
                    for (int i = 0; i < 64; ++i) X[i] = bf2f(src[i * 144 + c]);
                } else {
#pragma unroll
                    for (int i = 0; i < 64; ++i) { X[i] = bf2f(src[i * 144 + c]) * (bts[i] * egs[i]); if ((i & 7) == 7) asm volatile("" ::: "memory"); }
                }
#pragma unroll
                for (int i = 1; i < 64; ++i) { float acc = X[i];
#pragma unroll
                    for (int j4 = 0; j4 < (i + 3) / 4; ++j4) { const f32x4 a = *(const f32x4*)(AW + i * 68 + 4 * j4);
#pragma unroll
                        for (int e = 0; e < 4; ++e) if (4 * j4 + e < i) acc -= a[e] * X[4 * j4 + e]; }
                    X[i] = acc; if ((i & 3) == 3) asm volatile("" ::: "memory"); }
                bf16_t* dst = (w < 2) ? UU : W; const int dstride = (w < 2) ? 144 : 136;
#pragma unroll
                for (int i = 0; i < 64; ++i) dst[i * dstride + c] = f2bf(X[i]);
            }
            __syncthreads();
            const float gcl = gcs[63];
            {
                const int lt_ = fresh_tid(); const int fr = lt_ & 15, fq = (lt_ & 63) >> 4; (void)fr; (void)fq;
                const int tt = w >> 1;
#pragma unroll
                for (int x = 0; x < 4; ++x) { const int vt = (w & 1) * 4 + x; f32x4 acc = (f32x4){0.f, 0.f, 0.f, 0.f};
#pragma unroll
                    for (int ks = 0; ks < 4; ++ks) acc = __builtin_amdgcn_mfma_f32_16x16x32_bf16(frag_row(W, 136, 16 * tt, 32 * ks, fr, fq), frag_tr(SB, 144, 32 * ks, 16 * vt, fr, fq), acc, 0, 0, 0);
#pragma unroll
                    for (int j = 0; j < 4; ++j) { const int t = 16 * tt + 4 * fq + j, vx = 16 * vt + fr; const float vn = bf2f(UU[t * 144 + vx]) - acc[j];
                        VN[t * 144 + vx] = f2bf(vn); UU[t * 144 + vx] = f2bf(vn * __expf(gcl - gcs[t])); } asm volatile("" ::: "memory"); }
            }
            __syncthreads();
            f32x4 oacc[4];
            {
                const int lt_ = fresh_tid(); const int fr = lt_ & 15, fq = (lt_ & 63) >> 4; (void)fr; (void)fq;
                const int tt = w >> 1;
#pragma unroll
                for (int x = 0; x < 4; ++x) { const int vt = (w & 1) * 4 + x; f32x4 acc = (f32x4){0.f, 0.f, 0.f, 0.f};
#pragma unroll
                    for (int ks = 0; ks < 4; ++ks) acc = __builtin_amdgcn_mfma_f32_16x16x32_bf16(frag_row(QQ, 136, 16 * tt, 32 * ks, fr, fq), frag_tr(SB, 144, 32 * ks, 16 * vt, fr, fq), acc, 0, 0, 0);
#pragma unroll
                    for (int j = 0; j < 4; ++j) acc[j] *= egs[16 * tt + 4 * fq + j];
#pragma unroll
                    for (int ks = 0; ks < 2; ++ks) acc = __builtin_amdgcn_mfma_f32_16x16x32_bf16(frag_row(AT, 72, 16 * tt, 32 * ks, fr, fq), frag_tr(VN, 144, 32 * ks, 16 * vt, fr, fq), acc, 0, 0, 0);
                    oacc[x] = acc; asm volatile("" ::: "memory"); }
                const float egl = __expf(gcl);
                const bf16x8 ka0 = frag_tr(KK, 144, 0, 16 * w, fr, fq), ka1 = frag_tr(KK, 144, 32, 16 * w, fr, fq);
#pragma unroll
                for (int vt = 0; vt < 8; ++vt) { f32x4 a2 = (f32x4){0.f, 0.f, 0.f, 0.f};
                    a2 = __builtin_amdgcn_mfma_f32_16x16x32_bf16(ka0, frag_tr(UU, 144, 0, 16 * vt, fr, fq), a2, 0, 0, 0);
                    a2 = __builtin_amdgcn_mfma_f32_16x16x32_bf16(ka1, frag_tr(UU, 144, 32, 16 * vt, fr, fq), a2, 0, 0, 0);
                    S[vt] = S[vt] * egl + a2; asm volatile("" ::: "memory"); }
            }
            __syncthreads();
            {
                const int lt_ = fresh_tid(); const int fr = lt_ & 15, fq = (lt_ & 63) >> 4; (void)fr; (void)fq;
                const int tt = w >> 1;
#pragma unroll
                for (int x = 0; x < 4; ++x) { const int vt = (w & 1) * 4 + x;
#pragma unroll
                    for (int j = 0; j < 4; ++j) OT[(16 * tt + 4 * fq + j) * 132 + 16 * vt + fr] = oacc[x][j]; }
            }
            __syncthreads();
            {
                const int lt2_ = fresh_tid(); const int r = lt2_ >> 3, seg = lt2_ & 7; const float* op = OT + r * 132 + seg * 16;
                f32x4 v[4]; float ss = 0.f;
#pragma unroll
                for (int i = 0; i < 4; ++i) { v[i] = *(const f32x4*)(op + 4 * i); ss += v[i][0] * v[i][0] + v[i][1] * v[i][1] + v[i][2] * v[i][2] + v[i][3] * v[i][3]; }
                ss += __shfl_xor(ss, 1); ss += __shfl_xor(ss, 2); ss += __shfl_xor(ss, 4);
                const float rn = rsqrtf(ss * (1.f / 128.f) + EPS);
                bf16_t* zp = Zs + (size_t)(trow0 + r) * 4096 + vh * 128 + seg * 16;
#pragma unroll
                for (int i = 0; i < 2; ++i) { const u32x4 zz = *(const u32x4*)(zp + 8 * i); const f32x4 h0 = *(const f32x4*)(hn + seg * 16 + 8 * i), h1 = *(const f32x4*)(hn + seg * 16 + 8 * i + 4);
                    f32x4 o0 = v[2 * i] * rn * h0, o1 = v[2 * i + 1] * rn * h1;
                    o0[0] *= __uint_as_float(zz.x << 16); o0[1] *= __uint_as_float(zz.x & 0xffff0000u); o0[2] *= __uint_as_float(zz.y << 16); o0[3] *= __uint_as_float(zz.y & 0xffff0000u);
                    o1[0] *= __uint_as_float(zz.z << 16); o1[1] *= __uint_as_float(zz.z & 0xffff0000u); o1[2] *= __uint_as_float(zz.w << 16); o1[3] *= __uint_as_float(zz.w & 0xffff0000u);
                    *(u32x4*)(zp + 8 * i) = pack8(o0, o1); }
            }
        }
    }
}

constexpr int KS_STRIDE = 200, VS_STRIDE = 144;
__device__ __forceinline__ void attn_tile(bf16_t* Ks, bf16_t* Vs, unsigned char* ws, int b, int h, int qt) {
    const int tid = fresh_tid(), lane = tid & 63, wv = __builtin_amdgcn_readfirstlane(tid >> 6), fr = lane & 15, fq = lane >> 4;
    const bf16_t* Q = (const bf16_t*)(ws + WS_BIG); const bf16_t* KV = (const bf16_t*)(ws + WS_BIG + 96 * MiB); const bf16_t* KR = (const bf16_t*)(ws + WS_Z + 96 * MiB);
    bf16_t* Zs = (bf16_t*)(ws + WS_Z);
    const int row = b * SEQ + qt * 128 + wv * 16 + fr;
    bf16x8 qf[6];
#pragma unroll
    for (int s = 0; s < 6; ++s) qf[s] = *(const bf16x8*)(Q + (size_t)row * 3072 + h * 192 + 32 * s + 8 * fq);
    f32x4 acc[8];
#pragma unroll
    for (int i = 0; i < 8; ++i) acc[i] = (f32x4){0.f, 0.f, 0.f, 0.f};
    float mrun = -INFINITY, lsum = 0.f;
    const int ntiles = 2 * qt + 2, myn = (wv < 4) ? 2 * qt + 1 : 2 * qt + 2;
    for (int kt = 0; kt < ntiles; ++kt) {
        __syncthreads();
        {
            const size_t krow0 = (size_t)(b * SEQ + kt * 64);
#pragma unroll
            for (int i = 0; i < 2; ++i) { const int ch = tid + 512 * i, r = ch >> 4, cc = ch & 15;
                *(u32x4*)(Ks + r * KS_STRIDE + cc * 8) = *(const u32x4*)(KV + (krow0 + r) * 4096 + h * 256 + cc * 8);
                *(u32x4*)(Vs + r * VS_STRIDE + cc * 8) = *(const u32x4*)(KV + (krow0 + r) * 4096 + h * 256 + 128 + cc * 8); }
            { const int r = tid >> 3, cc = tid & 7; *(u32x4*)(Ks + r * KS_STRIDE + 128 + cc * 8) = *(const u32x4*)(KR + (krow0 + r) * 64 + cc * 8); }
        }
        __syncthreads();
        if (kt < myn) {
            f32x4 s[4];
#pragma unroll
            for (int nt = 0; nt < 4; ++nt) { s[nt] = (f32x4){0.f, 0.f, 0.f, 0.f};
#pragma unroll
                for (int st = 0; st < 6; ++st) { const bf16x8 kf = *(const bf16x8*)(Ks + (16 * nt + fr) * KS_STRIDE + 32 * st + 8 * fq);
                    s[nt] = __builtin_amdgcn_mfma_f32_16x16x32_bf16(kf, qf[st], s[nt], 0, 0, 0); } }
            float mx = s[0][0];
#pragma unroll
            for (int nt = 0; nt < 4; ++nt)
#pragma unroll
                for (int j = 0; j < 4; ++j) mx = fmaxf(mx, s[nt][j]);
            mx = fmaxf(mx, __shfl_xor(mx, 16)); mx = fmaxf(mx, __shfl_xor(mx, 32));
            const float mnew = fmaxf(mrun, mx), alpha = __expf(mrun - mnew); mrun = mnew;
            float ps = 0.f;
#pragma unroll
            for (int nt = 0; nt < 4; ++nt)
#pragma unroll
                for (int j = 0; j < 4; ++j) { s[nt][j] = __expf(s[nt][j] - mnew); ps += s[nt][j]; }
            lsum = lsum * alpha + ps;
#pragma unroll
            for (int i = 0; i < 8; ++i) acc[i] *= alpha;
            bf16x8 pf[2];
#pragma unroll
            for (int s2 = 0; s2 < 2; ++s2) { const u32x4 w = pack8(s[2 * s2], s[2 * s2 + 1]); pf[s2] = __builtin_bit_cast(bf16x8, w); }
            const int tq = fr >> 2, tp = fr & 3;
#pragma unroll
            for (int vt = 0; vt < 8; ++vt)
#pragma unroll
                for (int s2 = 0; s2 < 2; ++s2) { const bf16_t* vp = Vs + (32 * s2 + 4 * fq + tq) * VS_STRIDE + 16 * vt + 4 * tp;
                    const s16x4 r0 = tr_read(vp), r1 = tr_read(vp + 16 * VS_STRIDE);
                    const bf16x8 vf = (bf16x8){r0[0], r0[1], r0[2], r0[3], r1[0], r1[1], r1[2], r1[3]};
                    acc[vt] = __builtin_amdgcn_mfma_f32_16x16x32_bf16(vf, pf[s2], acc[vt], 0, 0, 0); }
        }
    }
    lsum += __shfl_xor(lsum, 16); lsum += __shfl_xor(lsum, 32);
    const float inv = 1.f / lsum;
#pragma unroll
    for (int vt = 0; vt < 8; ++vt) { bf16_t* zp = Zs + (size_t)row * 2048 + h * 128 + 16 * vt + 4 * fq; const u32x2 zz = *(const u32x2*)zp;
        const float z0 = __uint_as_float(zz.x << 16), z1 = __uint_as_float(zz.x & 0xffff0000u), z2 = __uint_as_float(zz.y << 16), z3 = __uint_as_float(zz.y & 0xffff0000u);
        u32x2 w; w.x = pg8::cvt_pk_bf16(acc[vt][0] * inv * z0, acc[vt][1] * inv * z1); w.y = pg8::cvt_pk_bf16(acc[vt][2] * inv * z2, acc[vt][3] * inv * z3); *(u32x2*)zp = w; }
}
__device__ __forceinline__ void attn_phase(unsigned char* lds, unsigned char* ws) {
    bf16_t* Ks = (bf16_t*)lds; bf16_t* Vs = (bf16_t*)(lds + 64 * KS_STRIDE * 2);
    for (int p = blockIdx.x; p < 1024; p += gridDim.x) { const int bh = p >> 3, pr = p & 7;
        attn_tile(Ks, Vs, ws, bh >> 4, bh & 15, 15 - pr);
        attn_tile(Ks, Vs, ws, bh >> 4, bh & 15, pr); }
}

__device__ __forceinline__ void prep_tables(const Params& P) {
    unsigned char* ws = P.ws; const int gt = blockIdx.x * 512 + fresh_tid(), ng = gridDim.x * 512;
    const int* pos = (const int*)P.in[1]; float* COS = (float*)(ws + WS_COS); float* SIN = (float*)(ws + WS_SIN);
    for (int i = gt; i < MTOK * 32; i += ng) { const int row = i >> 5, j = i & 31;
        const float invf = __builtin_amdgcn_exp2f(-(float)j * (13.287712379549449f / 32.f));
        const float ang = (float)pos[row] * invf;
        double t = (double)ang * 0.15915494309189535; t -= floor(t); const float tf = (float)t;
        COS[i] = __builtin_amdgcn_cosf(tf); SIN[i] = __builtin_amdgcn_sinf(tf); }
    const float* lbp = (const float*)P.in[2]; float* LB = (float*)(ws + WS_LB);
    for (int c = gt; c < 2048; c += ng) { const float a0 = lbp[c], a1 = lbp[2048 + c], a2 = lbp[4096 + c], a3 = lbp[6144 + c];
        const float mx = fmaxf(fmaxf(a0, a1), fmaxf(a2, a3)); const float e0 = expf(a0 - mx), e1 = expf(a1 - mx), e2 = expf(a2 - mx), e3 = expf(a3 - mx); const float sm = e0 + e1 + e2 + e3;
        LB[c] = 0.f; LB[2048 + c] = (e1 + e2 + e3) / sm; }
}

struct CvM { const float* W; int K, Ns, Nd, mode; bf16_t* dst; const float* rs; float cs; };
__device__ __forceinline__ bool cv_get(const Params& P, int cv, int sub, CvM& m) {
#define FIN(i) ((const float*)P.in[i])
    bf16_t* RW = (bf16_t*)(P.ws + WS_RW); bf16_t* U = (bf16_t*)(P.ws + WS_U);
    m.rs = nullptr; m.cs = 1.f; m.mode = MAP_ID;
    if (sub > 0 && cv != 2) return false;
    switch (cv) {
        case 0: m.W = FIN(5);  m.K = 2048; m.Ns = 8192;  m.Nd = 8192;  m.dst = RW; return true;
        case 1: m.W = FIN(7);  m.K = 2048; m.Ns = 2048;  m.Nd = 2048;  m.dst = U;  return true;
        case 2:
            if (sub == 0) { m.W = FIN(10); m.K = 2048; m.Ns = 3136; m.Nd = 3328; m.mode = MAP_MLAIN; m.dst = RW; return true; }
            if (sub == 1) { m.W = FIN(13); m.K = 512; m.Ns = 3072; m.Nd = 3072; m.mode = MAP_UQ; m.dst = RW + (size_t)3328 * 2048; m.rs = FIN(11); m.cs = 0.07216878364870323f; return true; }
            if (sub == 2) { m.W = FIN(14); m.K = 512; m.Ns = 4096; m.Nd = 4096; m.dst = RW + (size_t)3328 * 2048 + (size_t)3072 * 512; m.rs = FIN(12); return true; }
            return false;
        case 3: m.W = FIN(15); m.K = 2048; m.Ns = 2048;  m.Nd = 2048;  m.dst = U;  return true;
        case 4: m.W = FIN(18); m.K = 2048; m.Ns = 12352; m.Nd = 12544; m.dst = RW; return true;
        case 5: m.W = FIN(23); m.K = 4096; m.Ns = 2048;  m.Nd = 2048;  m.dst = U;  return true;
        case 6: m.W = FIN(26); m.K = 2048; m.Ns = 8192;  m.Nd = 8192;  m.dst = RW; return true;
        case 7: m.W = FIN(28); m.K = 2048; m.Ns = 2048;  m.Nd = 2048;  m.dst = U;  return true;
        default: return false;
    }
}

__global__ void __launch_bounds__(512) trunk_fwd(Params P) {
    extern __shared__ __attribute__((aligned(16))) unsigned char lds[];
    cg::grid_group grid = cg::this_grid();
    unsigned char* ws = P.ws; LAS unsigned char* L3 = (LAS unsigned char*)lds; float* Lf = (float*)lds;
    const int bi = blockIdx.x, nb = gridDim.x;
    bf16_t* RW = (bf16_t*)(ws + WS_RW); bf16_t* U = (bf16_t*)(ws + WS_U);
    const bf16_t* Z0 = (const bf16_t*)(ws + WS_Z); const bf16_t* Z64 = (const bf16_t*)(ws + WS_Z + 64 * MiB); const bf16_t* Z80 = (const bf16_t*)(ws + WS_Z + 80 * MiB);
    const float* YB = (const float*)(ws + WS_BIG); const float* LB = (const float*)(ws + WS_LB);
    for (int st = P.ph_lo; st < P.ph_hi; ++st) {
        int cv = -1, rowk = 0, gm = -1, gN = 0, gK = 0, mix = 0; bool sync_after = true, tables = false;
        const float *r_h = nullptr, *r_y = nullptr, *r_post = nullptr, *r_pre = nullptr, *hn = nullptr, *lbp = LB;
        const bf16_t *gA = nullptr, *gB = nullptr;
        switch (st) {
            case 0:  tables = true; rowk = 1; r_h = FIN(0); r_pre = FIN(3); cv = 0; break;
            case 1:  gm = EM_HG; gA = U; gB = RW; gN = 8192; gK = 2048; lbp = LB; break;
            case 2:  cv = 1; mix = 1; hn = FIN(6); break;
            case 3:  gm = EM_OUT; gA = Z64; gB = U; gN = 2048; gK = 2048; break;
            case 4:  rowk = 1; r_h = FIN(0); r_y = YB; r_post = FIN(4); r_pre = FIN(8); cv = 2; break;
            case 5:  gm = EM_MLAIN; gA = U; gB = RW; gN = 3328; gK = 2048; break;
            case 6:  gm = EM_Q; gA = Z64; gB = RW + (size_t)3328 * 2048; gN = 3072; gK = 512; sync_after = false; break;
            case 7:  gm = EM_KV; gA = Z80; gB = RW + (size_t)3328 * 2048 + (size_t)3072 * 512; gN = 4096; gK = 512; break;
            case 8:  cv = 3; mix = 2; break;
            case 9:  gm = EM_OUT; gA = Z0; gB = U; gN = 2048; gK = 2048; break;
            case 10: rowk = 1; r_h = P.out; r_y = YB; r_post = FIN(9); r_pre = FIN(16); cv = 4; break;
            case 11: gm = EM_GDN; gA = U; gB = RW; gN = 12544; gK = 2048; break;
            case 12: cv = 5; mix = 3; hn = FIN(22); break;
            case 13: gm = EM_OUT; gA = Z0; gB = U; gN = 2048; gK = 4096; break;
            case 14: rowk = 1; r_h = P.out; r_y = YB; r_post = FIN(17); r_pre = FIN(24); cv = 6; break;
            case 15: gm = EM_HG; gA = U; gB = RW; gN = 8192; gK = 2048; lbp = LB + 2048; break;
            case 16: cv = 7; mix = 1; hn = FIN(27); break;
            case 17: gm = EM_OUT; gA = Z64; gB = U; gN = 2048; gK = 2048; break;
            default: rowk = 1; r_h = P.out; r_y = YB; r_post = FIN(25); r_pre = nullptr; break;
        }
        if (tables) prep_tables(P);
        if (rowk) row_phase(r_h, r_y, r_post, r_pre, P.out, U);
        if (cv >= 0) { for (int sub = 0; sub < 3; ++sub) { CvM m; if (!cv_get(P, cv, sub, m)) break; convert_w(Lf, m.W, m.K, m.Ns, m.dst, m.Nd, m.mode, m.rs, m.cs, bi, nb); } }
        if (gm >= 0) { Epi E; E.mode = gm;
#ifdef ONLY_MODE
            E.mode = ONLY_MODE;
#endif
 E.ws = ws; E.lb = lbp; E.alog = FIN(20); E.dtb = FIN(21); run_gemm(L3, gA, gB, gN, gK, E); }
#ifndef DIS_GLA
        if (mix == 1) gla_chunked(lds, ws, hn);
#endif
#ifndef DIS_ATTN
        if (mix == 2) attn_phase(lds, ws);
#endif
#ifndef DIS_GDN
        if (mix == 3) gdn_chunked(lds, ws, FIN(19), hn);
#endif
        if (sync_after && st + 1 < P.ph_hi) grid.sync();
    }
#ifdef PROBE_N
    grid.sync();
    { const unsigned short* U16 = (const unsigned short*)(ws + WS_U); const unsigned short* B16 = (const unsigned short*)(ws + WS_BIG); const unsigned short* Z16 = (const unsigned short*)(ws + WS_Z);
      const unsigned short* S16 = (const unsigned short*)(ws + WS_SM); const unsigned short* R16 = (const unsigned short*)(ws + WS_RW);
      const size_t n = (size_t)MTOK * DM; for (size_t i = (size_t)blockIdx.x * 512 + threadIdx.x; i < n; i += (size_t)gridDim.x * 512) {
        unsigned a = U16[i]; a = a * 2654435761u + B16[i]; a = a * 2654435761u + B16[i + n]; a = a * 2654435761u + B16[i + 2 * n]; a = a * 2654435761u + B16[i + 3 * n]; a = a * 2654435761u + Z16[i]; a = a * 2654435761u + Z16[i + n];
        if (i < 4 * MiB) a = a * 2654435761u + S16[i]; if (i < 25 * MiB) a = a * 2654435761u + R16[i];
        a ^= a >> 15; a *= 2246822519u; a ^= a >> 13;
        P.out[i] = (float)(a & 0xFFFFu); } }
#endif
#undef FIN
}

extern "C" void kernel_launch(void* const* d_in, const int* in_sizes, int n_in, void* d_out, int out_size, void* d_ws, size_t ws_size, hipStream_t stream) {
    static int grid_blocks = 0;
    if (grid_blocks == 0) {
        if (n_in != 29 || ws_size < WS_END) { fprintf(stderr, "kernel_launch: need 29 inputs and %zu bytes of workspace; got %d, %zu\n", (size_t)WS_END, n_in, ws_size); grid_blocks = -1; return; }
        int dev = 0, cus = 0, per_cu = 0;
        hipGetDevice(&dev); hipDeviceGetAttribute(&cus, hipDeviceAttributeMultiprocessorCount, dev);
        if (hipFuncSetAttribute((const void*)trunk_fwd, hipFuncAttributeMaxDynamicSharedMemorySize, LDS_BYTES) != hipSuccess) { fprintf(stderr, "hipFuncSetAttribute failed\n"); grid_blocks = -1; return; }
        if (hipOccupancyMaxActiveBlocksPerMultiprocessor(&per_cu, (const void*)trunk_fwd, 512, LDS_BYTES) != hipSuccess || per_cu < 1) { fprintf(stderr, "occupancy query failed (%d)\n", per_cu); per_cu = 1; }
        (void)hipGetLastError();
        grid_blocks = cus * 1;
    }
    if (grid_blocks < 0) return;
    Params p{};
    for (int i = 0; i < 29; ++i) p.in[i] = d_in[i];
    p.out = (float*)d_out; p.ws = (unsigned char*)d_ws;
#if PER_PHASE_LAUNCH
    for (int ph = 0; ph < NPHASE; ++ph) {
        p.ph_lo = ph; p.ph_hi = ph + 1; void* args[] = {&p};
        hipError_t e = hipLaunchCooperativeKernel((const void*)trunk_fwd, dim3(grid_blocks), dim3(512), args, LDS_BYTES, stream);
        if (e != hipSuccess) { fprintf(stderr, "launch failed: %s\n", hipGetErrorString(e)); break; }
    }
#else
#ifdef PROBE_N
    p.ph_lo = 0; p.ph_hi = PROBE_N; void* args[] = {&p};
#else
    p.ph_lo = 0; p.ph_hi = NPHASE; void* args[] = {&p};
#endif
    hipError_t e = hipLaunchCooperativeKernel((const void*)trunk_fwd, dim3(grid_blocks), dim3(512), args, LDS_BYTES, stream);
    if (e != hipSuccess) fprintf(stderr, "cooperative launch failed: %s (grid %d)\n", hipGetErrorString(e), grid_blocks);
#endif
}
```

```cpp
#include <hip/hip_runtime.h>
#include <hip/hip_cooperative_groups.h>
#include <cstdio>
namespace cg = cooperative_groups;
namespace pg8 {
#define PG8_LAS __attribute__((address_space(3)))
typedef unsigned short bf16_t;
typedef short bf16x8 __attribute__((ext_vector_type(8)));
typedef float f32x4 __attribute__((ext_vector_type(4)));
typedef unsigned u32x4 __attribute__((ext_vector_type(4)));
constexpr int BM = 256, BK = 64, HALF = 128, HTB = HALF * BK * 2  , STAGE_BYTES = 8 * HTB, NXCD = 8, WGM = 8;

__host__ __device__ __forceinline__ int lds_byte(int r, int c) { const int st = (r >> 4) * 2 + (c >> 5), rr = r & 15, cc = c & 31, ob = rr * 64 + cc * 2; return st * 1024 + (ob ^ (((ob >> 9) & 1) << 5)); }
__host__ __device__ __forceinline__ void stage_rc(int b, int& R, int& C) { const int st = b / 1024, sb = b % 1024, swz = sb ^ (((sb >> 9) & 1) << 5); R = (st >> 1) * 16 + swz / 64; C = (st & 1) * 32 + (swz % 64) / 2; }
__host__ __device__ __forceinline__ int perm32(int rho) { const int n = rho >> 4, i = rho & 15; return 8 * (i >> 2) + 4 * n + (i & 3); }

struct Unit { int pm, pn; };
struct Gemm { const bf16_t* A; const bf16_t* Bt; int M, N, K; };
struct StaticOrder {
    int nM, nN, nwg, G, c;
    __host__ __device__ void init(int M, int N, int G_, int c_) { nM = M / BM; nN = N / BM; nwg = nM * nN; G = G_; c = c_; }
    __host__ __device__ bool next(int i, Unit& u) const {
        const long L = (long)i * G + c; if (L >= nwg) return false;
        int wgid = (int)L; { const int q = nwg / NXCD, r = nwg % NXCD, xcd = wgid % NXCD, off = wgid / NXCD; wgid = (xcd < r ? xcd * (q + 1) : r * (q + 1) + (xcd - r) * q) + off; }
        const int nig = WGM * nN, gid = wgid / nig, fm = gid * WGM, gsz = (nM - fm) < WGM ? (nM - fm) : WGM;
        u.pm = fm + ((wgid % nig) % gsz); u.pn = (wgid % nig) / gsz; return true;
    }
    __device__ __forceinline__ void a_ready(const Unit&) const {}
    __device__ __forceinline__ void done(const Unit&) const {}
};
__device__ __forceinline__ unsigned cvt_pk_bf16(float lo, float hi) { unsigned r; asm("v_cvt_pk_bf16_f32 %0, %1, %2" : "=v"(r) : "v"(lo), "v"(hi)); return r; }
template <class Epi, class Sched>
__device__ __forceinline__ void gemm_phase(PG8_LAS unsigned char* lds, const Gemm g, const Sched& S, const Epi& E) {
    int tid_l_ = threadIdx.x; asm volatile("" : "+v"(tid_l_)); const int tid = tid_l_, wid = __builtin_amdgcn_readfirstlane(tid >> 6), lane = tid & 63, wr = wid >> 2, wc = wid & 3, fr = lane & 15, fq = lane >> 4;
    const int K = g.K, nt = K / BK;
    unsigned voffA[2], voffB[2];
#pragma unroll
    for (int i = 0; i < 2; ++i) { int R, C; stage_rc(tid * 16 + i * 8192, R, C); const int Rb = Epi::PERM ? ((R & ~31) + perm32(R & 31)) : R;
        voffA[i] = (unsigned)(R * K + C) * 2u; voffB[i] = (unsigned)(Rb * K + C) * 2u; }
    const size_t kstep = (size_t)(BK * 2);
    const size_t hstep = (size_t)HALF * K * 2;
    const size_t tstep = 2 * hstep;
    const unsigned ldsw = (unsigned)wid * 1024u;
    const int aoff = lds_byte(wr * 64 + fr, fq * 8), boff = lds_byte(wc * 32 + fr, fq * 8);
#define PG8_SA(b, h) (((b) * 2 + (h)) * HTB)
#define PG8_SB(b, h) ((4 + (b) * 2 + (h)) * HTB)
#define PG8_STAGE(bufoff, gbase, voff) do { _Pragma("unroll") for (int _i = 0; _i < 2; ++_i) \
        __builtin_amdgcn_global_load_lds((const unsigned*)((const char*)(gbase) + (voff)[_i]), (PG8_LAS unsigned*)(lds + (bufoff) + ldsw + _i * 8192), 16, 0, 0); } while (0)
#define PG8_LDA(dst, b, h) do { _Pragma("unroll") for (int m = 0; m < 4; ++m) _Pragma("unroll") for (int k = 0; k < 2; ++k) dst[m][k] = *(const PG8_LAS bf16x8*)(lds + PG8_SA(b, h) + aoff + m * 2048 + k * 1024); } while (0)
#define PG8_LDB(dst, b, h) do { _Pragma("unroll") for (int n = 0; n < 2; ++n) _Pragma("unroll") for (int k = 0; k < 2; ++k) dst[n][k] = *(const PG8_LAS bf16x8*)(lds + PG8_SB(b, h) + boff + n * 2048 + k * 1024); } while (0)
#define PG8_MMA(ai, bj, At, Bt) do { __builtin_amdgcn_s_setprio(1); _Pragma("unroll") for (int m = 0; m < 4; ++m) _Pragma("unroll") for (int n = 0; n < 2; ++n) _Pragma("unroll") for (int k = 0; k < 2; ++k) \
        acc[ai][bj][m][n] = __builtin_amdgcn_mfma_f32_16x16x32_bf16(Bt[n][k], At[m][k], acc[ai][bj][m][n], 0, 0, 0); __builtin_amdgcn_s_setprio(0); } while (0)
#define PG8_WAIT_V(n) asm volatile("s_waitcnt vmcnt(" #n ")" ::: "memory")
#define PG8_WAIT_L(n) asm volatile("s_waitcnt lgkmcnt(" #n ")" ::: "memory")
#define PG8_BAR __builtin_amdgcn_s_barrier()
#define PG8_SCHED __builtin_amdgcn_sched_barrier(0)
    Unit cur, nxt; int ui = 0;
    if (!S.next(0, cur)) return;
    f32x4 acc[2][2][4][2];
#pragma unroll
    for (int a = 0; a < 2; ++a)
#pragma unroll
        for (int b = 0; b < 2; ++b)
#pragma unroll
            for (int m = 0; m < 4; ++m)
#pragma unroll
                for (int n = 0; n < 2; ++n) acc[a][b][m][n] = (f32x4){0.f, 0.f, 0.f, 0.f};
    bf16x8 At[4][2], B0[2][2], B1[2][2];
    const char* cA = (const char*)g.A + (size_t)cur.pm * tstep; const char* cB = (const char*)g.Bt + (size_t)cur.pn * tstep;
    S.a_ready(cur);
    PG8_STAGE(PG8_SB(0, 0), cB, voffB); PG8_STAGE(PG8_SA(0, 0), cA, voffA); PG8_STAGE(PG8_SB(0, 1), cB + hstep, voffB); PG8_STAGE(PG8_SA(0, 1), cA + hstep, voffA);
    if (wr == 1) PG8_BAR;
    PG8_WAIT_V(4); PG8_BAR;
    PG8_STAGE(PG8_SB(1, 0), cB + kstep, voffB); PG8_STAGE(PG8_SA(1, 0), cA + kstep, voffA); PG8_STAGE(PG8_SB(1, 1), cB + hstep + kstep, voffB);
    PG8_WAIT_V(6); PG8_BAR;
    for (;;) {
        const bool has_next = S.next(ui + 1, nxt);
        const char* nA = has_next ? (const char*)g.A + (size_t)nxt.pm * tstep : cA; const char* nB = has_next ? (const char*)g.Bt + (size_t)nxt.pn * tstep : cB;
        for (int t = 0; t < nt; t += 2) {
            const bool last = (t == nt - 2);
            const char* a1 = cA + (size_t)(t + 1) * kstep;
            const char* a2 = last ? nA : cA + (size_t)(t + 2) * kstep; const char* b2 = last ? nB : cB + (size_t)(t + 2) * kstep;
            const char* a3 = a2 + kstep; const char* b3 = b2 + kstep;
            if (last && has_next) S.a_ready(nxt);
            PG8_LDB(B0, 0, 0); PG8_SCHED; PG8_LDA(At, 0, 0); PG8_STAGE(PG8_SA(1, 1), a1 + hstep, voffA);
            PG8_WAIT_L(8); PG8_BAR; PG8_WAIT_L(0); PG8_MMA(0, 0, At, B0); PG8_BAR; PG8_SCHED;
            PG8_LDB(B1, 0, 1); PG8_STAGE(PG8_SB(0, 0), b2, voffB);
            PG8_BAR; PG8_WAIT_L(0); PG8_MMA(0, 1, At, B1); PG8_BAR;
            PG8_LDA(At, 0, 1); PG8_STAGE(PG8_SA(0, 0), a2, voffA);
            PG8_BAR; PG8_WAIT_L(0); PG8_MMA(1, 0, At, B0); PG8_BAR; PG8_SCHED;
            PG8_STAGE(PG8_SB(0, 1), b2 + hstep, voffB);
            PG8_WAIT_V(6); PG8_BAR; PG8_MMA(1, 1, At, B1); PG8_BAR;
            PG8_LDB(B0, 1, 0); PG8_SCHED; PG8_LDA(At, 1, 0); PG8_STAGE(PG8_SA(0, 1), a2 + hstep, voffA);
            PG8_WAIT_L(8); PG8_BAR; PG8_WAIT_L(0); PG8_MMA(0, 0, At, B0); PG8_BAR; PG8_SCHED;
            PG8_LDB(B1, 1, 1); PG8_STAGE(PG8_SB(1, 0), b3, voffB);
            PG8_BAR; PG8_WAIT_L(0); PG8_MMA(0, 1, At, B1); PG8_BAR;
            PG8_LDA(At, 1, 1); PG8_STAGE(PG8_SA(1, 0), a3, voffA);
            PG8_BAR; PG8_WAIT_L(0); PG8_MMA(1, 0, At, B0); PG8_BAR; PG8_SCHED;
            PG8_STAGE(PG8_SB(1, 1), b3 + hstep, voffB);
            PG8_WAIT_V(6); PG8_BAR; PG8_MMA(1, 1, At, B1); PG8_BAR;
        }
        if constexpr (!Epi::AFTER_DRAIN) { E(acc, cur, wr, wc, fr, fq); S.done(cur); }
        if (!has_next) break;
#pragma unroll
        for (int a = 0; a < 2; ++a)
#pragma unroll
            for (int b = 0; b < 2; ++b)
#pragma unroll
                for (int m = 0; m < 4; ++m)
#pragma unroll
                    for (int n = 0; n < 2; ++n) acc[a][b][m][n] = (f32x4){0.f, 0.f, 0.f, 0.f};
        cur = nxt; cA = nA; cB = nB; ++ui;
    }
    PG8_WAIT_V(0);
    if (wr == 0) PG8_BAR;
    PG8_BAR;
    if constexpr (Epi::AFTER_DRAIN) { E.fused(acc, cur, wr, wc, fr, fq, lds, wid, lane); S.done(cur); }
#undef PG8_SA
#undef PG8_SB
#undef PG8_STAGE
#undef PG8_LDA
#undef PG8_LDB
#undef PG8_MMA
#undef PG8_WAIT_V
#undef PG8_WAIT_L
#undef PG8_BAR
#undef PG8_SCHED
}
}

#ifndef PER_PHASE_LAUNCH
#define PER_PHASE_LAUNCH 0
#endif

#define LAS __attribute__((address_space(3)))
typedef unsigned short bf16_t;
typedef short bf16x8 __attribute__((ext_vector_type(8)));
typedef short s16x4 __attribute__((ext_vector_type(4)));
typedef float f32x4 __attribute__((ext_vector_type(4)));
typedef unsigned u32x4 __attribute__((ext_vector_type(4)));
typedef unsigned u32x2 __attribute__((ext_vector_type(2)));

constexpr int MTOK = 16384, DM = 2048, SEQ = 2048;
constexpr float EPS = 1e-6f;
constexpr size_t MiB = 1ull << 20;
constexpr size_t WS_RW = 0;
constexpr size_t WS_U = 50 * MiB;
constexpr size_t WS_BIG = 114 * MiB;
constexpr size_t WS_Z = 370 * MiB;
constexpr size_t WS_SM = 498 * MiB;
constexpr size_t WS_COS = WS_SM, WS_SIN = WS_SM + 2 * MiB, WS_GD = WS_SM + 4 * MiB, WS_BD = WS_SM + 6 * MiB;
constexpr size_t WS_SSQ = WS_SM + 8 * MiB;
constexpr size_t WS_LB = WS_SM + 9 * MiB;
constexpr size_t WS_BAR = WS_LB + 16384;
constexpr size_t WS_END = WS_SM + 9 * MiB + 65536;
constexpr int LDS_BYTES = 163088;
constexpr int NPHASE = 19;

struct Params { const void* in[29]; float* out; unsigned char* ws; int ph_lo, ph_hi; };

__device__ __forceinline__ int fresh_tid() { int t = threadIdx.x; asm volatile("" : "+v"(t)); return t; }
__device__ __forceinline__ float bf2f(bf16_t v) { return __uint_as_float(((unsigned)v) << 16); }
__device__ __forceinline__ bf16_t f2bf(float f) { return (bf16_t)(pg8::cvt_pk_bf16(f, f) & 0xffffu); }
__device__ __forceinline__ float siluf(float x) { return x * __builtin_amdgcn_rcpf(1.f + __expf(-x)); }
__device__ __forceinline__ float sigmf(float x) { return __builtin_amdgcn_rcpf(1.f + __expf(-x)); }
__device__ __forceinline__ float wave_sum(float v) {
#pragma unroll
    for (int o = 32; o >= 1; o >>= 1) v += __shfl_xor(v, o);
    return v;
}
__device__ __forceinline__ u32x4 pack8(const f32x4 a, const f32x4 b) {
    u32x4 w; w.x = pg8::cvt_pk_bf16(a[0], a[1]); w.y = pg8::cvt_pk_bf16(a[2], a[3]); w.z = pg8::cvt_pk_bf16(b[0], b[1]); w.w = pg8::cvt_pk_bf16(b[2], b[3]); return w;
}

enum { MAP_ID = 0, MAP_MLAIN = 1, MAP_UQ = 2 };
__device__ __forceinline__ int map_src(int mode, int n, int nsrc) {
    if (mode == MAP_MLAIN) { if (n < 1024) return n; if (n < 3072) return n + 64; if (n < 3136) { const int j = n - 3072; return 1024 + (j >> 1) + 32 * (j & 1); } return -1; }
    if (mode == MAP_UQ) { const int hd = n / 192, c = n - hd * 192; if (c < 128) return n; const int j = c - 128; return hd * 192 + 128 + (j >> 1) + 32 * (j & 1); }
    return n < nsrc ? n : -1;
}
__device__ __forceinline__ void convert_w(float* tile, const float* W, int K, int Nsrc, bf16_t* Bt, int Ndst, int mode, const float* rowscale, float cscale, int bi, int nb) {
    const int tid = fresh_tid();
    const int tk = K / 64, nt = tk * (Ndst / 64);
    const int j = tid & 63, i0 = tid >> 6;
    float v[8];
#define CW_LOAD(tt) do { const int n0_ = ((tt) / tk) * 64, k0_ = ((tt) % tk) * 64; const int sc_ = map_src(mode, n0_ + j, Nsrc); \
        _Pragma("unroll") for (int it = 0; it < 8; ++it) { const int k_ = k0_ + i0 + 8 * it; float x_ = 0.f; if (sc_ >= 0) { x_ = W[(size_t)k_ * Nsrc + sc_] * cscale; if (rowscale) x_ *= rowscale[k_]; } v[it] = x_; } } while (0)
    int t = bi;
    if (t < nt) CW_LOAD(t);
    for (; t < nt; t += nb) {
        const int n0 = (t / tk) * 64, k0 = (t % tk) * 64;
        __syncthreads();
#pragma unroll
        for (int it = 0; it < 8; ++it) tile[(i0 + 8 * it) * 65 + j] = v[it];
        if (t + nb < nt) CW_LOAD(t + nb);
        __syncthreads();
        {
            const int n = tid >> 3, kk = (tid & 7) * 8; u32x4 w;
            w.x = pg8::cvt_pk_bf16(tile[(kk + 0) * 65 + n], tile[(kk + 1) * 65 + n]);
            w.y = pg8::cvt_pk_bf16(tile[(kk + 2) * 65 + n], tile[(kk + 3) * 65 + n]);
            w.z = pg8::cvt_pk_bf16(tile[(kk + 4) * 65 + n], tile[(kk + 5) * 65 + n]);
            w.w = pg8::cvt_pk_bf16(tile[(kk + 6) * 65 + n], tile[(kk + 7) * 65 + n]);
            *(u32x4*)(Bt + (size_t)(n0 + n) * K + k0 + kk) = w;
        }
    }
#undef CW_LOAD
    __syncthreads();
}

__device__ __forceinline__ void row_phase(const float* hsrc, const bf16_t* Y, const float* postw, const float* prew, float* hout, bf16_t* U) {
    const int tid_ = fresh_tid(); const int lane = tid_ & 63, gw = blockIdx.x * 8 + (tid_ >> 6), nw = gridDim.x * 8;
    f32x4 hn[8]; u32x2 yn[8];
    int row = gw;
    if (row < MTOK) {
        const float* hp = hsrc + (size_t)row * DM + lane * 4;
#pragma unroll
        for (int i = 0; i < 8; ++i) hn[i] = *(const f32x4*)(hp + 256 * i);
        if (Y) { const bf16_t* yp = Y + (size_t)row * DM + lane * 4;
#pragma unroll
            for (int i = 0; i < 8; ++i) yn[i] = *(const u32x2*)(yp + 256 * i); }
    }
    for (; row < MTOK; row += nw) {
        f32x4 h[8]; u32x2 yc[8];
#pragma unroll
        for (int i = 0; i < 8; ++i) { h[i] = hn[i]; yc[i] = yn[i]; }
        const int nrow = row + nw;
        if (nrow < MTOK) {
            const float* hp = hsrc + (size_t)nrow * DM + lane * 4;
#pragma unroll
            for (int i = 0; i < 8; ++i) hn[i] = *(const f32x4*)(hp + 256 * i);
            if (Y) { const bf16_t* yp = Y + (size_t)nrow * DM + lane * 4;
#pragma unroll
                for (int i = 0; i < 8; ++i) yn[i] = *(const u32x2*)(yp + 256 * i); }
        }
        if (Y) {
            f32x4 y[8]; float ss = 0.f;
#pragma unroll
            for (int i = 0; i < 8; ++i) { const u32x2 yy = yc[i]; y[i] = (f32x4){__uint_as_float(yy.x << 16), __uint_as_float(yy.x & 0xffff0000u), __uint_as_float(yy.y << 16), __uint_as_float(yy.y & 0xffff0000u)};
                ss += y[i][0] * y[i][0] + y[i][1] * y[i][1] + y[i][2] * y[i][2] + y[i][3] * y[i][3]; }
            ss = wave_sum(ss); const float ry = rsqrtf(ss * (1.f / 2048.f) + EPS);
            float* op = hout + (size_t)row * DM + lane * 4;
#pragma unroll
            for (int i = 0; i < 8; ++i) { const f32x4 pw = *(const f32x4*)(postw + lane * 4 + 256 * i); h[i] += y[i] * ry * pw; *(f32x4*)(op + 256 * i) = h[i]; }
        }
        if (prew) {
            float ss = 0.f;
#pragma unroll
            for (int i = 0; i < 8; ++i) ss += h[i][0] * h[i][0] + h[i][1] * h[i][1] + h[i][2] * h[i][2] + h[i][3] * h[i][3];
            ss = wave_sum(ss); const float r = rsqrtf(ss * (1.f / 2048.f) + EPS);
            bf16_t* up = U + (size_t)row * DM + lane * 4;
#pragma unroll
            for (int i = 0; i < 8; ++i) { const f32x4 pw = *(const f32x4*)(prew + lane * 4 + 256 * i); const f32x4 u = h[i] * r * pw;
                u32x2 w; w.x = pg8::cvt_pk_bf16(u[0], u[1]); w.y = pg8::cvt_pk_bf16(u[2], u[3]); *(u32x2*)(up + 256 * i) = w; }
        }
    }
}

enum { EM_HG = 0, EM_MLAIN = 1, EM_Q = 2, EM_KV = 3, EM_GDN = 4, EM_OUT = 5 };
struct Epi {
    static constexpr bool PERM = true, AFTER_DRAIN = false;
    int mode;
    unsigned char* ws;
    const float* lb;
    const float* alog; const float* dtb;
    __device__ __forceinline__ void operator()(const f32x4 (&acc)[2][2][4][2], const pg8::Unit& u, int wr, int wc, int fr, int fq) const {
        asm volatile("" : "+v"(fr), "+v"(fq));
        const int rowb = u.pm * 256 + wr * 64 + fr, colw = wc * 32 + 8 * fq;
#define EPI_LOOP for (int ai = 0; ai < 2; ++ai) for (int m = 0; m < 4; ++m) { const int row = rowb + ai * 128 + m * 16; (void)row; for (int bj = 0; bj < 2; ++bj) { const int col = colw + bj * 128; (void)col; f32x4 v0 = acc[ai][bj][m][0], v1 = acc[ai][bj][m][1];
#define EPI_END } }
        if (mode == EM_OUT) {
            bf16_t* Y = (bf16_t*)(ws + WS_BIG);
#pragma unroll
            EPI_LOOP *(u32x4*)(Y + (size_t)row * 2048 + u.pn * 256 + col) = pack8(v0, v1); EPI_END
        } else if (mode == EM_KV) {
            bf16_t* KV = (bf16_t*)(ws + WS_BIG + 96 * MiB); const float* ssq = (const float*)(ws + WS_SSQ) + (size_t)MTOK * 8;
#pragma unroll
            for (int ai = 0; ai < 2; ++ai)
#pragma unroll
                for (int m = 0; m < 4; ++m) { const int row = rowb + ai * 128 + m * 16; const f32x4 p0 = *(const f32x4*)(ssq + (size_t)row * 8), p1 = *(const f32x4*)(ssq + (size_t)row * 8 + 4); const float r = rsqrtf((((p0[0] + p0[1]) + (p0[2] + p0[3])) + ((p1[0] + p1[1]) + (p1[2] + p1[3]))) * (1.f / 512.f) + EPS);
#pragma unroll
                    for (int bj = 0; bj < 2; ++bj) { const int col = colw + bj * 128; *(u32x4*)(KV + (size_t)row * 4096 + u.pn * 256 + col) = pack8(acc[ai][bj][m][0] * r, acc[ai][bj][m][1] * r); } }
        } else if (mode == EM_Q) {
            bf16_t* Q = (bf16_t*)(ws + WS_BIG); const float* ssq = (const float*)(ws + WS_SSQ);
            const float* COS = (const float*)(ws + WS_COS); const float* SIN = (const float*)(ws + WS_SIN);
#pragma unroll
            for (int ai = 0; ai < 2; ++ai)
#pragma unroll
                for (int m = 0; m < 4; ++m) { const int row = rowb + ai * 128 + m * 16; const f32x4 p0 = *(const f32x4*)(ssq + (size_t)row * 8), p1 = *(const f32x4*)(ssq + (size_t)row * 8 + 4); const float r = rsqrtf((((p0[0] + p0[1]) + (p0[2] + p0[3])) + ((p1[0] + p1[1]) + (p1[2] + p1[3]))) * (1.f / 512.f) + EPS);
#pragma unroll
                    for (int bj = 0; bj < 2; ++bj) { const int c = u.pn * 256 + colw + bj * 128; const int within = c % 192;
                        f32x4 v0 = acc[ai][bj][m][0] * r, v1 = acc[ai][bj][m][1] * r;
                        if (within >= 128) { const int j0 = (within - 128) >> 1; const f32x4 cs = *(const f32x4*)(COS + (size_t)row * 32 + j0), sn = *(const f32x4*)(SIN + (size_t)row * 32 + j0);
                            const f32x4 a = (f32x4){v0[0], v0[2], v1[0], v1[2]}, b = (f32x4){v0[1], v0[3], v1[1], v1[3]};
                            const f32x4 ra = a * cs - b * sn, rb = b * cs + a * sn;
                            v0 = (f32x4){ra[0], rb[0], ra[1], rb[1]}; v1 = (f32x4){ra[2], rb[2], ra[3], rb[3]}; }
                        *(u32x4*)(Q + (size_t)row * 3072 + c) = pack8(v0, v1); } }
        } else if (mode == EM_MLAIN) {
            if (u.pn < 4) {
                bf16_t* C = (bf16_t*)(ws + WS_Z + (u.pn < 2 ? 64 : 80) * MiB); float* ssq = (float*)(ws + WS_SSQ) + (u.pn < 2 ? (size_t)0 : (size_t)MTOK * 8); const int cb = (u.pn & 1) * 256;
#pragma unroll
                for (int ai = 0; ai < 2; ++ai)
#pragma unroll
                    for (int m = 0; m < 4; ++m) { const int row = rowb + ai * 128 + m * 16; float s = 0.f;
#pragma unroll
                        for (int bj = 0; bj < 2; ++bj) { const int col = colw + bj * 128; const f32x4 v0 = acc[ai][bj][m][0], v1 = acc[ai][bj][m][1];
                            s += v0[0] * v0[0] + v0[1] * v0[1] + v0[2] * v0[2] + v0[3] * v0[3] + v1[0] * v1[0] + v1[1] * v1[1] + v1[2] * v1[2] + v1[3] * v1[3];
                            *(u32x4*)(C + (size_t)row * 512 + cb + col) = pack8(v0, v1); }
                        s += __shfl_xor(s, 16); s += __shfl_xor(s, 32);
                        if (fq == 0) ssq[(size_t)row * 8 + (u.pn & 1) * 4 + wc] = s; }
            } else if (u.pn < 12) {
                bf16_t* Zs = (bf16_t*)(ws + WS_Z); const int cb = (u.pn - 4) * 256;
#pragma unroll
                EPI_LOOP
                    for (int e = 0; e < 4; ++e) { v0[e] = siluf(v0[e]); v1[e] = siluf(v1[e]); }
                    *(u32x4*)(Zs + (size_t)row * 2048 + cb + col) = pack8(v0, v1);
                EPI_END
            } else {
                if (colw < 64) {
                    bf16_t* KR = (bf16_t*)(ws + WS_Z + 96 * MiB); const float* COS = (const float*)(ws + WS_COS); const float* SIN = (const float*)(ws + WS_SIN);
#pragma unroll
                    for (int ai = 0; ai < 2; ++ai)
#pragma unroll
                        for (int m = 0; m < 4; ++m) { const int row = rowb + ai * 128 + m * 16; const int j0 = colw >> 1;
                            const f32x4 v0 = acc[ai][0][m][0], v1 = acc[ai][0][m][1];
                            const f32x4 cs = *(const f32x4*)(COS + (size_t)row * 32 + j0), sn = *(const f32x4*)(SIN + (size_t)row * 32 + j0);
                            const f32x4 a = (f32x4){v0[0], v0[2], v1[0], v1[2]}, b = (f32x4){v0[1], v0[3], v1[1], v1[3]};
                            const f32x4 ra = a * cs - b * sn, rb = b * cs + a * sn;
                            *(u32x4*)(KR + (size_t)row * 64 + colw) = pack8((f32x4){ra[0], rb[0], ra[1], rb[1]}, (f32x4){ra[2], rb[2], ra[3], rb[3]}); }
                }
            }
        } else if (mode == EM_HG) {
            const int region = u.pn >> 3, cb = (u.pn & 7) * 256;
            if (region == 0) {
                bf16_t* Q = (bf16_t*)(ws + WS_BIG);
#pragma unroll
                EPI_LOOP
                    for (int e = 0; e < 4; ++e) { v0[e] = siluf(v0[e]) * 0.08838834764831845f; v1[e] = siluf(v1[e]) * 0.08838834764831845f; }
                    *(u32x4*)(Q + (size_t)row * 2048 + cb + col) = pack8(v0, v1);
                EPI_END
            } else if (region == 1) {
                bf16_t* Kk = (bf16_t*)(ws + WS_BIG + 64 * MiB); float* G = (float*)(ws + WS_BIG + 128 * MiB);
#pragma unroll
                for (int bj = 0; bj < 2; ++bj) { const int col = colw + bj * 128; const f32x4 l0 = *(const f32x4*)(lb + cb + col), l1 = *(const f32x4*)(lb + cb + col + 4);
#pragma unroll
                    for (int ai = 0; ai < 2; ++ai)
#pragma unroll
                        for (int m = 0; m < 4; ++m) { const int row = rowb + ai * 128 + m * 16; const f32x4 v0 = acc[ai][bj][m][0], v1 = acc[ai][bj][m][1]; f32x4 g0, g1, k0, k1;
#pragma unroll
                            for (int e = 0; e < 4; ++e) {
                                { const float f = v0[e], l = l0[e], en = __expf(-fabsf(f)), ls = fminf(f, 0.f) - __logf(1.f + en), sg = __expf(ls);
                                  g0[e] = (l == 0.f) ? ls : __logf(l + (1.f - l) * sg); k0[e] = (1.f - l) * (1.f - sg); }
                                { const float f = v1[e], l = l1[e], en = __expf(-fabsf(f)), ls = fminf(f, 0.f) - __logf(1.f + en), sg = __expf(ls);
                                  g1[e] = (l == 0.f) ? ls : __logf(l + (1.f - l) * sg); k1[e] = (1.f - l) * (1.f - sg); } }
                            float* gp = G + (size_t)row * 2048 + cb + col; *(f32x4*)gp = g0; *(f32x4*)(gp + 4) = g1;
                            *(u32x4*)(Kk + (size_t)row * 2048 + cb + col) = pack8(k0, k1); } }
            } else if (region == 2) {
                bf16_t* V = (bf16_t*)(ws + WS_Z);
#pragma unroll
                EPI_LOOP *(u32x4*)(V + (size_t)row * 2048 + cb + col) = pack8(v0, v1); EPI_END
            } else {
                bf16_t* Zs = (bf16_t*)(ws + WS_Z + 64 * MiB);
#pragma unroll
                EPI_LOOP
                    for (int e = 0; e < 4; ++e) { v0[e] = siluf(v0[e]); v1[e] = siluf(v1[e]); }
                    *(u32x4*)(Zs + (size_t)row * 2048 + cb + col) = pack8(v0, v1);
                EPI_END
            }
        } else if (mode == EM_GDN) {
            if (u.pn < 32) {
                bf16_t* QKV = (bf16_t*)(ws + WS_BIG);
#pragma unroll
                EPI_LOOP *(u32x4*)(QKV + (size_t)row * 8192 + u.pn * 256 + col) = pack8(v0, v1); EPI_END
            } else if (u.pn < 48) {
                bf16_t* Zs = (bf16_t*)(ws + WS_Z); const int cb = (u.pn - 32) * 256;
#pragma unroll
                EPI_LOOP
                    for (int e = 0; e < 4; ++e) { v0[e] = siluf(v0[e]); v1[e] = siluf(v1[e]); }
                    *(u32x4*)(Zs + (size_t)row * 4096 + cb + col) = pack8(v0, v1);
                EPI_END
            } else {
                if (colw < 64) {
                    float* GD = (float*)(ws + WS_GD); float* BD = (float*)(ws + WS_BD);
#pragma unroll
                    for (int ai = 0; ai < 2; ++ai)
#pragma unroll
                        for (int m = 0; m < 4; ++m) { const int row = rowb + ai * 128 + m * 16; f32x4 v0 = acc[ai][0][m][0], v1 = acc[ai][0][m][1];
                            if (colw < 32) {
                                const f32x4 a0 = *(const f32x4*)(alog + colw), a1 = *(const f32x4*)(alog + colw + 4), d0 = *(const f32x4*)(dtb + colw), d1 = *(const f32x4*)(dtb + colw + 4);
#pragma unroll
                                for (int e = 0; e < 4; ++e) {
                                    { const float x = v0[e] + d0[e]; const float sp = fmaxf(x, 0.f) + __logf(1.f + __expf(-fabsf(x))); v0[e] = -__expf(a0[e]) * sp; }
                                    { const float x = v1[e] + d1[e]; const float sp = fmaxf(x, 0.f) + __logf(1.f + __expf(-fabsf(x))); v1[e] = -__expf(a1[e]) * sp; } }
                                float* p = GD + (size_t)row * 32 + colw; *(f32x4*)p = v0; *(f32x4*)(p + 4) = v1;
                            } else {
#pragma unroll
                                for (int e = 0; e < 4; ++e) { v0[e] = sigmf(v0[e]); v1[e] = sigmf(v1[e]); }
                                float* p = BD + (size_t)row * 32 + (colw - 32); *(f32x4*)p = v0; *(f32x4*)(p + 4) = v1;
                            } }
                }
            }
        }
#undef EPI_LOOP
#undef EPI_END
    }
};

__device__ __forceinline__ void run_gemm(LAS unsigned char* lds, const bf16_t* A, const bf16_t* Bt, int N, int K, const Epi E) {
    pg8::Gemm g{A, Bt, MTOK, N, K}; pg8::StaticOrder S; S.init(MTOK, N, (int)gridDim.x, (int)blockIdx.x);
    pg8::gemm_phase<Epi, pg8::StaticOrder>(lds, g, S, E);
    __syncthreads();
}

__device__ __forceinline__ s16x4 tr_read(const bf16_t* p) {
    typedef short v4i16_t __attribute__((ext_vector_type(4)));
    return __builtin_bit_cast(s16x4, __builtin_amdgcn_ds_read_tr16_b64_v4i16((LAS v4i16_t*)p));
}
__device__ __forceinline__ bf16x8 frag_tr(const bf16_t* base, int stride, int k0, int c0, int fr, int fq) {
    const bf16_t* p = base + (k0 + 8 * fq + (fr >> 2)) * stride + c0 + 4 * (fr & 3);
    const s16x4 r0 = tr_read(p), r1 = tr_read(p + 4 * stride);
    return (bf16x8){r0[0], r0[1], r0[2], r0[3], r1[0], r1[1], r1[2], r1[3]};
}
__device__ __forceinline__ bf16x8 frag_row(const bf16_t* base, int stride, int r0, int k0, int fr, int fq) { return *(const bf16x8*)(base + (r0 + fr) * stride + k0 + 8 * fq); }

__device__ __forceinline__ f32x4 quad_t4(const f32x4 a, int q) {
    const bool b0 = q & 1, b1 = q & 2;
    const float s0 = b0 ? a[0] : a[1], s1 = b0 ? a[2] : a[3];
    const float r0 = __builtin_bit_cast(float, __builtin_amdgcn_mov_dpp(__builtin_bit_cast(int, s0), 0xB1, 0xF, 0xF, true));
    const float r1 = __builtin_bit_cast(float, __builtin_amdgcn_mov_dpp(__builtin_bit_cast(int, s1), 0xB1, 0xF, 0xF, true));
    const float c0 = b0 ? r0 : a[0], c1 = b0 ? a[1] : r0, d0 = b0 ? r1 : a[2], d1 = b0 ? a[3] : r1;
    const float t0 = b1 ? c0 : d0, t1 = b1 ? c1 : d1;
    const float u0 = __builtin_bit_cast(float, __builtin_amdgcn_mov_dpp(__builtin_bit_cast(int, t0), 0x4E, 0xF, 0xF, true));
    const float u1 = __builtin_bit_cast(float, __builtin_amdgcn_mov_dpp(__builtin_bit_cast(int, t1), 0x4E, 0xF, 0xF, true));
    return (f32x4){b1 ? u0 : c0, b1 ? u1 : c1, b1 ? d0 : u0, b1 ? d1 : u1};
}
__device__ __forceinline__ void store_ctile_bf16(bf16_t* base, int stride, int row0, int col0, const f32x4 a, int fr, int fq) {
    const f32x4 o = quad_t4(a, fr & 3);
    u32x2 w; w.x = pg8::cvt_pk_bf16(o[0], o[1]); w.y = pg8::cvt_pk_bf16(o[2], o[3]);
    *(u32x2*)(base + (row0 + 4 * fq + (fr & 3)) * stride + col0 + 4 * (fr >> 2)) = w;
}
__device__ __forceinline__ void store_ctile_f32(float* base, int stride, int row0, int col0, const f32x4 a, int fr, int fq) {
    *(f32x4*)(base + (row0 + 4 * fq + (fr & 3)) * stride + col0 + 4 * (fr >> 2)) = quad_t4(a, fr & 3);
}

__device__ __forceinline__ void gla_chunked(unsigned char* lds, unsigned char* ws, const float* hn, bool dry) {
    if (blockIdx.x >= 128) return;
    const int tid = fresh_tid(), lane = tid & 63, w = __builtin_amdgcn_readfirstlane(tid >> 6), fr = lane & 15, fq = lane >> 4;
    const int b = blockIdx.x >> 4, h = blockIdx.x & 15;
    const bf16_t* Q = (const bf16_t*)(ws + WS_BIG); const bf16_t* Kk = (const bf16_t*)(ws + WS_BIG + 64 * MiB); const float* G = (const float*)(ws + WS_BIG + 128 * MiB);
    const bf16_t* V = (const bf16_t*)(ws + WS_Z); bf16_t* Zs = (bf16_t*)(ws + WS_Z + 64 * MiB);
    bf16_t* QD = (bf16_t*)lds; bf16_t* KD = (bf16_t*)(lds + 17408); bf16_t* VV = (bf16_t*)(lds + 35840); bf16_t* PP = (bf16_t*)(lds + 54272);
    bf16_t* SB = (bf16_t*)(lds + 63488); float* OT = (float*)(lds + 104960); float* TOT0 = (float*)(lds + 100352);
    const int c = tid & 127, part = tid >> 7;
    f32x4 S[8];
#pragma unroll
    for (int i = 0; i < 8; ++i) S[i] = (f32x4){0.f, 0.f, 0.f, 0.f};
    float* HN = (float*)(lds + 104448); if (tid < 128) HN[tid] = hn[tid];
    float ng[16]; bf16_t nq[16], nk[16]; u32x4 nv0, nv1;
    {
#pragma unroll
        for (int i = 0; i < 16; ++i) { const size_t gi = (size_t)(b * SEQ + 16 * part + i) * 2048 + h * 128 + c; ng[i] = G[gi]; nq[i] = Q[gi]; nk[i] = Kk[gi]; }
        nv0 = *(const u32x4*)(V + (size_t)(b * SEQ + (tid >> 4)) * 2048 + h * 128 + (tid & 15) * 8); nv1 = *(const u32x4*)(V + (size_t)(b * SEQ + ((tid + 512) >> 4)) * 2048 + h * 128 + (tid & 15) * 8);
    }
    u32x4 zp0 = (u32x4){0u, 0u, 0u, 0u}, zp1 = zp0; int trp = 0;
    for (int ch = 0; ch < 32; ++ch) {
        const int tid = fresh_tid(), lane = tid & 63, fr = lane & 15, fq = lane >> 4, c = tid & 127, part = tid >> 7; (void)lane;
        const int trow0 = b * SEQ + ch * 64;
        float g[16], qv[16], kv[16];
#pragma unroll
        for (int i = 0; i < 16; ++i) { g[i] = ng[i]; qv[i] = bf2f(nq[i]); kv[i] = bf2f(nk[i]); }
        float* TOT = TOT0 + (ch & 1) * 512;
        const u32x4 cv0 = nv0, cv1 = nv1;
        const u32x4 zc0 = *(const u32x4*)(Zs + (size_t)(trow0 + (tid >> 3)) * 2048 + h * 128 + (tid & 7) * 16), zc1 = *(const u32x4*)(Zs + (size_t)(trow0 + (tid >> 3)) * 2048 + h * 128 + (tid & 7) * 16 + 8);
        if (ch + 1 < 32) {
#pragma unroll
            for (int i = 0; i < 16; ++i) { const size_t gi = (size_t)(trow0 + 64 + 16 * part + i) * 2048 + h * 128 + c; ng[i] = G[gi]; nq[i] = Q[gi]; nk[i] = Kk[gi]; }
            nv0 = *(const u32x4*)(V + (size_t)(trow0 + 64 + (tid >> 4)) * 2048 + h * 128 + (tid & 15) * 8); nv1 = *(const u32x4*)(V + (size_t)(trow0 + 64 + ((tid + 512) >> 4)) * 2048 + h * 128 + (tid & 15) * 8);
        }
#pragma unroll
        for (int i = 1; i < 16; ++i) g[i] += g[i - 1];
        TOT[part * 128 + c] = g[15];
        __syncthreads();
        if (ch > 0)
        {
            const int r = tid >> 3, seg = tid & 7; const float* op = OT + r * 132 + seg * 16;
            f32x4 v[4]; float ss = 0.f;
#pragma unroll
            for (int i = 0; i < 4; ++i) { v[i] = *(const f32x4*)(op + 4 * i); ss += v[i][0] * v[i][0] + v[i][1] * v[i][1] + v[i][2] * v[i][2] + v[i][3] * v[i][3]; }
            ss += __shfl_xor(ss, 1); ss += __shfl_xor(ss, 2); ss += __shfl_xor(ss, 4);
            const float rn = rsqrtf(ss * (1.f / 128.f) + EPS);
            bf16_t* zp = Zs + (size_t)(trp + r) * 2048 + h * 128 + seg * 16;
#pragma unroll
            for (int i = 0; i < 2; ++i) { const u32x4 zz = i ? zp1 : zp0; const f32x4 h0 = *(const f32x4*)(HN + seg * 16 + 8 * i), h1 = *(const f32x4*)(HN + seg * 16 + 8 * i + 4);
                f32x4 o0 = v[2 * i] * rn * h0, o1 = v[2 * i + 1] * rn * h1;
                o0[0] *= __uint_as_float(zz.x << 16); o0[1] *= __uint_as_float(zz.x & 0xffff0000u); o0[2] *= __uint_as_float(zz.y << 16); o0[3] *= __uint_as_float(zz.y & 0xffff0000u);
                o1[0] *= __uint_as_float(zz.z << 16); o1[1] *= __uint_as_float(zz.z & 0xffff0000u); o1[2] *= __uint_as_float(zz.w << 16); o1[3] *= __uint_as_float(zz.w & 0xffff0000u);
                if (!dry) *(u32x4*)(zp + 8 * i) = pack8(o0, o1); }
        }
        *(u32x4*)(VV + (tid >> 4) * 144 + (tid & 15) * 8) = cv0; *(u32x4*)(VV + ((tid + 512) >> 4) * 144 + (tid & 15) * 8) = cv1;
#ifdef GLASKIP_B
        if (!dry)
#endif
        {
            const float t0 = TOT[c], t1 = TOT[128 + c], t2 = TOT[256 + c];
            const float off = (part > 0 ? t0 : 0.f) + (part > 1 ? t1 : 0.f) + (part > 2 ? t2 : 0.f), bref = t0 + t1;
#pragma unroll
            for (int i = 0; i < 16; ++i) { const float bt = g[i] + off;
                QD[(16 * part + i) * 136 + c] = f2bf(qv[i] * __expf(fminf(bt - bref, 80.f))); KD[(16 * part + i) * 144 + c] = f2bf(kv[i] * __expf(fminf(bref - bt, 80.f))); }
            { f32x4 er;
#pragma unroll
              for (int j = 0; j < 4; ++j) { const int kk = 16 * w + 4 * fq + j; er[j] = __expf(TOT[kk] + TOT[128 + kk]); }
#pragma unroll
              for (int vt = 0; vt < 8; ++vt) store_ctile_bf16(SB, 144, 16 * w, 16 * vt, S[vt] * er, fr, fq); }
        }
        __syncthreads();
#ifdef GLASKIP_C
        if (!dry)
#endif
        {
            const int tt = w >> 1;
#pragma unroll
            for (int x = 0; x < 2; ++x) { const int st = (w & 1) * 2 + x; f32x4 acc = (f32x4){0.f, 0.f, 0.f, 0.f};
                if (st <= tt) {
#pragma unroll
                    for (int ks = 0; ks < 4; ++ks) acc = __builtin_amdgcn_mfma_f32_16x16x32_bf16(frag_row(QD, 136, 16 * tt, 32 * ks, fr, fq), frag_row(KD, 144, 16 * st, 32 * ks, fr, fq), acc, 0, 0, 0);
                }
#pragma unroll
                for (int j = 0; j < 4; ++j) { const int t = 16 * tt + 4 * fq + j, sx = 16 * st + fr; acc[j] = (st <= tt && sx <= t) ? acc[j] : 0.f; }
                store_ctile_bf16(PP, 72, 16 * tt, 16 * st, acc, fr, fq); }
        }
        __syncthreads();
        f32x4 oacc[4];
#ifdef GLASKIP_D
        if (dry) { oacc[0] = oacc[1] = oacc[2] = oacc[3] = S[0]; } else
#endif
        {
            const int tt = w >> 1;
#pragma unroll
            for (int x = 0; x < 4; ++x) { const int vt = (w & 1) * 4 + x; f32x4 acc = (f32x4){0.f, 0.f, 0.f, 0.f};
#pragma unroll
                for (int ks = 0; ks < 2; ++ks) acc = __builtin_amdgcn_mfma_f32_16x16x32_bf16(frag_row(PP, 72, 16 * tt, 32 * ks, fr, fq), frag_tr(VV, 144, 32 * ks, 16 * vt, fr, fq), acc, 0, 0, 0);
#pragma unroll
                for (int ks = 0; ks < 4; ++ks) acc = __builtin_amdgcn_mfma_f32_16x16x32_bf16(frag_row(QD, 136, 16 * tt, 32 * ks, fr, fq), frag_tr(SB, 144, 32 * ks, 16 * vt, fr, fq), acc, 0, 0, 0);
                oacc[x] = acc; }
            float el[4], e2[4];
#pragma unroll
            for (int j = 0; j < 4; ++j) { const int kk = 16 * w + 4 * fq + j; const float hi = TOT[256 + kk] + TOT[384 + kk]; e2[j] = __expf(hi); el[j] = __expf(TOT[kk] + TOT[128 + kk] + hi); }
            const bf16x8 ka0 = frag_tr(KD, 144, 0, 16 * w, fr, fq), ka1 = frag_tr(KD, 144, 32, 16 * w, fr, fq);
#pragma unroll
            for (int vt = 0; vt < 8; ++vt) { f32x4 a2 = (f32x4){0.f, 0.f, 0.f, 0.f};
                a2 = __builtin_amdgcn_mfma_f32_16x16x32_bf16(ka0, frag_tr(VV, 144, 0, 16 * vt, fr, fq), a2, 0, 0, 0);
                a2 = __builtin_amdgcn_mfma_f32_16x16x32_bf16(ka1, frag_tr(VV, 144, 32, 16 * vt, fr, fq), a2, 0, 0, 0);
#pragma unroll
                for (int j = 0; j < 4; ++j) S[vt][j] = el[j] * S[vt][j] + e2[j] * a2[j]; }
        }
        {
            const int tt = w >> 1;
#pragma unroll
            for (int x = 0; x < 4; ++x) { const int vt = (w & 1) * 4 + x; store_ctile_f32(OT, 132, 16 * tt, 16 * vt, oacc[x], fr, fq); }
        }
        zp0 = zc0; zp1 = zc1; trp = trow0;
    }
    __syncthreads();
        {
            const int r = tid >> 3, seg = tid & 7; const float* op = OT + r * 132 + seg * 16;
            f32x4 v[4]; float ss = 0.f;
#pragma unroll
            for (int i = 0; i < 4; ++i) { v[i] = *(const f32x4*)(op + 4 * i); ss += v[i][0] * v[i][0] + v[i][1] * v[i][1] + v[i][2] * v[i][2] + v[i][3] * v[i][3]; }
            ss += __shfl_xor(ss, 1); ss += __shfl_xor(ss, 2); ss += __shfl_xor(ss, 4);
            const float rn = rsqrtf(ss * (1.f / 128.f) + EPS);
            bf16_t* zp = Zs + (size_t)(trp + r) * 2048 + h * 128 + seg * 16;
#pragma unroll
            for (int i = 0; i < 2; ++i) { const u32x4 zz = i ? zp1 : zp0; const f32x4 h0 = *(const f32x4*)(HN + seg * 16 + 8 * i), h1 = *(const f32x4*)(HN + seg * 16 + 8 * i + 4);
                f32x4 o0 = v[2 * i] * rn * h0, o1 = v[2 * i + 1] * rn * h1;
                o0[0] *= __uint_as_float(zz.x << 16); o0[1] *= __uint_as_float(zz.x & 0xffff0000u); o0[2] *= __uint_as_float(zz.y << 16); o0[3] *= __uint_as_float(zz.y & 0xffff0000u);
                o1[0] *= __uint_as_float(zz.z << 16); o1[1] *= __uint_as_float(zz.z & 0xffff0000u); o1[2] *= __uint_as_float(zz.w << 16); o1[3] *= __uint_as_float(zz.w & 0xffff0000u);
                if (!dry) *(u32x4*)(zp + 8 * i) = pack8(o0, o1); }
        }
}


constexpr int GD_KK = 0, GD_QQ = 18432, GD_VN = 35840, GD_SB = 54272, GD_AW = 91136, GD_AT = 108544, GD_UU = 117760, GD_MM = 136192, GD_W = 143104, GD_SM = 160512, GD_HN = 162560, GD_END = 163072;
constexpr int GD_AB = GD_AW + 4096, GD_TI = GD_AW + 13312;
constexpr int GD_RAW = GD_AW;
__device__ __forceinline__ void gdn_chunked(unsigned char* lds, unsigned char* ws, const float* cw, const float* hn, bool dry) {
    const int w = __builtin_amdgcn_readfirstlane(fresh_tid() >> 6);
    const bf16_t* QKV = (const bf16_t*)(ws + WS_BIG); bf16_t* Zs = (bf16_t*)(ws + WS_Z); const float* GDp = (const float*)(ws + WS_GD); const float* BDp = (const float*)(ws + WS_BD);
    bf16_t* KK = (bf16_t*)(lds + GD_KK); bf16_t* QQ = (bf16_t*)(lds + GD_QQ); float* AW = (float*)(lds + GD_AW); bf16_t* W = (bf16_t*)(lds + GD_W); bf16_t* AT = (bf16_t*)(lds + GD_AT);
    bf16_t* UU = (bf16_t*)(lds + GD_UU); bf16_t* VN = (bf16_t*)(lds + GD_VN); bf16_t* SB = (bf16_t*)(lds + GD_SB); bf16_t* OT = (bf16_t*)(lds + GD_W); bf16_t* RAW = (bf16_t*)(lds + GD_RAW); bf16_t* AB = (bf16_t*)(lds + GD_AB); bf16_t* TI = (bf16_t*)(lds + GD_TI); bf16_t* MM = (bf16_t*)(lds + GD_MM);
    float* gcs = (float*)(lds + GD_SM); float* egs = gcs + 64; float* bts = gcs + 128; float* nk2 = gcs + 192; float* nq2 = gcs + 256; float* rks = gcs + 320; float* rqs = gcs + 384;
    float* HN = (float*)(lds + GD_HN); { const int t_ = fresh_tid(); if (t_ < 128) HN[t_] = hn[t_]; }
    for (int item = blockIdx.x; item < 256; item += gridDim.x) {
        const int b = item >> 5, vh = item & 31, hq = vh >> 1;
        f32x4 S[8];
#pragma unroll
        for (int i = 0; i < 8; ++i) S[i] = (f32x4){0.f, 0.f, 0.f, 0.f};
        const int c = fresh_tid() & 127;
        const float wq0 = cw[hq * 128 + c], wq1 = cw[8192 + hq * 128 + c], wq2 = cw[16384 + hq * 128 + c], wq3 = cw[24576 + hq * 128 + c];
        const float wk0 = cw[2048 + hq * 128 + c], wk1 = cw[8192 + 2048 + hq * 128 + c], wk2 = cw[16384 + 2048 + hq * 128 + c], wk3 = cw[24576 + 2048 + hq * 128 + c];
        const float wv0 = cw[4096 + vh * 128 + c], wv1 = cw[8192 + 4096 + vh * 128 + c], wv2 = cw[16384 + 4096 + vh * 128 + c], wv3 = cw[24576 + 4096 + vh * 128 + c];
        u32x4 praw[7];
#define GD_LOADRAW(chn) do { _Pragma("unroll") for (int i = 0; i < 7; ++i) { const int p = ptid + 512 * i; praw[i] = (u32x4){0u, 0u, 0u, 0u}; \
            if (p < 3216) { const int r = p / 48, k = p - r * 48; const int tl = (chn) * 64 + r - 3; const int chb = (k < 16) ? hq * 128 + k * 8 : ((k < 32) ? 2048 + hq * 128 + (k - 16) * 8 : 4096 + vh * 128 + (k - 32) * 8); \
                if (tl >= 0) praw[i] = *(const u32x4*)(QKV + (size_t)(b * SEQ + tl) * 8192 + chb); } } } while (0)
        { const int ptid = fresh_tid(); GD_LOADRAW(0); }
        float pgd = GDp[(size_t)(b * SEQ + (fresh_tid() & 63)) * 32 + vh], pbd = BDp[(size_t)(b * SEQ + (fresh_tid() & 63)) * 32 + vh];
        u32x4 zp0 = (u32x4){0u, 0u, 0u, 0u}, zp1 = zp0; int trp = 0;
        for (int ch = 0; ch < 32; ++ch) {
            const int tid = fresh_tid(), lane = tid & 63, c = tid & 127, part = tid >> 7;
            const int trow0 = b * SEQ + ch * 64;
#pragma unroll
            for (int i = 0; i < 7; ++i) { const int p = tid + 512 * i; if (p < 3216) *(u32x4*)(RAW + p * 8) = praw[i]; }
            const u32x4 zz0 = *(const u32x4*)(Zs + (size_t)(trow0 + (tid >> 3)) * 4096 + vh * 128 + (tid & 7) * 16), zz1 = *(const u32x4*)(Zs + (size_t)(trow0 + (tid >> 3)) * 4096 + vh * 128 + (tid & 7) * 16 + 8);
            if (w == 0) {
                float gsum = pgd;
#pragma unroll
                for (int o = 1; o < 64; o <<= 1) { const float t = __shfl_up(gsum, o); if (lane >= o) gsum += t; }
                gcs[lane] = gsum; egs[lane] = __expf(gsum); bts[lane] = pbd;
            }
            if (ch + 1 < 32) { pgd = GDp[(size_t)(trow0 + 64 + lane) * 32 + vh]; pbd = BDp[(size_t)(trow0 + 64 + lane) * 32 + vh]; }
            { const int lt_ = fresh_tid(); const int fr = lt_ & 15, fq = (lt_ & 63) >> 4;
#pragma unroll
              for (int vt = 0; vt < 8; ++vt) store_ctile_bf16(SB, 144, 16 * w, 16 * vt, S[vt], fr, fq); }
            __syncthreads();
            if (ch > 0)
            {
                const int lt2_ = fresh_tid(); const int r = lt2_ >> 3, seg = lt2_ & 7; const bf16_t* op = OT + r * 136 + seg * 16;
                f32x4 v[4]; float ss = 0.f;
                { const u32x4 q0 = *(const u32x4*)op, q1 = *(const u32x4*)(op + 8);
                  v[0] = (f32x4){__uint_as_float(q0.x << 16), __uint_as_float(q0.x & 0xffff0000u), __uint_as_float(q0.y << 16), __uint_as_float(q0.y & 0xffff0000u)};
                  v[1] = (f32x4){__uint_as_float(q0.z << 16), __uint_as_float(q0.z & 0xffff0000u), __uint_as_float(q0.w << 16), __uint_as_float(q0.w & 0xffff0000u)};
                  v[2] = (f32x4){__uint_as_float(q1.x << 16), __uint_as_float(q1.x & 0xffff0000u), __uint_as_float(q1.y << 16), __uint_as_float(q1.y & 0xffff0000u)};
                  v[3] = (f32x4){__uint_as_float(q1.z << 16), __uint_as_float(q1.z & 0xffff0000u), __uint_as_float(q1.w << 16), __uint_as_float(q1.w & 0xffff0000u)}; }
#pragma unroll
                for (int i = 0; i < 4; ++i) ss += v[i][0] * v[i][0] + v[i][1] * v[i][1] + v[i][2] * v[i][2] + v[i][3] * v[i][3];
                ss += __shfl_xor(ss, 1); ss += __shfl_xor(ss, 2); ss += __shfl_xor(ss, 4);
                const float rn = rsqrtf(ss * (1.f / 128.f) + EPS);
                bf16_t* zp = Zs + (size_t)(trp + r) * 4096 + vh * 128 + seg * 16;
#pragma unroll
                for (int i = 0; i < 2; ++i) { const u32x4 zz = i ? zp1 : zp0; const f32x4 h0 = *(const f32x4*)(HN + seg * 16 + 8 * i), h1 = *(const f32x4*)(HN + seg * 16 + 8 * i + 4);
                    f32x4 o0 = v[2 * i] * rn * h0, o1 = v[2 * i + 1] * rn * h1;
                    o0[0] *= __uint_as_float(zz.x << 16); o0[1] *= __uint_as_float(zz.x & 0xffff0000u); o0[2] *= __uint_as_float(zz.y << 16); o0[3] *= __uint_as_float(zz.y & 0xffff0000u);
                    o1[0] *= __uint_as_float(zz.z << 16); o1[1] *= __uint_as_float(zz.z & 0xffff0000u); o1[2] *= __uint_as_float(zz.w << 16); o1[3] *= __uint_as_float(zz.w & 0xffff0000u);
                    if (!dry) *(u32x4*)(zp + 8 * i) = pack8(o0, o1); }
            }
            if (ch + 1 < 32) { const int ptid = tid; GD_LOADRAW(ch + 1); }
#ifdef DRYSKIP_CONV
            if (!dry)
#endif
            {
                const bf16_t* rp = RAW + (16 * part) * 384 + c;
                float x0, x1, x2;
#define GD_CONV(off, w0, w1, w2, w3, STORE) \
                x0 = bf2f(rp[off]); x1 = bf2f(rp[384 + off]); x2 = bf2f(rp[768 + off]); \
                _Pragma("unroll") for (int i = 0; i < 16; ++i) { const float x3 = bf2f(rp[(i + 3) * 384 + off]); const float y = siluf(w0 * x0 + w1 * x1 + w2 * x2 + w3 * x3); const int t = 16 * part + i; STORE; x0 = x1; x1 = x2; x2 = x3; }
                GD_CONV(0, wq0, wq1, wq2, wq3, QQ[t * 136 + c] = f2bf(y))
                GD_CONV(128, wk0, wk1, wk2, wk3, KK[t * 144 + c] = f2bf(y))
                GD_CONV(256, wv0, wv1, wv2, wv3, VN[t * 144 + c] = f2bf(y * bts[t]))
#undef GD_CONV
            }
            __syncthreads();
            f32x4 ak[2], aq[2];
            {
                const int lt_ = fresh_tid(); const int fr = lt_ & 15, fq = (lt_ & 63) >> 4;
                const int tt = w >> 1;
#pragma unroll
                for (int x = 0; x < 2; ++x) { const int st = (w & 1) * 2 + x; f32x4 a1 = (f32x4){0.f, 0.f, 0.f, 0.f}, a2 = (f32x4){0.f, 0.f, 0.f, 0.f};
                    if (st <= tt) {
#pragma unroll
                        for (int ks = 0; ks < 4; ++ks) { const bf16x8 kb = frag_row(KK, 144, 16 * st, 32 * ks, fr, fq);
                            a1 = __builtin_amdgcn_mfma_f32_16x16x32_bf16(frag_row(KK, 144, 16 * tt, 32 * ks, fr, fq), kb, a1, 0, 0, 0);
                            a2 = __builtin_amdgcn_mfma_f32_16x16x32_bf16(frag_row(QQ, 136, 16 * tt, 32 * ks, fr, fq), kb, a2, 0, 0, 0); }
                    }
                    if (st == tt) { f32x4 a3 = (f32x4){0.f, 0.f, 0.f, 0.f};
#pragma unroll
                        for (int ks = 0; ks < 4; ++ks) { const bf16x8 qa = frag_row(QQ, 136, 16 * tt, 32 * ks, fr, fq); a3 = __builtin_amdgcn_mfma_f32_16x16x32_bf16(qa, qa, a3, 0, 0, 0); }
#pragma unroll
                        for (int j = 0; j < 4; ++j) if (4 * fq + j == fr) { nk2[16 * tt + fr] = a1[j]; nq2[16 * tt + fr] = a3[j]; } }
                    ak[x] = a1; aq[x] = a2; }
            }
            __syncthreads();
            {
                const int lt_ = fresh_tid(); const int fr = lt_ & 15, fq = (lt_ & 63) >> 4;
                const int tt = w >> 1;
                if (lt_ < 64) { rks[lt_] = rsqrtf(nk2[lt_] + EPS); rqs[lt_] = rsqrtf(nq2[lt_] + EPS) * 0.08838834764831845f; }
#pragma unroll
                for (int x = 0; x < 2; ++x) { const int st = (w & 1) * 2 + x; f32x4 av, tv;
#pragma unroll
                    for (int j = 0; j < 4; ++j) { const int t = 16 * tt + 4 * fq + j, sx = 16 * st + fr; const float dec = __expf(fminf(gcs[t] - gcs[sx], 0.f));
                        const float rkt = rsqrtf(nk2[t] + EPS), rks_ = rsqrtf(nk2[sx] + EPS), rqt = rsqrtf(nq2[t] + EPS) * 0.08838834764831845f;
                        av[j] = (st <= tt && sx < t) ? bts[t] * ak[x][j] * rkt * rks_ * dec : 0.f;
                        tv[j] = (st <= tt && sx <= t) ? aq[x][j] * rqt * rks_ * dec : 0.f; }
                    if (st == tt) store_ctile_f32(AW, 16, 16 * tt, 0, av, fr, fq);
                    if (st <= tt) store_ctile_bf16(AB, 72, 16 * tt, 16 * st, av, fr, fq);
                    store_ctile_bf16(AT, 72, 16 * tt, 16 * st, tv, fr, fq); }
                if (w == 0 || w == 2 || w == 5 || w == 7) {
                    const int l = lt_ & 63, c = l & 15;
                    float Ar[16], T[16];
#pragma unroll
                    for (int i = 0; i < 16; ++i) { Ar[i] = AW[(16 * tt + i) * 16 + c]; T[i] = (i == c) ? 1.f : 0.f; }
#pragma unroll
                    for (int i = 1; i < 16; ++i)
#pragma unroll
                        for (int j = 0; j < i; ++j) { const float sv = __builtin_bit_cast(float, __builtin_amdgcn_readlane(__builtin_bit_cast(int, Ar[i]), j)); T[i] -= sv * T[j]; }
                    if (l < 32) {
#pragma unroll
                        for (int i = 0; i < 16; ++i) TI[(tt * 16 + i) * 32 + l] = f2bf(((l >> 4) == (tt & 1)) ? T[i] : 0.f);
                    }
                }
            }
            {
                const int lt_ = fresh_tid();
#pragma unroll
                for (int i = 0; i < 16; ++i) { const int e = lt_ + 512 * i, t = e >> 7, k = e & 127; W[t * 136 + k] = f2bf(bf2f(KK[t * 144 + k]) * (bts[t] * egs[t] * rsqrtf(nk2[t] + EPS))); }
                { const int which = lt_ >> 8, r = (lt_ >> 4) & 15, ci = lt_ & 15; if (which == 0) MM[r * 72 + 16 + ci] = (bf16_t)0; else MM[(32 + r) * 72 + 48 + ci] = (bf16_t)0; }
            }
            __syncthreads();
#ifdef DRYSKIP_SOLVE
            if (!dry)
#endif
            {
                const int lt_ = fresh_tid(); const int fr = lt_ & 15, fq = (lt_ & 63) >> 4;
                const bf16_t* rhs = (w < 4) ? VN : W; bf16_t* outp = (w < 4) ? UU : W; const int ostr = (w < 4) ? 144 : 136; const int cb = 32 * (w & 3);
                f32x4 tr[4][2];
#pragma unroll
                for (int r = 0; r < 4; ++r) { const bf16x8 ti = frag_row(TI + r * 512, 32, 0, 0, fr, fq);
#pragma unroll
                    for (int x = 0; x < 2; ++x) tr[r][x] = __builtin_amdgcn_mfma_f32_16x16x32_bf16(ti, frag_tr(rhs, ostr, 32 * (r >> 1), cb + 16 * x, fr, fq), (f32x4){0.f, 0.f, 0.f, 0.f}, 0, 0, 0);
                    const int mr = (w == 0) ? 1 : ((w < 3) ? 2 : 3), mc = (w == 0) ? 0 : ((w < 3) ? w - 1 : w - 3);
                    if (w < 6 && mr == r) { const f32x4 m = __builtin_amdgcn_mfma_f32_16x16x32_bf16(ti, frag_tr(AB, 72, 32 * (r >> 1), 16 * mc, fr, fq), (f32x4){0.f, 0.f, 0.f, 0.f}, 0, 0, 0);
                        store_ctile_bf16(MM, 72, (r - 1) * 16, 16 * mc, -m, fr, fq); } }
                __syncthreads();
#pragma unroll
                for (int x = 0; x < 2; ++x) { const int c0 = cb + 16 * x;
                    store_ctile_bf16(outp, ostr, 0, c0, tr[0][x], fr, fq);
                    f32x4 acc = __builtin_amdgcn_mfma_f32_16x16x32_bf16(frag_row(MM, 72, 0, 0, fr, fq), frag_tr(outp, ostr, 0, c0, fr, fq), tr[1][x], 0, 0, 0);
                    store_ctile_bf16(outp, ostr, 16, c0, acc, fr, fq);
                    acc = __builtin_amdgcn_mfma_f32_16x16x32_bf16(frag_row(MM + 16 * 72, 72, 0, 0, fr, fq), frag_tr(outp, ostr, 0, c0, fr, fq), tr[2][x], 0, 0, 0);
                    store_ctile_bf16(outp, ostr, 32, c0, acc, fr, fq);
                    acc = __builtin_amdgcn_mfma_f32_16x16x32_bf16(frag_row(MM + 32 * 72, 72, 0, 0, fr, fq), frag_tr(outp, ostr, 0, c0, fr, fq), tr[3][x], 0, 0, 0);
                    acc = __builtin_amdgcn_mfma_f32_16x16x32_bf16(frag_row(MM + 32 * 72, 72, 0, 32, fr, fq), frag_tr(outp, ostr, 32, c0, fr, fq), acc, 0, 0, 0);
                    store_ctile_bf16(outp, ostr, 48, c0, acc, fr, fq); }
            }
            __syncthreads();
            const float gcl = gcs[63];
#ifdef DRYSKIP_D
            if (!dry)
#endif
            {
                const int lt_ = fresh_tid(); const int fr = lt_ & 15, fq = (lt_ & 63) >> 4;
                const int tt = w >> 1;
#pragma unroll
                for (int x = 0; x < 4; ++x) { const int vt = (w & 1) * 4 + x; f32x4 acc = (f32x4){0.f, 0.f, 0.f, 0.f};
#pragma unroll
                    for (int ks = 0; ks < 4; ++ks) acc = __builtin_amdgcn_mfma_f32_16x16x32_bf16(frag_row(W, 136, 16 * tt, 32 * ks, fr, fq), frag_tr(SB, 144, 32 * ks, 16 * vt, fr, fq), acc, 0, 0, 0);
                    f32x4 vnv, vsv;
#pragma unroll
                    for (int j = 0; j < 4; ++j) { const int t = 16 * tt + 4 * fq + j, vx = 16 * vt + fr; const float vn = bf2f(UU[t * 144 + vx]) - acc[j]; vnv[j] = vn; vsv[j] = vn * __expf(gcl - gcs[t]) * rks[t]; }
                    store_ctile_bf16(VN, 144, 16 * tt, 16 * vt, vnv, fr, fq); store_ctile_bf16(UU, 144, 16 * tt, 16 * vt, vsv, fr, fq); asm volatile("" ::: "memory"); }
            }
            __syncthreads();
            f32x4 oacc[4];
            {
                const int lt_ = fresh_tid(); const int fr = lt_ & 15, fq = (lt_ & 63) >> 4;
                const int tt = w >> 1;
#pragma unroll
                for (int x = 0; x < 4; ++x) { const int vt = (w & 1) * 4 + x; f32x4 acc = (f32x4){0.f, 0.f, 0.f, 0.f};
#pragma unroll
                    for (int ks = 0; ks < 4; ++ks) acc = __builtin_amdgcn_mfma_f32_16x16x32_bf16(frag_row(QQ, 136, 16 * tt, 32 * ks, fr, fq), frag_tr(SB, 144, 32 * ks, 16 * vt, fr, fq), acc, 0, 0, 0);
#pragma unroll
                    for (int j = 0; j < 4; ++j) acc[j] *= egs[16 * tt + 4 * fq + j] * rqs[16 * tt + 4 * fq + j];
#pragma unroll
                    for (int ks = 0; ks < 2; ++ks) acc = __builtin_amdgcn_mfma_f32_16x16x32_bf16(frag_row(AT, 72, 16 * tt, 32 * ks, fr, fq), frag_tr(VN, 144, 32 * ks, 16 * vt, fr, fq), acc, 0, 0, 0);
                    oacc[x] = acc; asm volatile("" ::: "memory"); }
                const float egl = __expf(gcl);
                const bf16x8 ka0 = frag_tr(KK, 144, 0, 16 * w, fr, fq), ka1 = frag_tr(KK, 144, 32, 16 * w, fr, fq);
#pragma unroll
                for (int vt = 0; vt < 8; ++vt) { f32x4 a2 = (f32x4){0.f, 0.f, 0.f, 0.f};
                    a2 = __builtin_amdgcn_mfma_f32_16x16x32_bf16(ka0, frag_tr(UU, 144, 0, 16 * vt, fr, fq), a2, 0, 0, 0);
                    a2 = __builtin_amdgcn_mfma_f32_16x16x32_bf16(ka1, frag_tr(UU, 144, 32, 16 * vt, fr, fq), a2, 0, 0, 0);
                    S[vt] = S[vt] * egl + a2; asm volatile("" ::: "memory"); }
            }
            {
                const int lt_ = fresh_tid(); const int fr = lt_ & 15, fq = (lt_ & 63) >> 4;
                const int tt = w >> 1;
#pragma unroll
                for (int x = 0; x < 4; ++x) { const int vt = (w & 1) * 4 + x; store_ctile_bf16(OT, 136, 16 * tt, 16 * vt, oacc[x], fr, fq); }
            }
            zp0 = zz0; zp1 = zz1; trp = trow0;
            __syncthreads();
        }
        __syncthreads();
        {
                const int lt2_ = fresh_tid(); const int r = lt2_ >> 3, seg = lt2_ & 7; const bf16_t* op = OT + r * 136 + seg * 16;
                f32x4 v[4]; float ss = 0.f;
                { const u32x4 q0 = *(const u32x4*)op, q1 = *(const u32x4*)(op + 8);
                  v[0] = (f32x4){__uint_as_float(q0.x << 16), __uint_as_float(q0.x & 0xffff0000u), __uint_as_float(q0.y << 16), __uint_as_float(q0.y & 0xffff0000u)};
                  v[1] = (f32x4){__uint_as_float(q0.z << 16), __uint_as_float(q0.z & 0xffff0000u), __uint_as_float(q0.w << 16), __uint_as_float(q0.w & 0xffff0000u)};
                  v[2] = (f32x4){__uint_as_float(q1.x << 16), __uint_as_float(q1.x & 0xffff0000u), __uint_as_float(q1.y << 16), __uint_as_float(q1.y & 0xffff0000u)};
                  v[3] = (f32x4){__uint_as_float(q1.z << 16), __uint_as_float(q1.z & 0xffff0000u), __uint_as_float(q1.w << 16), __uint_as_float(q1.w & 0xffff0000u)}; }
#pragma unroll
                for (int i = 0; i < 4; ++i) ss += v[i][0] * v[i][0] + v[i][1] * v[i][1] + v[i][2] * v[i][2] + v[i][3] * v[i][3];
                ss += __shfl_xor(ss, 1); ss += __shfl_xor(ss, 2); ss += __shfl_xor(ss, 4);
                const float rn = rsqrtf(ss * (1.f / 128.f) + EPS);
                bf16_t* zp = Zs + (size_t)(trp + r) * 4096 + vh * 128 + seg * 16;
#pragma unroll
                for (int i = 0; i < 2; ++i) { const u32x4 zz = i ? zp1 : zp0; const f32x4 h0 = *(const f32x4*)(HN + seg * 16 + 8 * i), h1 = *(const f32x4*)(HN + seg * 16 + 8 * i + 4);
                    f32x4 o0 = v[2 * i] * rn * h0, o1 = v[2 * i + 1] * rn * h1;
                    o0[0] *= __uint_as_float(zz.x << 16); o0[1] *= __uint_as_float(zz.x & 0xffff0000u); o0[2] *= __uint_as_float(zz.y << 16); o0[3] *= __uint_as_float(zz.y & 0xffff0000u);
                    o1[0] *= __uint_as_float(zz.z << 16); o1[1] *= __uint_as_float(zz.z & 0xffff0000u); o1[2] *= __uint_as_float(zz.w << 16); o1[3] *= __uint_as_float(zz.w & 0xffff0000u);
                    if (!dry) *(u32x4*)(zp + 8 * i) = pack8(o0, o1); }
            }
        __syncthreads();
#undef GD_LOADRAW
    }
}

__device__ __forceinline__ float quad16_max(float x) {
    const auto r = __builtin_amdgcn_permlane32_swap(__float_as_uint(x), __float_as_uint(x), false, false);
    const float m = fmaxf(__uint_as_float(r[0]), __uint_as_float(r[1]));
    const auto q = __builtin_amdgcn_permlane16_swap(__float_as_uint(m), __float_as_uint(m), false, false);
    return fmaxf(__uint_as_float(q[0]), __uint_as_float(q[1]));
}
__device__ __forceinline__ float quad16_sum(float x) {
    const auto r = __builtin_amdgcn_permlane32_swap(__float_as_uint(x), __float_as_uint(x), false, false);
    const float m = __uint_as_float(r[0]) + __uint_as_float(r[1]);
    const auto q = __builtin_amdgcn_permlane16_swap(__float_as_uint(m), __float_as_uint(m), false, false);
    return __uint_as_float(q[0]) + __uint_as_float(q[1]);
}
constexpr int KS_STRIDE = 200, VS_STRIDE = 144;
__device__ __forceinline__ void attn_tile(bf16_t* Ks, bf16_t* Vs, unsigned char* ws, int b, int h, int qt, bool dry) {
    const int tid = fresh_tid(), lane = tid & 63, wv = __builtin_amdgcn_readfirstlane(tid >> 6), fr = lane & 15, fq = lane >> 4;
    const bf16_t* Q = (const bf16_t*)(ws + WS_BIG); const bf16_t* KV = (const bf16_t*)(ws + WS_BIG + 96 * MiB); const bf16_t* KR = (const bf16_t*)(ws + WS_Z + 96 * MiB);
    bf16_t* Zs = (bf16_t*)(ws + WS_Z);
    const int rowA = b * SEQ + qt * 256 + wv * 16 + fr, rowB = rowA + 128;
    bf16x8 qfA[6], qfB[6];
#pragma unroll
    for (int s = 0; s < 6; ++s) { qfA[s] = *(const bf16x8*)(Q + (size_t)rowA * 3072 + h * 192 + 32 * s + 8 * fq); qfB[s] = *(const bf16x8*)(Q + (size_t)rowB * 3072 + h * 192 + 32 * s + 8 * fq); }
    f32x4 accA[8], accB[8];
#pragma unroll
    for (int i = 0; i < 8; ++i) { accA[i] = (f32x4){0.f, 0.f, 0.f, 0.f}; accB[i] = (f32x4){0.f, 0.f, 0.f, 0.f}; }
    float mA = -INFINITY, lA = 0.f, mB = -INFINITY, lB = 0.f;
    const int ntiles = 4 * qt + 4, cA = 4 * qt + (wv >> 2), cB = cA + 2;
    u32x4 pk0, pk1, pv0, pv1, pr0;
    const int lr0 = tid >> 4, lc0 = tid & 15, lr1 = (tid + 512) >> 4, lrr = tid >> 3, lcr = tid & 7;
    {
        const size_t krow0 = (size_t)(b * SEQ);
        pk0 = *(const u32x4*)(KV + (krow0 + lr0) * 4096 + h * 256 + lc0 * 8); pv0 = *(const u32x4*)(KV + (krow0 + lr0) * 4096 + h * 256 + 128 + lc0 * 8);
        pk1 = *(const u32x4*)(KV + (krow0 + lr1) * 4096 + h * 256 + lc0 * 8); pv1 = *(const u32x4*)(KV + (krow0 + lr1) * 4096 + h * 256 + 128 + lc0 * 8);
        pr0 = *(const u32x4*)(KR + (krow0 + lrr) * 64 + lcr * 8);
    }
    for (int kt = 0; kt < ntiles; ++kt) {
        __syncthreads();
        *(u32x4*)(Ks + lr0 * KS_STRIDE + lc0 * 8) = pk0; *(u32x4*)(Vs + lr0 * VS_STRIDE + lc0 * 8) = pv0;
        *(u32x4*)(Ks + lr1 * KS_STRIDE + lc0 * 8) = pk1; *(u32x4*)(Vs + lr1 * VS_STRIDE + lc0 * 8) = pv1;
        *(u32x4*)(Ks + lrr * KS_STRIDE + 128 + lcr * 8) = pr0;
        if (kt + 1 < ntiles) {
            const size_t krow0 = (size_t)(b * SEQ + (kt + 1) * 64);
            pk0 = *(const u32x4*)(KV + (krow0 + lr0) * 4096 + h * 256 + lc0 * 8); pv0 = *(const u32x4*)(KV + (krow0 + lr0) * 4096 + h * 256 + 128 + lc0 * 8);
            pk1 = *(const u32x4*)(KV + (krow0 + lr1) * 4096 + h * 256 + lc0 * 8); pv1 = *(const u32x4*)(KV + (krow0 + lr1) * 4096 + h * 256 + 128 + lc0 * 8);
            pr0 = *(const u32x4*)(KR + (krow0 + lrr) * 64 + lcr * 8);
        }
        __syncthreads();
        if (kt <= cB) {
            const bool doA = (kt <= cA);
            f32x4 sA[4], sB[4];
#pragma unroll
            for (int nt = 0; nt < 4; ++nt) { sA[nt] = (f32x4){0.f, 0.f, 0.f, 0.f}; sB[nt] = (f32x4){0.f, 0.f, 0.f, 0.f};
#pragma unroll
                for (int st = 0; st < 6; ++st) { const bf16x8 kf = *(const bf16x8*)(Ks + (16 * nt + fr) * KS_STRIDE + 32 * st + 8 * fq);
                    sB[nt] = __builtin_amdgcn_mfma_f32_16x16x32_bf16(kf, qfB[st], sB[nt], 0, 0, 0);
                    if (doA) sA[nt] = __builtin_amdgcn_mfma_f32_16x16x32_bf16(kf, qfA[st], sA[nt], 0, 0, 0); } }
            bf16x8 pfA[2], pfB[2];
#define ATT_SOFTMAX(s, mrun, lsum, acc, pf) do { float mx = s[0][0]; \
            _Pragma("unroll") for (int nt = 0; nt < 4; ++nt) _Pragma("unroll") for (int j = 0; j < 4; ++j) mx = fmaxf(mx, s[nt][j]); \
            mx = quad16_max(mx); \
            if (__builtin_amdgcn_ballot_w64(mx > mrun + 8.f) != 0ull) {     \
                const float mnew = fmaxf(mrun, mx), alpha = __builtin_amdgcn_exp2f(mrun - mnew); mrun = mnew; lsum *= alpha; \
                _Pragma("unroll") for (int i = 0; i < 8; ++i) acc[i] *= alpha; } \
            float ps = 0.f; \
            _Pragma("unroll") for (int nt = 0; nt < 4; ++nt) _Pragma("unroll") for (int j = 0; j < 4; ++j) { s[nt][j] = __builtin_amdgcn_exp2f(s[nt][j] - mrun); ps += s[nt][j]; } \
            lsum += ps; \
            _Pragma("unroll") for (int s2 = 0; s2 < 2; ++s2) { const u32x4 w_ = pack8(s[2 * s2], s[2 * s2 + 1]); pf[s2] = __builtin_bit_cast(bf16x8, w_); } } while (0)
            ATT_SOFTMAX(sB, mB, lB, accB, pfB);
            if (doA) ATT_SOFTMAX(sA, mA, lA, accA, pfA);
#undef ATT_SOFTMAX
            const int tq = fr >> 2, tp = fr & 3;
#pragma unroll
            for (int vt = 0; vt < 8; ++vt)
#pragma unroll
                for (int s2 = 0; s2 < 2; ++s2) { const bf16_t* vp = Vs + (32 * s2 + 4 * fq + tq) * VS_STRIDE + 16 * vt + 4 * tp;
                    const s16x4 r0 = tr_read(vp), r1 = tr_read(vp + 16 * VS_STRIDE);
                    const bf16x8 vf = (bf16x8){r0[0], r0[1], r0[2], r0[3], r1[0], r1[1], r1[2], r1[3]};
                    accB[vt] = __builtin_amdgcn_mfma_f32_16x16x32_bf16(vf, pfB[s2], accB[vt], 0, 0, 0);
                    if (doA) accA[vt] = __builtin_amdgcn_mfma_f32_16x16x32_bf16(vf, pfA[s2], accA[vt], 0, 0, 0); }
        }
    }
#define ATT_FINAL(acc, lsum, row) do { const float l_ = quad16_sum(lsum); const float inv = __builtin_amdgcn_rcpf(l_); \
    _Pragma("unroll") for (int vt = 0; vt < 8; ++vt) { bf16_t* zp = Zs + (size_t)(row) * 2048 + h * 128 + 16 * vt + 4 * fq; const u32x2 zz = *(const u32x2*)zp; \
        const float z0 = __uint_as_float(zz.x << 16), z1 = __uint_as_float(zz.x & 0xffff0000u), z2 = __uint_as_float(zz.y << 16), z3 = __uint_as_float(zz.y & 0xffff0000u); \
        u32x2 w_; w_.x = pg8::cvt_pk_bf16(acc[vt][0] * inv * z0, acc[vt][1] * inv * z1); w_.y = pg8::cvt_pk_bf16(acc[vt][2] * inv * z2, acc[vt][3] * inv * z3); if (!dry) *(u32x2*)zp = w_; } } while (0)
    ATT_FINAL(accA, lA, rowA);
    ATT_FINAL(accB, lB, rowB);
#undef ATT_FINAL
}
__device__ __forceinline__ void attn_phase(unsigned char* lds, unsigned char* ws, bool dry) {
    bf16_t* Ks = (bf16_t*)lds; bf16_t* Vs = (bf16_t*)(lds + 64 * KS_STRIDE * 2);
    for (int p = blockIdx.x; p < 512; p += gridDim.x) { const int bh = p >> 2, pr = p & 3;
        attn_tile(Ks, Vs, ws, bh >> 4, bh & 15, 7 - pr, dry);
        attn_tile(Ks, Vs, ws, bh >> 4, bh & 15, pr, dry); }
}

__device__ __forceinline__ void prep_tables(const Params& P) {
    unsigned char* ws = P.ws; const int gt = blockIdx.x * 512 + fresh_tid(), ng = gridDim.x * 512;
    const int* pos = (const int*)P.in[1]; float* COS = (float*)(ws + WS_COS); float* SIN = (float*)(ws + WS_SIN);
    for (int i = gt; i < MTOK * 32; i += ng) { const int row = i >> 5, j = i & 31;
        const float invf = __builtin_amdgcn_exp2f(-(float)j * (13.287712379549449f / 32.f));
        const float ang = (float)pos[row] * invf;
        double t = (double)ang * 0.15915494309189535; t -= floor(t); const float tf = (float)t;
        COS[i] = __builtin_amdgcn_cosf(tf); SIN[i] = __builtin_amdgcn_sinf(tf); }
    const float* lbp = (const float*)P.in[2]; float* LB = (float*)(ws + WS_LB);
    for (int c = gt; c < 2048; c += ng) { const float a0 = lbp[c], a1 = lbp[2048 + c], a2 = lbp[4096 + c], a3 = lbp[6144 + c];
        const float mx = fmaxf(fmaxf(a0, a1), fmaxf(a2, a3)); const float e0 = expf(a0 - mx), e1 = expf(a1 - mx), e2 = expf(a2 - mx), e3 = expf(a3 - mx); const float sm = e0 + e1 + e2 + e3;
        LB[c] = 0.f; LB[2048 + c] = (e1 + e2 + e3) / sm; }
}

#define XB_TMO      128
#define XB_XCNT(j)  (256  + 64 * (j))
#define XB_XSUB(j)  (1280 + 64 * (j))
#define XB_XGEN(j)  (2304 + 64 * (j))
#define XB_TOP      3328
#define XB_TOPGEN   3392
#define XCD_BAR_WORDS 3456
#define XB_SPIN_CAP (1u << 18)
__device__ __forceinline__ unsigned xb_ld(unsigned* p)              { return __hip_atomic_load(p, __ATOMIC_RELAXED, __HIP_MEMORY_SCOPE_AGENT); }
__device__ __forceinline__ unsigned xb_add(unsigned* p, unsigned v) { return __hip_atomic_fetch_add(p, v, __ATOMIC_RELAXED, __HIP_MEMORY_SCOPE_AGENT); }
__device__ __forceinline__ unsigned xb_xcc_id() { return (unsigned)__builtin_amdgcn_s_getreg((3 << 11) | 20) & 0xFu; }
#define XB_SPIN(cond, bar) do { unsigned _sp = 0; while (cond) { __builtin_amdgcn_s_sleep(1); \
    if ((++_sp & 255u) == 0u) { if (xb_ld(&(bar)[XB_TMO])) break; if (_sp > XB_SPIN_CAP) { atomicAdd(&(bar)[XB_TMO], 1u); break; } } } } while (0)

struct XcdBarrier {
    unsigned* bar; unsigned x;
    volatile LAS unsigned* st;
};

__device__ __forceinline__ XcdBarrier xcd_barrier_post(unsigned* bar, volatile LAS unsigned* st) {
    XcdBarrier b; b.bar = bar; b.x = xb_xcc_id(); b.st = st;
    if (threadIdx.x == 0) (void)xb_add(&bar[XB_XCNT(b.x)], 1u);
    return b;
}
__device__ __forceinline__ void xcd_barrier_complete(unsigned* bar, unsigned x, unsigned& nloc, unsigned& nx) {
    const unsigned G = gridDim.x * gridDim.y * gridDim.z;
    unsigned sum, cnt, mine, sp = 0u;
    for (;;) {
        sum = 0u; cnt = 0u; mine = 0u;
#pragma unroll
        for (unsigned j = 0; j < 16; ++j) { const unsigned c = xb_ld(&bar[XB_XCNT(j)]); sum += c; cnt += (c > 0u) ? 1u : 0u; mine = (j == x) ? c : mine; }
        if (sum == G) break;
        __builtin_amdgcn_s_sleep(1);
        if ((++sp & 255u) == 0u) { if (xb_ld(&bar[XB_TMO])) break; if (sp > XB_SPIN_CAP) { atomicAdd(&bar[XB_TMO], 1u); break; } }
    }
    nloc = mine > 0u ? mine : 1u; nx = cnt > 0u ? cnt : 1u;
}

__device__ __forceinline__ void xcd_barrier(const XcdBarrier& b) {
    asm volatile("s_waitcnt vmcnt(0)" ::: "memory");
    __syncthreads();
    if (threadIdx.x == 0) {
        unsigned* bar = b.bar;
        __builtin_amdgcn_s_waitcnt(0);
        unsigned nloc = b.st[0], nx = b.st[1];
        if (nloc == 0u) { xcd_barrier_complete(bar, b.x, nloc, nx); b.st[0] = nloc; b.st[1] = nx; }
        const unsigned old = xb_add(&bar[XB_XSUB(b.x)], 1u);
        const unsigned gen = old / nloc;
        if (old + 1u == (gen + 1u) * nloc) {
            __builtin_amdgcn_fence(__ATOMIC_RELEASE, "agent");
            asm volatile("s_waitcnt vmcnt(0)" ::: "memory");
            const unsigned og = xb_add(&bar[XB_TOP], 1u);
            const unsigned tg = og / nx;
            if (og + 1u == (tg + 1u) * nx) xb_add(&bar[XB_TOPGEN], 1u);
            else XB_SPIN(xb_ld(&bar[XB_TOPGEN]) == tg, bar);
            __builtin_amdgcn_fence(__ATOMIC_ACQUIRE, "agent");
            xb_add(&bar[XB_XGEN(b.x)], 1u);
            asm volatile("s_waitcnt vmcnt(0)" ::: "memory");
        } else {
            XB_SPIN(xb_ld(&bar[XB_XGEN(b.x)]) == gen, bar);
            __builtin_amdgcn_fence(__ATOMIC_ACQUIRE, "agent");
            asm volatile("s_waitcnt vmcnt(0)" ::: "memory");
        }
    }
    __syncthreads();
}


struct CvM { const float* W; int K, Ns, Nd, mode; bf16_t* dst; const float* rs; float cs; };
__device__ __forceinline__ bool cv_get(const Params& P, int cv, int sub, CvM& m) {
#define FIN(i) ((const float*)P.in[i])
    bf16_t* RW = (bf16_t*)(P.ws + WS_RW); bf16_t* U = (bf16_t*)(P.ws + WS_U);
    m.rs = nullptr; m.cs = 1.f; m.mode = MAP_ID;
    if (sub > 0 && cv != 2) return false;
    switch (cv) {
        case 0: m.W = FIN(5);  m.K = 2048; m.Ns = 8192;  m.Nd = 8192;  m.dst = RW; return true;
        case 1: m.W = FIN(7);  m.K = 2048; m.Ns = 2048;  m.Nd = 2048;  m.dst = U;  return true;
        case 2:
            if (sub == 0) { m.W = FIN(10); m.K = 2048; m.Ns = 3136; m.Nd = 3328; m.mode = MAP_MLAIN; m.dst = RW; return true; }
            if (sub == 1) { m.W = FIN(13); m.K = 512; m.Ns = 3072; m.Nd = 3072; m.mode = MAP_UQ; m.dst = RW + (size_t)3328 * 2048; m.rs = FIN(11); m.cs = 0.10411754627697266f;     return true; }
            if (sub == 2) { m.W = FIN(14); m.K = 512; m.Ns = 4096; m.Nd = 4096; m.dst = RW + (size_t)3328 * 2048 + (size_t)3072 * 512; m.rs = FIN(12); return true; }
            return false;
        case 3: m.W = FIN(15); m.K = 2048; m.Ns = 2048;  m.Nd = 2048;  m.dst = U;  return true;
        case 4: m.W = FIN(18); m.K = 2048; m.Ns = 12352; m.Nd = 12544; m.dst = RW; return true;
        case 5: m.W = FIN(23); m.K = 4096; m.Ns = 2048;  m.Nd = 2048;  m.dst = U;  return true;
        case 6: m.W = FIN(26); m.K = 2048; m.Ns = 8192;  m.Nd = 8192;  m.dst = RW; return true;
        case 7: m.W = FIN(28); m.K = 2048; m.Ns = 2048;  m.Nd = 2048;  m.dst = U;  return true;
        default: return false;
    }
}

__global__ void __launch_bounds__(512) trunk_fwd(Params P) {
    extern __shared__ __attribute__((aligned(16))) unsigned char lds[];
    cg::grid_group grid = cg::this_grid();
    unsigned char* ws = P.ws; LAS unsigned char* L3 = (LAS unsigned char*)lds; float* Lf = (float*)lds;
    const int bi = blockIdx.x, nb = gridDim.x;
    bf16_t* RW = (bf16_t*)(ws + WS_RW); bf16_t* U = (bf16_t*)(ws + WS_U);
    const bf16_t* Z0 = (const bf16_t*)(ws + WS_Z); const bf16_t* Z64 = (const bf16_t*)(ws + WS_Z + 64 * MiB); const bf16_t* Z80 = (const bf16_t*)(ws + WS_Z + 80 * MiB);
    const bf16_t* YB = (const bf16_t*)(ws + WS_BIG); const float* LB = (const float*)(ws + WS_LB);
#ifdef PROBE_TA
    unsigned long long* stamps = (unsigned long long*)(lds + LDS_BYTES - 256);
    if (threadIdx.x == 0) stamps[0] = __builtin_amdgcn_s_memrealtime();
#endif
    { if (threadIdx.x < 4) ((LAS unsigned*)(lds + 163072))[threadIdx.x] = 0u; __syncthreads(); }
    XcdBarrier xbar = xcd_barrier_post((unsigned*)(ws + WS_BAR), (volatile LAS unsigned*)(lds + 163072));
    for (int st = P.ph_lo; st < P.ph_hi; ++st) {
        int cv = -1, cvb = -1, rowk = 0, gm = -1, gN = 0, gK = 0, mix = 0; bool sync_after = true, tables = false;
        const bf16_t* r_y = nullptr; const float *r_h = nullptr, *r_post = nullptr, *r_pre = nullptr, *hn = nullptr, *lbp = LB;
        const bf16_t *gA = nullptr, *gB = nullptr;
        switch (st) {
            case 0:  tables = true; rowk = 1; r_h = FIN(0); r_pre = FIN(3); cv = 0; break;
            case 1:  gm = EM_HG; gA = U; gB = RW; gN = 8192; gK = 2048; lbp = LB; break;
            case 2:  cv = 1; cvb = 2; mix = 1; hn = FIN(6); break;
            case 3:  gm = EM_OUT; gA = Z64; gB = U; gN = 2048; gK = 2048; break;
            case 4:  rowk = 1; r_h = FIN(0); r_y = YB; r_post = FIN(4); r_pre = FIN(8); break;
            case 5:  gm = EM_MLAIN; gA = U; gB = RW; gN = 3328; gK = 2048; break;
            case 6:  gm = EM_Q; gA = Z64; gB = RW + (size_t)3328 * 2048; gN = 3072; gK = 512; sync_after = false; break;
            case 7:  gm = EM_KV; gA = Z80; gB = RW + (size_t)3328 * 2048 + (size_t)3072 * 512; gN = 4096; gK = 512; break;
            case 8:  cv = 3; mix = 2; break;
            case 9:  gm = EM_OUT; gA = Z0; gB = U; gN = 2048; gK = 2048; break;
            case 10: rowk = 1; r_h = P.out; r_y = YB; r_post = FIN(9); r_pre = FIN(16); cv = 4; break;
            case 11: gm = EM_GDN; gA = U; gB = RW; gN = 12544; gK = 2048; break;
            case 12: cv = 5; mix = 3; hn = FIN(22); break;
            case 13: gm = EM_OUT; gA = Z0; gB = U; gN = 2048; gK = 4096; break;
            case 14: rowk = 1; r_h = P.out; r_y = YB; r_post = FIN(17); r_pre = FIN(24); cv = 6; break;
            case 15: gm = EM_HG; gA = U; gB = RW; gN = 8192; gK = 2048; lbp = LB + 2048; break;
            case 16: cv = 7; mix = 1; hn = FIN(27); break;
            case 17: gm = EM_OUT; gA = Z64; gB = U; gN = 2048; gK = 2048; break;
            default: rowk = 1; r_h = P.out; r_y = YB; r_post = FIN(25); r_pre = nullptr; break;
        }
        if (tables) prep_tables(P);
        if (rowk) row_phase(r_h, r_y, r_post, r_pre, P.out, U);
        {
            const int cbi = (mix == 1) ? bi - 128 : bi, cnb = (mix == 1) ? nb - 128 : nb;
            if (cbi >= 0 && cnb > 0) {
                for (int pass = 0; pass < 2; ++pass) { const int cvx = pass ? cvb : cv; if (cvx < 0) continue;
                    for (int sub = 0; sub < 3; ++sub) { CvM m; if (!cv_get(P, cvx, sub, m)) break; convert_w(Lf, m.W, m.K, m.Ns, m.dst, m.Nd, m.mode, m.rs, m.cs, cbi, cnb);
#ifdef CONV_REPS
                        for (int r_ = 0; r_ < CONV_REPS; ++r_) convert_w(Lf, m.W, m.K, m.Ns, m.dst, m.Nd, m.mode, m.rs, m.cs, cbi, cnb);
#endif
                    } }
            }
        }
#ifndef GEMM_REPS
#define GEMM_REPS 1
#endif
#ifndef DRY_MIX
#define DRY_MIX 0
#endif
        if (gm >= 0) { Epi E; E.mode = gm; E.ws = ws; E.lb = lbp; E.alog = FIN(20); E.dtb = FIN(21);
            for (int rep = 0; rep < GEMM_REPS; ++rep) {
#ifdef GEMM_DRY_FIRST
                E.mode = (rep == 0) ? -1 : gm;
#endif
                run_gemm(L3, gA, gB, gN, gK, E); if (rep + 1 < GEMM_REPS) grid.sync(); } }
        if (mix) {
            for (int rep = (DRY_MIX == mix ? 0 : 1); rep < 2; ++rep) { const bool dry = (rep == 0);
                if (mix == 1) gla_chunked(lds, ws, hn, dry);
                if (mix == 2) attn_phase(lds, ws, dry);
                if (mix == 3) gdn_chunked(lds, ws, FIN(19), hn, dry);
                if (dry) grid.sync(); }
        }
        if (sync_after && st + 1 < P.ph_hi) { if (st == 0) grid.sync(); else xcd_barrier(xbar); }
#ifdef EXTRA_SYNCS
        for (int e_ = 0; e_ < EXTRA_SYNCS; ++e_) xcd_barrier(xbar);
#endif
#ifdef PROBE_TA
        if (threadIdx.x == 0) stamps[st + 1] = __builtin_amdgcn_s_memrealtime();
#endif
    }
#ifdef PROBE_TA
    grid.sync();
    { const size_t n = (size_t)MTOK * DM; for (size_t i = (size_t)blockIdx.x * 512 + threadIdx.x; i < n; i += (size_t)gridDim.x * 512) P.out[i] = 0.f; }
    grid.sync();
    if (blockIdx.x == 0) { const float ta = (float)(stamps[PROBE_TA + 1] - stamps[0]) * 0.01f, tb = (float)(stamps[PROBE_TB + 1] - stamps[0]) * 0.01f;
        if (threadIdx.x == 0) P.out[0] = ta;
        for (int i = threadIdx.x; i < 1000000; i += 512) P.out[1024 + i] = tb; }
#endif
#undef FIN
}

extern "C" void kernel_launch(void* const* d_in, const int* in_sizes, int n_in, void* d_out, int out_size, void* d_ws, size_t ws_size, hipStream_t stream) {
    static int grid_blocks = 0;
    if (grid_blocks == 0) {
        if (n_in != 29 || ws_size < WS_END) { fprintf(stderr, "kernel_launch: need 29 inputs and %zu bytes of workspace; got %d, %zu\n", (size_t)WS_END, n_in, ws_size); grid_blocks = -1; return; }
        int dev = 0, cus = 0, per_cu = 0;
        hipGetDevice(&dev); hipDeviceGetAttribute(&cus, hipDeviceAttributeMultiprocessorCount, dev);
        if (hipFuncSetAttribute((const void*)trunk_fwd, hipFuncAttributeMaxDynamicSharedMemorySize, LDS_BYTES) != hipSuccess) { fprintf(stderr, "hipFuncSetAttribute failed\n"); grid_blocks = -1; return; }
        if (hipOccupancyMaxActiveBlocksPerMultiprocessor(&per_cu, (const void*)trunk_fwd, 512, LDS_BYTES) != hipSuccess || per_cu < 1) { fprintf(stderr, "occupancy query failed (%d)\n", per_cu); per_cu = 1; }
        (void)hipGetLastError();
        grid_blocks = cus * 1;
    }
    if (grid_blocks < 0) return;
    Params p{};
    for (int i = 0; i < 29; ++i) p.in[i] = d_in[i];
    p.out = (float*)d_out; p.ws = (unsigned char*)d_ws;
#if PER_PHASE_LAUNCH
    for (int ph = 0; ph < NPHASE; ++ph) {
        p.ph_lo = ph; p.ph_hi = ph + 1; void* args[] = {&p};
        hipError_t e = hipLaunchCooperativeKernel((const void*)trunk_fwd, dim3(grid_blocks), dim3(512), args, LDS_BYTES, stream);
        if (e != hipSuccess) { fprintf(stderr, "launch failed: %s\n", hipGetErrorString(e)); break; }
    }
#else
    (void)hipMemsetAsync((unsigned char*)d_ws + WS_BAR, 0, XCD_BAR_WORDS * 4, stream);
    p.ph_lo = 0; p.ph_hi = NPHASE; void* args[] = {&p};
    hipError_t e = hipLaunchCooperativeKernel((const void*)trunk_fwd, dim3(grid_blocks), dim3(512), args, LDS_BYTES, stream);
    if (e != hipSuccess) fprintf(stderr, "cooperative launch failed: %s (grid %d)\n", hipGetErrorString(e), grid_blocks);
#endif
}
```

```cpp
#include <hip/hip_runtime.h>
#include <hip/hip_cooperative_groups.h>
#include <cstdio>
namespace cg = cooperative_groups;
namespace pg8 {
#define PG8_LAS __attribute__((address_space(3)))
typedef unsigned short bf16_t;
typedef short bf16x8 __attribute__((ext_vector_type(8)));
typedef float f32x4 __attribute__((ext_vector_type(4)));
typedef unsigned u32x4 __attribute__((ext_vector_type(4)));
constexpr int BM = 256, BK = 64, HALF = 128, HTB = HALF * BK * 2  , STAGE_BYTES = 8 * HTB, NXCD = 8, WGM = 8;

__host__ __device__ __forceinline__ int lds_byte(int r, int c) { const int st = (r >> 4) * 2 + (c >> 5), rr = r & 15, cc = c & 31, ob = rr * 64 + cc * 2; return st * 1024 + (ob ^ (((ob >> 9) & 1) << 5)); }
__host__ __device__ __forceinline__ void stage_rc(int b, int& R, int& C) { const int st = b / 1024, sb = b % 1024, swz = sb ^ (((sb >> 9) & 1) << 5); R = (st >> 1) * 16 + swz / 64; C = (st & 1) * 32 + (swz % 64) / 2; }
__host__ __device__ __forceinline__ int perm32(int rho) { const int n = rho >> 4, i = rho & 15; return 8 * (i >> 2) + 4 * n + (i & 3); }

struct Unit { int pm, pn; };
struct Gemm { const bf16_t* A; const bf16_t* Bt; int M, N, K; };
struct StaticOrder {
    int nM, nN, nwg, G, c;
    __host__ __device__ void init(int M, int N, int G_, int c_) { nM = M / BM; nN = N / BM; nwg = nM * nN; G = G_; c = c_; }
    __host__ __device__ bool next(int i, Unit& u) const {
        const long L = (long)i * G + c; if (L >= nwg) return false;
        int wgid = (int)L; { const int q = nwg / NXCD, r = nwg % NXCD, xcd = wgid % NXCD, off = wgid / NXCD; wgid = (xcd < r ? xcd * (q + 1) : r * (q + 1) + (xcd - r) * q) + off; }
        const int nig = WGM * nN, gid = wgid / nig, fm = gid * WGM, gsz = (nM - fm) < WGM ? (nM - fm) : WGM;
        u.pm = fm + ((wgid % nig) % gsz); u.pn = (wgid % nig) / gsz; return true;
    }
    __device__ __forceinline__ void a_ready(const Unit&) const {}
    __device__ __forceinline__ void done(const Unit&) const {}
};
__device__ __forceinline__ unsigned cvt_pk_bf16(float lo, float hi) { unsigned r; asm("v_cvt_pk_bf16_f32 %0, %1, %2" : "=v"(r) : "v"(lo), "v"(hi)); return r; }
template <class Epi, class Sched>
__device__ __forceinline__ void gemm_phase(PG8_LAS unsigned char* lds, const Gemm g, const Sched& S, const Epi& E) {
    int tid_l_ = threadIdx.x; asm volatile("" : "+v"(tid_l_)); const int tid = tid_l_, wid = __builtin_amdgcn_readfirstlane(tid >> 6), lane = tid & 63, wr = wid >> 2, wc = wid & 3, fr = lane & 15, fq = lane >> 4;
    const int K = g.K, nt = K / BK;
    unsigned voffA[2], voffB[2];
#pragma unroll
    for (int i = 0; i < 2; ++i) { int R, C; stage_rc(tid * 16 + i * 8192, R, C); const int Rb = Epi::PERM ? ((R & ~31) + perm32(R & 31)) : R;
        voffA[i] = (unsigned)(R * K + C) * 2u; voffB[i] = (unsigned)(Rb * K + C) * 2u; }
    const size_t kstep = (size_t)(BK * 2);
    const size_t hstep = (size_t)HALF * K * 2;
    const size_t tstep = 2 * hstep;
    const unsigned ldsw = (unsigned)wid * 1024u;
    const int aoff = lds_byte(wr * 64 + fr, fq * 8), boff = lds_byte(wc * 32 + fr, fq * 8);
#define PG8_SA(b, h) (((b) * 2 + (h)) * HTB)
#define PG8_SB(b, h) ((4 + (b) * 2 + (h)) * HTB)
#define PG8_STAGE(bufoff, gbase, voff) do { _Pragma("unroll") for (int _i = 0; _i < 2; ++_i) \
        __builtin_amdgcn_global_load_lds((const unsigned*)((const char*)(gbase) + (voff)[_i]), (PG8_LAS unsigned*)(lds + (bufoff) + ldsw + _i * 8192), 16, 0, 0); } while (0)
#define PG8_LDA(dst, b, h) do { _Pragma("unroll") for (int m = 0; m < 4; ++m) _Pragma("unroll") for (int k = 0; k < 2; ++k) dst[m][k] = *(const PG8_LAS bf16x8*)(lds + PG8_SA(b, h) + aoff + m * 2048 + k * 1024); } while (0)
#define PG8_LDB(dst, b, h) do { _Pragma("unroll") for (int n = 0; n < 2; ++n) _Pragma("unroll") for (int k = 0; k < 2; ++k) dst[n][k] = *(const PG8_LAS bf16x8*)(lds + PG8_SB(b, h) + boff + n * 2048 + k * 1024); } while (0)
#define PG8_MMA(ai, bj, At, Bt) do { __builtin_amdgcn_s_setprio(1); _Pragma("unroll") for (int m = 0; m < 4; ++m) _Pragma("unroll") for (int n = 0; n < 2; ++n) _Pragma("unroll") for (int k = 0; k < 2; ++k) \
        acc[ai][bj][m][n] = __builtin_amdgcn_mfma_f32_16x16x32_bf16(Bt[n][k], At[m][k], acc[ai][bj][m][n], 0, 0, 0); __builtin_amdgcn_s_setprio(0); } while (0)
#define PG8_WAIT_V(n) asm volatile("s_waitcnt vmcnt(" #n ")" ::: "memory")
#define PG8_WAIT_L(n) asm volatile("s_waitcnt lgkmcnt(" #n ")" ::: "memory")
#define PG8_BAR __builtin_amdgcn_s_barrier()
#define PG8_SCHED __builtin_amdgcn_sched_barrier(0)
    Unit cur, nxt; int ui = 0;
    if (!S.next(0, cur)) return;
    f32x4 acc[2][2][4][2];
#pragma unroll
    for (int a = 0; a < 2; ++a)
#pragma unroll
        for (int b = 0; b < 2; ++b)
#pragma unroll
            for (int m = 0; m < 4; ++m)
#pragma unroll
                for (int n = 0; n < 2; ++n) acc[a][b][m][n] = (f32x4){0.f, 0.f, 0.f, 0.f};
    bf16x8 At[4][2], B0[2][2], B1[2][2];
    const char* cA = (const char*)g.A + (size_t)cur.pm * tstep; const char* cB = (const char*)g.Bt + (size_t)cur.pn * tstep;
    S.a_ready(cur);
    PG8_STAGE(PG8_SB(0, 0), cB, voffB); PG8_STAGE(PG8_SA(0, 0), cA, voffA); PG8_STAGE(PG8_SB(0, 1), cB + hstep, voffB); PG8_STAGE(PG8_SA(0, 1), cA + hstep, voffA);
    if (wr == 1) PG8_BAR;
    PG8_WAIT_V(4); PG8_BAR;
    PG8_STAGE(PG8_SB(1, 0), cB + kstep, voffB); PG8_STAGE(PG8_SA(1, 0), cA + kstep, voffA); PG8_STAGE(PG8_SB(1, 1), cB + hstep + kstep, voffB);
    PG8_WAIT_V(6); PG8_BAR;
    for (;;) {
        const bool has_next = S.next(ui + 1, nxt);
        const char* nA = has_next ? (const char*)g.A + (size_t)nxt.pm * tstep : cA; const char* nB = has_next ? (const char*)g.Bt + (size_t)nxt.pn * tstep : cB;
        for (int t = 0; t < nt; t += 2) {
            const bool last = (t == nt - 2);
            const char* a1 = cA + (size_t)(t + 1) * kstep;
            const char* a2 = last ? nA : cA + (size_t)(t + 2) * kstep; const char* b2 = last ? nB : cB + (size_t)(t + 2) * kstep;
            const char* a3 = a2 + kstep; const char* b3 = b2 + kstep;
            if (last && has_next) S.a_ready(nxt);
            PG8_LDB(B0, 0, 0); PG8_SCHED; PG8_LDA(At, 0, 0); PG8_STAGE(PG8_SA(1, 1), a1 + hstep, voffA);
            PG8_WAIT_L(8); PG8_BAR; PG8_WAIT_L(0); PG8_MMA(0, 0, At, B0); PG8_BAR; PG8_SCHED;
            PG8_LDB(B1, 0, 1); PG8_STAGE(PG8_SB(0, 0), b2, voffB);
            PG8_BAR; PG8_WAIT_L(0); PG8_MMA(0, 1, At, B1); PG8_BAR;
            PG8_LDA(At, 0, 1); PG8_STAGE(PG8_SA(0, 0), a2, voffA);
            PG8_BAR; PG8_WAIT_L(0); PG8_MMA(1, 0, At, B0); PG8_BAR; PG8_SCHED;
            PG8_STAGE(PG8_SB(0, 1), b2 + hstep, voffB);
            PG8_WAIT_V(6); PG8_BAR; PG8_MMA(1, 1, At, B1); PG8_BAR;
            PG8_LDB(B0, 1, 0); PG8_SCHED; PG8_LDA(At, 1, 0); PG8_STAGE(PG8_SA(0, 1), a2 + hstep, voffA);
            PG8_WAIT_L(8); PG8_BAR; PG8_WAIT_L(0); PG8_MMA(0, 0, At, B0); PG8_BAR; PG8_SCHED;
            PG8_LDB(B1, 1, 1); PG8_STAGE(PG8_SB(1, 0), b3, voffB);
            PG8_BAR; PG8_WAIT_L(0); PG8_MMA(0, 1, At, B1); PG8_BAR;
            PG8_LDA(At, 1, 1); PG8_STAGE(PG8_SA(1, 0), a3, voffA);
            PG8_BAR; PG8_WAIT_L(0); PG8_MMA(1, 0, At, B0); PG8_BAR; PG8_SCHED;
            PG8_STAGE(PG8_SB(1, 1), b3 + hstep, voffB);
            PG8_WAIT_V(6); PG8_BAR; PG8_MMA(1, 1, At, B1); PG8_BAR;
        }
        if constexpr (!Epi::AFTER_DRAIN) { E(acc, cur, wr, wc, fr, fq); S.done(cur); }
        if (!has_next) break;
#pragma unroll
        for (int a = 0; a < 2; ++a)
#pragma unroll
            for (int b = 0; b < 2; ++b)
#pragma unroll
                for (int m = 0; m < 4; ++m)
#pragma unroll
                    for (int n = 0; n < 2; ++n) acc[a][b][m][n] = (f32x4){0.f, 0.f, 0.f, 0.f};
        cur = nxt; cA = nA; cB = nB; ++ui;
    }
    PG8_WAIT_V(0);
    if (wr == 0) PG8_BAR;
    PG8_BAR;
    if constexpr (Epi::AFTER_DRAIN) { E.fused(acc, cur, wr, wc, fr, fq, lds, wid, lane); S.done(cur); }
#undef PG8_SA
#undef PG8_SB
#undef PG8_STAGE
#undef PG8_LDA
#undef PG8_LDB
#undef PG8_MMA
#undef PG8_WAIT_V
#undef PG8_WAIT_L
#undef PG8_BAR
#undef PG8_SCHED
}
}

#ifndef PER_PHASE_LAUNCH
#define PER_PHASE_LAUNCH 0
#endif

#define LAS __attribute__((address_space(3)))
typedef unsigned short bf16_t;
typedef short bf16x8 __attribute__((ext_vector_type(8)));
typedef short s16x4 __attribute__((ext_vector_type(4)));
typedef float f32x4 __attribute__((ext_vector_type(4)));
typedef unsigned u32x4 __attribute__((ext_vector_type(4)));
typedef unsigned u32x2 __attribute__((ext_vector_type(2)));

constexpr int MTOK = 16384, DM = 2048, SEQ = 2048;
constexpr float EPS = 1e-6f;
constexpr size_t MiB = 1ull << 20;
constexpr size_t WS_RW = 0;
constexpr size_t WS_U = 50 * MiB;
constexpr size_t WS_BIG = 114 * MiB;
constexpr size_t WS_Z = 370 * MiB;
constexpr size_t WS_SM = 498 * MiB;
constexpr size_t WS_COS = WS_SM, WS_SIN = WS_SM + 2 * MiB, WS_GD = WS_SM + 4 * MiB, WS_BD = WS_SM + 6 * MiB;
constexpr size_t WS_SSQ = WS_SM + 8 * MiB;
constexpr size_t WS_LB = WS_SM + 9 * MiB;
constexpr size_t WS_BAR = WS_LB + 16384;
constexpr size_t WS_END = WS_SM + 9 * MiB + 65536;
constexpr int LDS_BYTES = 163088;
constexpr int NPHASE = 19;

struct Params { const void* in[29]; float* out; unsigned char* ws; int ph_lo, ph_hi; };

__device__ __forceinline__ int fresh_tid() { int t = threadIdx.x; asm volatile("" : "+v"(t)); return t; }
__device__ __forceinline__ float bf2f(bf16_t v) { return __uint_as_float(((unsigned)v) << 16); }
__device__ __forceinline__ bf16_t f2bf(float f) { return (bf16_t)(pg8::cvt_pk_bf16(f, f) & 0xffffu); }
__device__ __forceinline__ float siluf(float x) { return x * __builtin_amdgcn_rcpf(1.f + __expf(-x)); }
__device__ __forceinline__ float sigmf(float x) { return __builtin_amdgcn_rcpf(1.f + __expf(-x)); }
__device__ __forceinline__ float wave_sum(float v) {
#pragma unroll
    for (int o = 32; o >= 1; o >>= 1) v += __shfl_xor(v, o);
    return v;
}
__device__ __forceinline__ u32x4 pack8(const f32x4 a, const f32x4 b) {
    u32x4 w; w.x = pg8::cvt_pk_bf16(a[0], a[1]); w.y = pg8::cvt_pk_bf16(a[2], a[3]); w.z = pg8::cvt_pk_bf16(b[0], b[1]); w.w = pg8::cvt_pk_bf16(b[2], b[3]); return w;
}

enum { MAP_ID = 0, MAP_MLAIN = 1, MAP_UQ = 2 };
__device__ __forceinline__ int map_src(int mode, int n, int nsrc) {
    if (mode == MAP_MLAIN) { if (n < 1024) return n; if (n < 3072) return n + 64; if (n < 3136) { const int j = n - 3072; return 1024 + (j >> 1) + 32 * (j & 1); } return -1; }
    if (mode == MAP_UQ) { const int hd = n / 192, c = n - hd * 192; if (c < 128) return n; const int j = c - 128; return hd * 192 + 128 + (j >> 1) + 32 * (j & 1); }
    return n < nsrc ? n : -1;
}
__device__ __forceinline__ void convert_w(float* tile, const float* W, int K, int Nsrc, bf16_t* Bt, int Ndst, int mode, const float* rowscale, float cscale, int bi, int nb) {
    const int tid = fresh_tid();
    const int tk = K / 64, nt = tk * (Ndst / 64);
    const int j = tid & 63, i0 = tid >> 6;
    float v[8];
#define CW_LOAD(tt) do { const int n0_ = ((tt) / tk) * 64, k0_ = ((tt) % tk) * 64; const int sc_ = map_src(mode, n0_ + j, Nsrc); \
        _Pragma("unroll") for (int it = 0; it < 8; ++it) { const int k_ = k0_ + i0 + 8 * it; float x_ = 0.f; if (sc_ >= 0) { x_ = W[(size_t)k_ * Nsrc + sc_] * cscale; if (rowscale) x_ *= rowscale[k_]; } v[it] = x_; } } while (0)
    int t = bi;
    if (t < nt) CW_LOAD(t);
    for (; t < nt; t += nb) {
        const int n0 = (t / tk) * 64, k0 = (t % tk) * 64;
        __syncthreads();
#pragma unroll
        for (int it = 0; it < 8; ++it) tile[(i0 + 8 * it) * 65 + j] = v[it];
        if (t + nb < nt) CW_LOAD(t + nb);
        __syncthreads();
        {
            const int n = tid >> 3, kk = (tid & 7) * 8; u32x4 w;
            w.x = pg8::cvt_pk_bf16(tile[(kk + 0) * 65 + n], tile[(kk + 1) * 65 + n]);
            w.y = pg8::cvt_pk_bf16(tile[(kk + 2) * 65 + n], tile[(kk + 3) * 65 + n]);
            w.z = pg8::cvt_pk_bf16(tile[(kk + 4) * 65 + n], tile[(kk + 5) * 65 + n]);
            w.w = pg8::cvt_pk_bf16(tile[(kk + 6) * 65 + n], tile[(kk + 7) * 65 + n]);
            *(u32x4*)(Bt + (size_t)(n0 + n) * K + k0 + kk) = w;
        }
    }
#undef CW_LOAD
    __syncthreads();
}

__device__ __forceinline__ void row_phase(const float* hsrc, const bf16_t* Y, const float* postw, const float* prew, float* hout, bf16_t* U) {
    const int tid_ = fresh_tid(); const int lane = tid_ & 63, gw = blockIdx.x * 8 + (tid_ >> 6), nw = gridDim.x * 8;
    for (int row = gw; row < MTOK; row += nw) {
        f32x4 h[8]; const float* hp = hsrc + (size_t)row * DM + lane * 4;
#pragma unroll
        for (int i = 0; i < 8; ++i) h[i] = *(const f32x4*)(hp + 256 * i);
        if (Y) {
            f32x4 y[8]; const bf16_t* yp = Y + (size_t)row * DM + lane * 4; float ss = 0.f;
#pragma unroll
            for (int i = 0; i < 8; ++i) { const u32x2 yy = *(const u32x2*)(yp + 256 * i); y[i] = (f32x4){__uint_as_float(yy.x << 16), __uint_as_float(yy.x & 0xffff0000u), __uint_as_float(yy.y << 16), __uint_as_float(yy.y & 0xffff0000u)};
                ss += y[i][0] * y[i][0] + y[i][1] * y[i][1] + y[i][2] * y[i][2] + y[i][3] * y[i][3]; }
            ss = wave_sum(ss); const float ry = rsqrtf(ss * (1.f / 2048.f) + EPS);
            float* op = hout + (size_t)row * DM + lane * 4;
#pragma unroll
            for (int i = 0; i < 8; ++i) { const f32x4 pw = *(const f32x4*)(postw + lane * 4 + 256 * i); h[i] += y[i] * ry * pw; *(f32x4*)(op + 256 * i) = h[i]; }
        }
        if (prew) {
            float ss = 0.f;
#pragma unroll
            for (int i = 0; i < 8; ++i) ss += h[i][0] * h[i][0] + h[i][1] * h[i][1] + h[i][2] * h[i][2] + h[i][3] * h[i][3];
            ss = wave_sum(ss); const float r = rsqrtf(ss * (1.f / 2048.f) + EPS);
            bf16_t* up = U + (size_t)row * DM + lane * 4;
#pragma unroll
            for (int i = 0; i < 8; ++i) { const f32x4 pw = *(const f32x4*)(prew + lane * 4 + 256 * i); const f32x4 u = h[i] * r * pw;
                u32x2 w; w.x = pg8::cvt_pk_bf16(u[0], u[1]); w.y = pg8::cvt_pk_bf16(u[2], u[3]); *(u32x2*)(up + 256 * i) = w; }
        }
    }
}

enum { EM_HG = 0, EM_MLAIN = 1, EM_Q = 2, EM_KV = 3, EM_GDN = 4, EM_OUT = 5 };
struct Epi {
    static constexpr bool PERM = true, AFTER_DRAIN = false;
    int mode;
    unsigned char* ws;
    const float* lb;
    const float* alog; const float* dtb;
    __device__ __forceinline__ void operator()(const f32x4 (&acc)[2][2][4][2], const pg8::Unit& u, int wr, int wc, int fr, int fq) const {
        asm volatile("" : "+v"(fr), "+v"(fq));
        const int rowb = u.pm * 256 + wr * 64 + fr, colw = wc * 32 + 8 * fq;
#define EPI_LOOP for (int ai = 0; ai < 2; ++ai) for (int m = 0; m < 4; ++m) { const int row = rowb + ai * 128 + m * 16; (void)row; for (int bj = 0; bj < 2; ++bj) { const int col = colw + bj * 128; (void)col; f32x4 v0 = acc[ai][bj][m][0], v1 = acc[ai][bj][m][1];
#define EPI_END } }
        if (mode == EM_OUT) {
            bf16_t* Y = (bf16_t*)(ws + WS_BIG);
#pragma unroll
            EPI_LOOP *(u32x4*)(Y + (size_t)row * 2048 + u.pn * 256 + col) = pack8(v0, v1); EPI_END
        } else if (mode == EM_KV) {
            bf16_t* KV = (bf16_t*)(ws + WS_BIG + 96 * MiB); const float* ssq = (const float*)(ws + WS_SSQ) + (size_t)MTOK * 8;
#pragma unroll
            for (int ai = 0; ai < 2; ++ai)
#pragma unroll
                for (int m = 0; m < 4; ++m) { const int row = rowb + ai * 128 + m * 16; const f32x4 p0 = *(const f32x4*)(ssq + (size_t)row * 8), p1 = *(const f32x4*)(ssq + (size_t)row * 8 + 4); const float r = rsqrtf((((p0[0] + p0[1]) + (p0[2] + p0[3])) + ((p1[0] + p1[1]) + (p1[2] + p1[3]))) * (1.f / 512.f) + EPS);
#pragma unroll
                    for (int bj = 0; bj < 2; ++bj) { const int col = colw + bj * 128; *(u32x4*)(KV + (size_t)row * 4096 + u.pn * 256 + col) = pack8(acc[ai][bj][m][0] * r, acc[ai][bj][m][1] * r); } }
        } else if (mode == EM_Q) {
            bf16_t* Q = (bf16_t*)(ws + WS_BIG); const float* ssq = (const float*)(ws + WS_SSQ);
            const float* COS = (const float*)(ws + WS_COS); const float* SIN = (const float*)(ws + WS_SIN);
#pragma unroll
            for (int ai = 0; ai < 2; ++ai)
#pragma unroll
                for (int m = 0; m < 4; ++m) { const int row = rowb + ai * 128 + m * 16; const f32x4 p0 = *(const f32x4*)(ssq + (size_t)row * 8), p1 = *(const f32x4*)(ssq + (size_t)row * 8 + 4); const float r = rsqrtf((((p0[0] + p0[1]) + (p0[2] + p0[3])) + ((p1[0] + p1[1]) + (p1[2] + p1[3]))) * (1.f / 512.f) + EPS);
#pragma unroll
                    for (int bj = 0; bj < 2; ++bj) { const int c = u.pn * 256 + colw + bj * 128; const int within = c % 192;
                        f32x4 v0 = acc[ai][bj][m][0] * r, v1 = acc[ai][bj][m][1] * r;
                        if (within >= 128) { const int j0 = (within - 128) >> 1; const f32x4 cs = *(const f32x4*)(COS + (size_t)row * 32 + j0), sn = *(const f32x4*)(SIN + (size_t)row * 32 + j0);
                            const f32x4 a = (f32x4){v0[0], v0[2], v1[0], v1[2]}, b = (f32x4){v0[1], v0[3], v1[1], v1[3]};
                            const f32x4 ra = a * cs - b * sn, rb = b * cs + a * sn;
                            v0 = (f32x4){ra[0], rb[0], ra[1], rb[1]}; v1 = (f32x4){ra[2], rb[2], ra[3], rb[3]}; }
                        *(u32x4*)(Q + (size_t)row * 3072 + c) = pack8(v0, v1); } }
        } else if (mode == EM_MLAIN) {
            if (u.pn < 4) {
                bf16_t* C = (bf16_t*)(ws + WS_Z + (u.pn < 2 ? 64 : 80) * MiB); float* ssq = (float*)(ws + WS_SSQ) + (u.pn < 2 ? (size_t)0 : (size_t)MTOK * 8); const int cb = (u.pn & 1) * 256;
#pragma unroll
                for (int ai = 0; ai < 2; ++ai)
#pragma unroll
                    for (int m = 0; m < 4; ++m) { const int row = rowb + ai * 128 + m * 16; float s = 0.f;
#pragma unroll
                        for (int bj = 0; bj < 2; ++bj) { const int col = colw + bj * 128; const f32x4 v0 = acc[ai][bj][m][0], v1 = acc[ai][bj][m][1];
                            s += v0[0] * v0[0] + v0[1] * v0[1] + v0[2] * v0[2] + v0[3] * v0[3] + v1[0] * v1[0] + v1[1] * v1[1] + v1[2] * v1[2] + v1[3] * v1[3];
                            *(u32x4*)(C + (size_t)row * 512 + cb + col) = pack8(v0, v1); }
                        s += __shfl_xor(s, 16); s += __shfl_xor(s, 32);
                        if (fq == 0) ssq[(size_t)row * 8 + (u.pn & 1) * 4 + wc] = s; }
            } else if (u.pn < 12) {
                bf16_t* Zs = (bf16_t*)(ws + WS_Z); const int cb = (u.pn - 4) * 256;
#pragma unroll
                EPI_LOOP
                    for (int e = 0; e < 4; ++e) { v0[e] = siluf(v0[e]); v1[e] = siluf(v1[e]); }
                    *(u32x4*)(Zs + (size_t)row * 2048 + cb + col) = pack8(v0, v1);
                EPI_END
            } else {
                if (colw < 64) {
                    bf16_t* KR = (bf16_t*)(ws + WS_Z + 96 * MiB); const float* COS = (const float*)(ws + WS_COS); const float* SIN = (const float*)(ws + WS_SIN);
#pragma unroll
                    for (int ai = 0; ai < 2; ++ai)
#pragma unroll
                        for (int m = 0; m < 4; ++m) { const int row = rowb + ai * 128 + m * 16; const int j0 = colw >> 1;
                            const f32x4 v0 = acc[ai][0][m][0], v1 = acc[ai][0][m][1];
                            const f32x4 cs = *(const f32x4*)(COS + (size_t)row * 32 + j0), sn = *(const f32x4*)(SIN + (size_t)row * 32 + j0);
                            const f32x4 a = (f32x4){v0[0], v0[2], v1[0], v1[2]}, b = (f32x4){v0[1], v0[3], v1[1], v1[3]};
                            const f32x4 ra = a * cs - b * sn, rb = b * cs + a * sn;
                            *(u32x4*)(KR + (size_t)row * 64 + colw) = pack8((f32x4){ra[0], rb[0], ra[1], rb[1]}, (f32x4){ra[2], rb[2], ra[3], rb[3]}); }
                }
            }
        } else if (mode == EM_HG) {
            const int region = u.pn >> 3, cb = (u.pn & 7) * 256;
            if (region == 0) {
                bf16_t* Q = (bf16_t*)(ws + WS_BIG);
#pragma unroll
                EPI_LOOP
                    for (int e = 0; e < 4; ++e) { v0[e] = siluf(v0[e]) * 0.08838834764831845f; v1[e] = siluf(v1[e]) * 0.08838834764831845f; }
                    *(u32x4*)(Q + (size_t)row * 2048 + cb + col) = pack8(v0, v1);
                EPI_END
            } else if (region == 1) {
                bf16_t* Kk = (bf16_t*)(ws + WS_BIG + 64 * MiB); float* G = (float*)(ws + WS_BIG + 128 * MiB);
#pragma unroll
                for (int bj = 0; bj < 2; ++bj) { const int col = colw + bj * 128; const f32x4 l0 = *(const f32x4*)(lb + cb + col), l1 = *(const f32x4*)(lb + cb + col + 4);
#pragma unroll
                    for (int ai = 0; ai < 2; ++ai)
#pragma unroll
                        for (int m = 0; m < 4; ++m) { const int row = rowb + ai * 128 + m * 16; const f32x4 v0 = acc[ai][bj][m][0], v1 = acc[ai][bj][m][1]; f32x4 g0, g1, k0, k1;
#pragma unroll
                            for (int e = 0; e < 4; ++e) {
                                { const float f = v0[e], l = l0[e], en = __expf(-fabsf(f)), ls = fminf(f, 0.f) - __logf(1.f + en), sg = __expf(ls);
                                  g0[e] = (l == 0.f) ? ls : __logf(l + (1.f - l) * sg); k0[e] = (1.f - l) * (1.f - sg); }
                                { const float f = v1[e], l = l1[e], en = __expf(-fabsf(f)), ls = fminf(f, 0.f) - __logf(1.f + en), sg = __expf(ls);
                                  g1[e] = (l == 0.f) ? ls : __logf(l + (1.f - l) * sg); k1[e] = (1.f - l) * (1.f - sg); } }
                            float* gp = G + (size_t)row * 2048 + cb + col; *(f32x4*)gp = g0; *(f32x4*)(gp + 4) = g1;
                            *(u32x4*)(Kk + (size_t)row * 2048 + cb + col) = pack8(k0, k1); } }
            } else if (region == 2) {
                bf16_t* V = (bf16_t*)(ws + WS_Z);
#pragma unroll
                EPI_LOOP *(u32x4*)(V + (size_t)row * 2048 + cb + col) = pack8(v0, v1); EPI_END
            } else {
                bf16_t* Zs = (bf16_t*)(ws + WS_Z + 64 * MiB);
#pragma unroll
                EPI_LOOP
                    for (int e = 0; e < 4; ++e) { v0[e] = siluf(v0[e]); v1[e] = siluf(v1[e]); }
                    *(u32x4*)(Zs + (size_t)row * 2048 + cb + col) = pack8(v0, v1);
                EPI_END
            }
        } else if (mode == EM_GDN) {
            if (u.pn < 32) {
                bf16_t* QKV = (bf16_t*)(ws + WS_BIG);
#pragma unroll
                EPI_LOOP *(u32x4*)(QKV + (size_t)row * 8192 + u.pn * 256 + col) = pack8(v0, v1); EPI_END
            } else if (u.pn < 48) {
                bf16_t* Zs = (bf16_t*)(ws + WS_Z); const int cb = (u.pn - 32) * 256;
#pragma unroll
                EPI_LOOP
                    for (int e = 0; e < 4; ++e) { v0[e] = siluf(v0[e]); v1[e] = siluf(v1[e]); }
                    *(u32x4*)(Zs + (size_t)row * 4096 + cb + col) = pack8(v0, v1);
                EPI_END
            } else {
                if (colw < 64) {
                    float* GD = (float*)(ws + WS_GD); float* BD = (float*)(ws + WS_BD);
#pragma unroll
                    for (int ai = 0; ai < 2; ++ai)
#pragma unroll
                        for (int m = 0; m < 4; ++m) { const int row = rowb + ai * 128 + m * 16; f32x4 v0 = acc[ai][0][m][0], v1 = acc[ai][0][m][1];
                            if (colw < 32) {
                                const f32x4 a0 = *(const f32x4*)(alog + colw), a1 = *(const f32x4*)(alog + colw + 4), d0 = *(const f32x4*)(dtb + colw), d1 = *(const f32x4*)(dtb + colw + 4);
#pragma unroll
                                for (int e = 0; e < 4; ++e) {
                                    { const float x = v0[e] + d0[e]; const float sp = fmaxf(x, 0.f) + __logf(1.f + __expf(-fabsf(x))); v0[e] = -__expf(a0[e]) * sp; }
                                    { const float x = v1[e] + d1[e]; const float sp = fmaxf(x, 0.f) + __logf(1.f + __expf(-fabsf(x))); v1[e] = -__expf(a1[e]) * sp; } }
                                float* p = GD + (size_t)row * 32 + colw; *(f32x4*)p = v0; *(f32x4*)(p + 4) = v1;
                            } else {
#pragma unroll
                                for (int e = 0; e < 4; ++e) { v0[e] = sigmf(v0[e]); v1[e] = sigmf(v1[e]); }
                                float* p = BD + (size_t)row * 32 + (colw - 32); *(f32x4*)p = v0; *(f32x4*)(p + 4) = v1;
                            } }
                }
            }
        }
#undef EPI_LOOP
#undef EPI_END
    }
};

__device__ __forceinline__ void run_gemm(LAS unsigned char* lds, const bf16_t* A, const bf16_t* Bt, int N, int K, const Epi E) {
    pg8::Gemm g{A, Bt, MTOK, N, K}; pg8::StaticOrder S; S.init(MTOK, N, (int)gridDim.x, (int)blockIdx.x);
    pg8::gemm_phase<Epi, pg8::StaticOrder>(lds, g, S, E);
    __syncthreads();
}

__device__ __forceinline__ s16x4 tr_read(const bf16_t* p) {
    typedef short v4i16_t __attribute__((ext_vector_type(4)));
    return __builtin_bit_cast(s16x4, __builtin_amdgcn_ds_read_tr16_b64_v4i16((LAS v4i16_t*)p));
}
__device__ __forceinline__ bf16x8 frag_tr(const bf16_t* base, int stride, int k0, int c0, int fr, int fq) {
    const bf16_t* p = base + (k0 + 8 * fq + (fr >> 2)) * stride + c0 + 4 * (fr & 3);
    const s16x4 r0 = tr_read(p), r1 = tr_read(p + 4 * stride);
    return (bf16x8){r0[0], r0[1], r0[2], r0[3], r1[0], r1[1], r1[2], r1[3]};
}
__device__ __forceinline__ bf16x8 frag_row(const bf16_t* base, int stride, int r0, int k0, int fr, int fq) { return *(const bf16x8*)(base + (r0 + fr) * stride + k0 + 8 * fq); }

__device__ __forceinline__ f32x4 quad_t4(const f32x4 a, int q) {
    const bool b0 = q & 1, b1 = q & 2;
    const float s0 = b0 ? a[0] : a[1], s1 = b0 ? a[2] : a[3];
    const float r0 = __builtin_bit_cast(float, __builtin_amdgcn_mov_dpp(__builtin_bit_cast(int, s0), 0xB1, 0xF, 0xF, true));
    const float r1 = __builtin_bit_cast(float, __builtin_amdgcn_mov_dpp(__builtin_bit_cast(int, s1), 0xB1, 0xF, 0xF, true));
    const float c0 = b0 ? r0 : a[0], c1 = b0 ? a[1] : r0, d0 = b0 ? r1 : a[2], d1 = b0 ? a[3] : r1;
    const float t0 = b1 ? c0 : d0, t1 = b1 ? c1 : d1;
    const float u0 = __builtin_bit_cast(float, __builtin_amdgcn_mov_dpp(__builtin_bit_cast(int, t0), 0x4E, 0xF, 0xF, true));
    const float u1 = __builtin_bit_cast(float, __builtin_amdgcn_mov_dpp(__builtin_bit_cast(int, t1), 0x4E, 0xF, 0xF, true));
    return (f32x4){b1 ? u0 : c0, b1 ? u1 : c1, b1 ? d0 : u0, b1 ? d1 : u1};
}
__device__ __forceinline__ void store_ctile_bf16(bf16_t* base, int stride, int row0, int col0, const f32x4 a, int fr, int fq) {
    const f32x4 o = quad_t4(a, fr & 3);
    u32x2 w; w.x = pg8::cvt_pk_bf16(o[0], o[1]); w.y = pg8::cvt_pk_bf16(o[2], o[3]);
    *(u32x2*)(base + (row0 + 4 * fq + (fr & 3)) * stride + col0 + 4 * (fr >> 2)) = w;
}
__device__ __forceinline__ void store_ctile_f32(float* base, int stride, int row0, int col0, const f32x4 a, int fr, int fq) {
    *(f32x4*)(base + (row0 + 4 * fq + (fr & 3)) * stride + col0 + 4 * (fr >> 2)) = quad_t4(a, fr & 3);
}

__device__ __forceinline__ void gla_chunked(unsigned char* lds, unsigned char* ws, const float* hn, bool dry) {
    if (blockIdx.x >= 128) return;
    const int tid = fresh_tid(), lane = tid & 63, w = __builtin_amdgcn_readfirstlane(tid >> 6), fr = lane & 15, fq = lane >> 4;
    const int b = blockIdx.x >> 4, h = blockIdx.x & 15;
    const bf16_t* Q = (const bf16_t*)(ws + WS_BIG); const bf16_t* Kk = (const bf16_t*)(ws + WS_BIG + 64 * MiB); const float* G = (const float*)(ws + WS_BIG + 128 * MiB);
    const bf16_t* V = (const bf16_t*)(ws + WS_Z); bf16_t* Zs = (bf16_t*)(ws + WS_Z + 64 * MiB);
    bf16_t* QD = (bf16_t*)lds; bf16_t* KD = (bf16_t*)(lds + 17408); bf16_t* VV = (bf16_t*)(lds + 35840); bf16_t* PP = (bf16_t*)(lds + 54272);
    bf16_t* SB = (bf16_t*)(lds + 63488); float* OT = (float*)(lds + 104960); float* TOT0 = (float*)(lds + 100352);
    const int c = tid & 127, part = tid >> 7;
    f32x4 S[8];
#pragma unroll
    for (int i = 0; i < 8; ++i) S[i] = (f32x4){0.f, 0.f, 0.f, 0.f};
    float* HN = (float*)(lds + 104448); if (tid < 128) HN[tid] = hn[tid];
    float ng[16]; bf16_t nq[16], nk[16]; u32x4 nv0, nv1;
    {
#pragma unroll
        for (int i = 0; i < 16; ++i) { const size_t gi = (size_t)(b * SEQ + 16 * part + i) * 2048 + h * 128 + c; ng[i] = G[gi]; nq[i] = Q[gi]; nk[i] = Kk[gi]; }
        nv0 = *(const u32x4*)(V + (size_t)(b * SEQ + (tid >> 4)) * 2048 + h * 128 + (tid & 15) * 8); nv1 = *(const u32x4*)(V + (size_t)(b * SEQ + ((tid + 512) >> 4)) * 2048 + h * 128 + (tid & 15) * 8);
    }
    u32x4 zp0 = (u32x4){0u, 0u, 0u, 0u}, zp1 = zp0; int trp = 0;
    for (int ch = 0; ch < 32; ++ch) {
        const int tid = fresh_tid(), lane = tid & 63, fr = lane & 15, fq = lane >> 4, c = tid & 127, part = tid >> 7; (void)lane;
        const int trow0 = b * SEQ + ch * 64;
        float g[16], qv[16], kv[16];
#pragma unroll
        for (int i = 0; i < 16; ++i) { g[i] = ng[i]; qv[i] = bf2f(nq[i]); kv[i] = bf2f(nk[i]); }
        float* TOT = TOT0 + (ch & 1) * 512;
        const u32x4 cv0 = nv0, cv1 = nv1;
        const u32x4 zc0 = *(const u32x4*)(Zs + (size_t)(trow0 + (tid >> 3)) * 2048 + h * 128 + (tid & 7) * 16), zc1 = *(const u32x4*)(Zs + (size_t)(trow0 + (tid >> 3)) * 2048 + h * 128 + (tid & 7) * 16 + 8);
        if (ch + 1 < 32) {
#pragma unroll
            for (int i = 0; i < 16; ++i) { const size_t gi = (size_t)(trow0 + 64 + 16 * part + i) * 2048 + h * 128 + c; ng[i] = G[gi]; nq[i] = Q[gi]; nk[i] = Kk[gi]; }
            nv0 = *(const u32x4*)(V + (size_t)(trow0 + 64 + (tid >> 4)) * 2048 + h * 128 + (tid & 15) * 8); nv1 = *(const u32x4*)(V + (size_t)(trow0 + 64 + ((tid + 512) >> 4)) * 2048 + h * 128 + (tid & 15) * 8);
        }
#pragma unroll
        for (int i = 1; i < 16; ++i) g[i] += g[i - 1];
        TOT[part * 128 + c] = g[15];
        __syncthreads();
        if (ch > 0)
        {
            const int r = tid >> 3, seg = tid & 7; const float* op = OT + r * 132 + seg * 16;
            f32x4 v[4]; float ss = 0.f;
#pragma unroll
            for (int i = 0; i < 4; ++i) { v[i] = *(const f32x4*)(op + 4 * i); ss += v[i][0] * v[i][0] + v[i][1] * v[i][1] + v[i][2] * v[i][2] + v[i][3] * v[i][3]; }
            ss += __shfl_xor(ss, 1); ss += __shfl_xor(ss, 2); ss += __shfl_xor(ss, 4);
            const float rn = rsqrtf(ss * (1.f / 128.f) + EPS);
            bf16_t* zp = Zs + (size_t)(trp + r) * 2048 + h * 128 + seg * 16;
#pragma unroll
            for (int i = 0; i < 2; ++i) { const u32x4 zz = i ? zp1 : zp0; const f32x4 h0 = *(const f32x4*)(HN + seg * 16 + 8 * i), h1 = *(const f32x4*)(HN + seg * 16 + 8 * i + 4);
                f32x4 o0 = v[2 * i] * rn * h0, o1 = v[2 * i + 1] * rn * h1;
                o0[0] *= __uint_as_float(zz.x << 16); o0[1] *= __uint_as_float(zz.x & 0xffff0000u); o0[2] *= __uint_as_float(zz.y << 16); o0[3] *= __uint_as_float(zz.y & 0xffff0000u);
                o1[0] *= __uint_as_float(zz.z << 16); o1[1] *= __uint_as_float(zz.z & 0xffff0000u); o1[2] *= __uint_as_float(zz.w << 16); o1[3] *= __uint_as_float(zz.w & 0xffff0000u);
                if (!dry) *(u32x4*)(zp + 8 * i) = pack8(o0, o1); }
        }
        *(u32x4*)(VV + (tid >> 4) * 144 + (tid & 15) * 8) = cv0; *(u32x4*)(VV + ((tid + 512) >> 4) * 144 + (tid & 15) * 8) = cv1;
#ifdef GLASKIP_B
        if (!dry)
#endif
        {
            const float t0 = TOT[c], t1 = TOT[128 + c], t2 = TOT[256 + c];
            const float off = (part > 0 ? t0 : 0.f) + (part > 1 ? t1 : 0.f) + (part > 2 ? t2 : 0.f), bref = t0 + t1;
#pragma unroll
            for (int i = 0; i < 16; ++i) { const float bt = g[i] + off;
                QD[(16 * part + i) * 136 + c] = f2bf(qv[i] * __expf(fminf(bt - bref, 80.f))); KD[(16 * part + i) * 144 + c] = f2bf(kv[i] * __expf(fminf(bref - bt, 80.f))); }
            { f32x4 er;
#pragma unroll
              for (int j = 0; j < 4; ++j) { const int kk = 16 * w + 4 * fq + j; er[j] = __expf(TOT[kk] + TOT[128 + kk]); }
#pragma unroll
              for (int vt = 0; vt < 8; ++vt) store_ctile_bf16(SB, 144, 16 * w, 16 * vt, S[vt] * er, fr, fq); }
        }
        __syncthreads();
#ifdef GLASKIP_C
        if (!dry)
#endif
        {
            const int tt = w >> 1;
#pragma unroll
            for (int x = 0; x < 2; ++x) { const int st = (w & 1) * 2 + x; f32x4 acc = (f32x4){0.f, 0.f, 0.f, 0.f};
                if (st <= tt) {
#pragma unroll
                    for (int ks = 0; ks < 4; ++ks) acc = __builtin_amdgcn_mfma_f32_16x16x32_bf16(frag_row(QD, 136, 16 * tt, 32 * ks, fr, fq), frag_row(KD, 144, 16 * st, 32 * ks, fr, fq), acc, 0, 0, 0);
                }
#pragma unroll
                for (int j = 0; j < 4; ++j) { const int t = 16 * tt + 4 * fq + j, sx = 16 * st + fr; acc[j] = (st <= tt && sx <= t) ? acc[j] : 0.f; }
                store_ctile_bf16(PP, 72, 16 * tt, 16 * st, acc, fr, fq); }
        }
        __syncthreads();
        f32x4 oacc[4];
#ifdef GLASKIP_D
        if (dry) { oacc[0] = oacc[1] = oacc[2] = oacc[3] = S[0]; } else
#endif
        {
            const int tt = w >> 1;
#pragma unroll
            for (int x = 0; x < 4; ++x) { const int vt = (w & 1) * 4 + x; f32x4 acc = (f32x4){0.f, 0.f, 0.f, 0.f};
#pragma unroll
                for (int ks = 0; ks < 2; ++ks) acc = __builtin_amdgcn_mfma_f32_16x16x32_bf16(frag_row(PP, 72, 16 * tt, 32 * ks, fr, fq), frag_tr(VV, 144, 32 * ks, 16 * vt, fr, fq), acc, 0, 0, 0);
#pragma unroll
                for (int ks = 0; ks < 4; ++ks) acc = __builtin_amdgcn_mfma_f32_16x16x32_bf16(frag_row(QD, 136, 16 * tt, 32 * ks, fr, fq), frag_tr(SB, 144, 32 * ks, 16 * vt, fr, fq), acc, 0, 0, 0);
                oacc[x] = acc; }
            float el[4], e2[4];
#pragma unroll
            for (int j = 0; j < 4; ++j) { const int kk = 16 * w + 4 * fq + j; const float hi = TOT[256 + kk] + TOT[384 + kk]; e2[j] = __expf(hi); el[j] = __expf(TOT[kk] + TOT[128 + kk] + hi); }
            const bf16x8 ka0 = frag_tr(KD, 144, 0, 16 * w, fr, fq), ka1 = frag_tr(KD, 144, 32, 16 * w, fr, fq);
#pragma unroll
            for (int vt = 0; vt < 8; ++vt) { f32x4 a2 = (f32x4){0.f, 0.f, 0.f, 0.f};
                a2 = __builtin_amdgcn_mfma_f32_16x16x32_bf16(ka0, frag_tr(VV, 144, 0, 16 * vt, fr, fq), a2, 0, 0, 0);
                a2 = __builtin_amdgcn_mfma_f32_16x16x32_bf16(ka1, frag_tr(VV, 144, 32, 16 * vt, fr, fq), a2, 0, 0, 0);
#pragma unroll
                for (int j = 0; j < 4; ++j) S[vt][j] = el[j] * S[vt][j] + e2[j] * a2[j]; }
        }
        {
            const int tt = w >> 1;
#pragma unroll
            for (int x = 0; x < 4; ++x) { const int vt = (w & 1) * 4 + x; store_ctile_f32(OT, 132, 16 * tt, 16 * vt, oacc[x], fr, fq); }
        }
        zp0 = zc0; zp1 = zc1; trp = trow0;
    }
    __syncthreads();
        {
            const int r = tid >> 3, seg = tid & 7; const float* op = OT + r * 132 + seg * 16;
            f32x4 v[4]; float ss = 0.f;
#pragma unroll
            for (int i = 0; i < 4; ++i) { v[i] = *(const f32x4*)(op + 4 * i); ss += v[i][0] * v[i][0] + v[i][1] * v[i][1] + v[i][2] * v[i][2] + v[i][3] * v[i][3]; }
            ss += __shfl_xor(ss, 1); ss += __shfl_xor(ss, 2); ss += __shfl_xor(ss, 4);
            const float rn = rsqrtf(ss * (1.f / 128.f) + EPS);
            bf16_t* zp = Zs + (size_t)(trp + r) * 2048 + h * 128 + seg * 16;
#pragma unroll
            for (int i = 0; i < 2; ++i) { const u32x4 zz = i ? zp1 : zp0; const f32x4 h0 = *(const f32x4*)(HN + seg * 16 + 8 * i), h1 = *(const f32x4*)(HN + seg * 16 + 8 * i + 4);
                f32x4 o0 = v[2 * i] * rn * h0, o1 = v[2 * i + 1] * rn * h1;
                o0[0] *= __uint_as_float(zz.x << 16); o0[1] *= __uint_as_float(zz.x & 0xffff0000u); o0[2] *= __uint_as_float(zz.y << 16); o0[3] *= __uint_as_float(zz.y & 0xffff0000u);
                o1[0] *= __uint_as_float(zz.z << 16); o1[1] *= __uint_as_float(zz.z & 0xffff0000u); o1[2] *= __uint_as_float(zz.w << 16); o1[3] *= __uint_as_float(zz.w & 0xffff0000u);
                if (!dry) *(u32x4*)(zp + 8 * i) = pack8(o0, o1); }
        }
}


constexpr int GD_KK = 0, GD_QQ = 18432, GD_VN = 35840, GD_SB = 54272, GD_AW = 91136, GD_AT = 108544, GD_UU = 117760, GD_MM = 136192, GD_W = 143104, GD_SM = 160512, GD_HN = 162560, GD_END = 163072;
constexpr int GD_AB = GD_AW + 4096, GD_TI = GD_AW + 13312;
constexpr int GD_RAW = GD_AW;
__device__ __forceinline__ void gdn_chunked(unsigned char* lds, unsigned char* ws, const float* cw, const float* hn, bool dry) {
    const int w = __builtin_amdgcn_readfirstlane(fresh_tid() >> 6);
    const bf16_t* QKV = (const bf16_t*)(ws + WS_BIG); bf16_t* Zs = (bf16_t*)(ws + WS_Z); const float* GDp = (const float*)(ws + WS_GD); const float* BDp = (const float*)(ws + WS_BD);
    bf16_t* KK = (bf16_t*)(lds + GD_KK); bf16_t* QQ = (bf16_t*)(lds + GD_QQ); float* AW = (float*)(lds + GD_AW); bf16_t* W = (bf16_t*)(lds + GD_W); bf16_t* AT = (bf16_t*)(lds + GD_AT);
    bf16_t* UU = (bf16_t*)(lds + GD_UU); bf16_t* VN = (bf16_t*)(lds + GD_VN); bf16_t* SB = (bf16_t*)(lds + GD_SB); bf16_t* OT = (bf16_t*)(lds + GD_W); bf16_t* RAW = (bf16_t*)(lds + GD_RAW); bf16_t* AB = (bf16_t*)(lds + GD_AB); bf16_t* TI = (bf16_t*)(lds + GD_TI); bf16_t* MM = (bf16_t*)(lds + GD_MM);
    float* gcs = (float*)(lds + GD_SM); float* egs = gcs + 64; float* bts = gcs + 128; float* nk2 = gcs + 192; float* nq2 = gcs + 256; float* rks = gcs + 320; float* rqs = gcs + 384;
    float* HN = (float*)(lds + GD_HN); { const int t_ = fresh_tid(); if (t_ < 128) HN[t_] = hn[t_]; }
    for (int item = blockIdx.x; item < 256; item += gridDim.x) {
        const int b = item >> 5, vh = item & 31, hq = vh >> 1;
        f32x4 S[8];
#pragma unroll
        for (int i = 0; i < 8; ++i) S[i] = (f32x4){0.f, 0.f, 0.f, 0.f};
        const int c = fresh_tid() & 127;
        const float wq0 = cw[hq * 128 + c], wq1 = cw[8192 + hq * 128 + c], wq2 = cw[16384 + hq * 128 + c], wq3 = cw[24576 + hq * 128 + c];
        const float wk0 = cw[2048 + hq * 128 + c], wk1 = cw[8192 + 2048 + hq * 128 + c], wk2 = cw[16384 + 2048 + hq * 128 + c], wk3 = cw[24576 + 2048 + hq * 128 + c];
        const float wv0 = cw[4096 + vh * 128 + c], wv1 = cw[8192 + 4096 + vh * 128 + c], wv2 = cw[16384 + 4096 + vh * 128 + c], wv3 = cw[24576 + 4096 + vh * 128 + c];
        u32x4 praw[7];
#define GD_LOADRAW(chn) do { _Pragma("unroll") for (int i = 0; i < 7; ++i) { const int p = ptid + 512 * i; praw[i] = (u32x4){0u, 0u, 0u, 0u}; \
            if (p < 3216) { const int r = p / 48, k = p - r * 48; const int tl = (chn) * 64 + r - 3; const int chb = (k < 16) ? hq * 128 + k * 8 : ((k < 32) ? 2048 + hq * 128 + (k - 16) * 8 : 4096 + vh * 128 + (k - 32) * 8); \
                if (tl >= 0) praw[i] = *(const u32x4*)(QKV + (size_t)(b * SEQ + tl) * 8192 + chb); } } } while (0)
        { const int ptid = fresh_tid(); GD_LOADRAW(0); }
        float pgd = GDp[(size_t)(b * SEQ + (fresh_tid() & 63)) * 32 + vh], pbd = BDp[(size_t)(b * SEQ + (fresh_tid() & 63)) * 32 + vh];
        u32x4 zp0 = (u32x4){0u, 0u, 0u, 0u}, zp1 = zp0; int trp = 0;
        for (int ch = 0; ch < 32; ++ch) {
            const int tid = fresh_tid(), lane = tid & 63, c = tid & 127, part = tid >> 7;
            const int trow0 = b * SEQ + ch * 64;
#pragma unroll
            for (int i = 0; i < 7; ++i) { const int p = tid + 512 * i; if (p < 3216) *(u32x4*)(RAW + p * 8) = praw[i]; }
            const u32x4 zz0 = *(const u32x4*)(Zs + (size_t)(trow0 + (tid >> 3)) * 4096 + vh * 128 + (tid & 7) * 16), zz1 = *(const u32x4*)(Zs + (size_t)(trow0 + (tid >> 3)) * 4096 + vh * 128 + (tid & 7) * 16 + 8);
            if (w == 0) {
                float gsum = pgd;
#define GD_DPP(x, ctrl, rmask) __builtin_bit_cast(float, __builtin_amdgcn_update_dpp(0, __builtin_bit_cast(int, x), ctrl, rmask, 0xF, false))
                gsum += GD_DPP(gsum, 0x111, 0xF); gsum += GD_DPP(gsum, 0x112, 0xF); gsum += GD_DPP(gsum, 0x114, 0xF); gsum += GD_DPP(gsum, 0x118, 0xF);
                gsum += GD_DPP(gsum, 0x142, 0xA); gsum += GD_DPP(gsum, 0x143, 0xC);
#undef GD_DPP
                gcs[lane] = gsum; egs[lane] = __expf(gsum); bts[lane] = pbd;
            }
            if (ch + 1 < 32) { pgd = GDp[(size_t)(trow0 + 64 + lane) * 32 + vh]; pbd = BDp[(size_t)(trow0 + 64 + lane) * 32 + vh]; }
            { const int lt_ = fresh_tid(); const int fr = lt_ & 15, fq = (lt_ & 63) >> 4;
#pragma unroll
              for (int vt = 0; vt < 8; ++vt) store_ctile_bf16(SB, 144, 16 * w, 16 * vt, S[vt], fr, fq); }
            __syncthreads();
            if (ch > 0)
            {
                const int lt2_ = fresh_tid(); const int r = lt2_ >> 3, seg = lt2_ & 7; const bf16_t* op = OT + r * 136 + seg * 16;
                f32x4 v[4]; float ss = 0.f;
                { const u32x4 q0 = *(const u32x4*)op, q1 = *(const u32x4*)(op + 8);
                  v[0] = (f32x4){__uint_as_float(q0.x << 16), __uint_as_float(q0.x & 0xffff0000u), __uint_as_float(q0.y << 16), __uint_as_float(q0.y & 0xffff0000u)};
                  v[1] = (f32x4){__uint_as_float(q0.z << 16), __uint_as_float(q0.z & 0xffff0000u), __uint_as_float(q0.w << 16), __uint_as_float(q0.w & 0xffff0000u)};
                  v[2] = (f32x4){__uint_as_float(q1.x << 16), __uint_as_float(q1.x & 0xffff0000u), __uint_as_float(q1.y << 16), __uint_as_float(q1.y & 0xffff0000u)};
                  v[3] = (f32x4){__uint_as_float(q1.z << 16), __uint_as_float(q1.z & 0xffff0000u), __uint_as_float(q1.w << 16), __uint_as_float(q1.w & 0xffff0000u)}; }
#pragma unroll
                for (int i = 0; i < 4; ++i) ss += v[i][0] * v[i][0] + v[i][1] * v[i][1] + v[i][2] * v[i][2] + v[i][3] * v[i][3];
                ss += __shfl_xor(ss, 1); ss += __shfl_xor(ss, 2); ss += __shfl_xor(ss, 4);
                const float rn = rsqrtf(ss * (1.f / 128.f) + EPS);
                bf16_t* zp = Zs + (size_t)(trp + r) * 4096 + vh * 128 + seg * 16;
#pragma unroll
                for (int i = 0; i < 2; ++i) { const u32x4 zz = i ? zp1 : zp0; const f32x4 h0 = *(const f32x4*)(HN + seg * 16 + 8 * i), h1 = *(const f32x4*)(HN + seg * 16 + 8 * i + 4);
                    f32x4 o0 = v[2 * i] * rn * h0, o1 = v[2 * i + 1] * rn * h1;
                    o0[0] *= __uint_as_float(zz.x << 16); o0[1] *= __uint_as_float(zz.x & 0xffff0000u); o0[2] *= __uint_as_float(zz.y << 16); o0[3] *= __uint_as_float(zz.y & 0xffff0000u);
                    o1[0] *= __uint_as_float(zz.z << 16); o1[1] *= __uint_as_float(zz.z & 0xffff0000u); o1[2] *= __uint_as_float(zz.w << 16); o1[3] *= __uint_as_float(zz.w & 0xffff0000u);
                    if (!dry) *(u32x4*)(zp + 8 * i) = pack8(o0, o1); }
            }
            if (ch + 1 < 32) { const int ptid = tid; GD_LOADRAW(ch + 1); }
#ifdef DRYSKIP_CONV
            if (!dry)
#endif
            {
                const bf16_t* rp = RAW + (16 * part) * 384 + c;
                float x0, x1, x2;
#define GD_CONV(off, w0, w1, w2, w3, STORE) \
                x0 = bf2f(rp[off]); x1 = bf2f(rp[384 + off]); x2 = bf2f(rp[768 + off]); \
                _Pragma("unroll") for (int i = 0; i < 16; ++i) { const float x3 = bf2f(rp[(i + 3) * 384 + off]); const float y = siluf(w0 * x0 + w1 * x1 + w2 * x2 + w3 * x3); const int t = 16 * part + i; STORE; x0 = x1; x1 = x2; x2 = x3; }
                GD_CONV(0, wq0, wq1, wq2, wq3, QQ[t * 136 + c] = f2bf(y))
                GD_CONV(128, wk0, wk1, wk2, wk3, KK[t * 144 + c] = f2bf(y))
                GD_CONV(256, wv0, wv1, wv2, wv3, VN[t * 144 + c] = f2bf(y * bts[t]))
#undef GD_CONV
            }
            __syncthreads();
            f32x4 ak[2], aq[2];
            {
                const int lt_ = fresh_tid(); const int fr = lt_ & 15, fq = (lt_ & 63) >> 4;
                const int tt = w >> 1;
#pragma unroll
                for (int x = 0; x < 2; ++x) { const int st = (w & 1) * 2 + x; f32x4 a1 = (f32x4){0.f, 0.f, 0.f, 0.f}, a2 = (f32x4){0.f, 0.f, 0.f, 0.f};
                    if (st <= tt) {
#pragma unroll
                        for (int ks = 0; ks < 4; ++ks) { const bf16x8 kb = frag_row(KK, 144, 16 * st, 32 * ks, fr, fq);
                            a1 = __builtin_amdgcn_mfma_f32_16x16x32_bf16(frag_row(KK, 144, 16 * tt, 32 * ks, fr, fq), kb, a1, 0, 0, 0);
                            a2 = __builtin_amdgcn_mfma_f32_16x16x32_bf16(frag_row(QQ, 136, 16 * tt, 32 * ks, fr, fq), kb, a2, 0, 0, 0); }
                    }
                    if (st == tt) { f32x4 a3 = (f32x4){0.f, 0.f, 0.f, 0.f};
#pragma unroll
                        for (int ks = 0; ks < 4; ++ks) { const bf16x8 qa = frag_row(QQ, 136, 16 * tt, 32 * ks, fr, fq); a3 = __builtin_amdgcn_mfma_f32_16x16x32_bf16(qa, qa, a3, 0, 0, 0); }
#pragma unroll
                        for (int j = 0; j < 4; ++j) if (4 * fq + j == fr) { nk2[16 * tt + fr] = a1[j]; nq2[16 * tt + fr] = a3[j]; } }
                    ak[x] = a1; aq[x] = a2; }
            }
            __syncthreads();
            {
                const int lt_ = fresh_tid(); const int fr = lt_ & 15, fq = (lt_ & 63) >> 4;
                const int tt = w >> 1;
                if (lt_ < 64) { rks[lt_] = rsqrtf(nk2[lt_] + EPS); rqs[lt_] = rsqrtf(nq2[lt_] + EPS) * 0.08838834764831845f; }
#pragma unroll
                for (int x = 0; x < 2; ++x) { const int st = (w & 1) * 2 + x; f32x4 av, tv;
#pragma unroll
                    for (int j = 0; j < 4; ++j) { const int t = 16 * tt + 4 * fq + j, sx = 16 * st + fr; const float dec = __expf(fminf(gcs[t] - gcs[sx], 0.f));
                        const float rkt = rsqrtf(nk2[t] + EPS), rks_ = rsqrtf(nk2[sx] + EPS), rqt = rsqrtf(nq2[t] + EPS) * 0.08838834764831845f;
                        av[j] = (st <= tt && sx < t) ? bts[t] * ak[x][j] * rkt * rks_ * dec : 0.f;
                        tv[j] = (st <= tt && sx <= t) ? aq[x][j] * rqt * rks_ * dec : 0.f; }
                    if (st == tt) store_ctile_f32(AW, 16, 16 * tt, 0, av, fr, fq);
                    if (st <= tt) store_ctile_bf16(AB, 72, 16 * tt, 16 * st, av, fr, fq);
                    store_ctile_bf16(AT, 72, 16 * tt, 16 * st, tv, fr, fq); }
                if (w == 0 || w == 2 || w == 5 || w == 7) {
                    const int l = lt_ & 63, c = l & 15;
                    float Ar[16], T[16];
#pragma unroll
                    for (int i = 0; i < 16; ++i) { Ar[i] = AW[(16 * tt + i) * 16 + c]; T[i] = (i == c) ? 1.f : 0.f; }
#pragma unroll
                    for (int i = 1; i < 16; ++i)
#pragma unroll
                        for (int j = 0; j < i; ++j) { const float sv = __builtin_bit_cast(float, __builtin_amdgcn_readlane(__builtin_bit_cast(int, Ar[i]), j)); T[i] -= sv * T[j]; }
                    if (l < 32) {
#pragma unroll
                        for (int i = 0; i < 16; ++i) TI[(tt * 16 + i) * 32 + l] = f2bf(((l >> 4) == (tt & 1)) ? T[i] : 0.f);
                    }
                }
            }
            {
                const int lt_ = fresh_tid();
#pragma unroll
                for (int i = 0; i < 16; ++i) { const int e = lt_ + 512 * i, t = e >> 7, k = e & 127; W[t * 136 + k] = f2bf(bf2f(KK[t * 144 + k]) * (bts[t] * egs[t] * rsqrtf(nk2[t] + EPS))); }
                { const int which = lt_ >> 8, r = (lt_ >> 4) & 15, ci = lt_ & 15; if (which == 0) MM[r * 72 + 16 + ci] = (bf16_t)0; else MM[(32 + r) * 72 + 48 + ci] = (bf16_t)0; }
            }
            __syncthreads();
#ifdef DRYSKIP_SOLVE
            if (!dry)
#endif
            {
                const int lt_ = fresh_tid(); const int fr = lt_ & 15, fq = (lt_ & 63) >> 4;
                const bf16_t* rhs = (w < 4) ? VN : W; bf16_t* outp = (w < 4) ? UU : W; const int ostr = (w < 4) ? 144 : 136; const int cb = 32 * (w & 3);
                f32x4 tr[4][2];
#pragma unroll
                for (int r = 0; r < 4; ++r) { const bf16x8 ti = frag_row(TI + r * 512, 32, 0, 0, fr, fq);
#pragma unroll
                    for (int x = 0; x < 2; ++x) tr[r][x] = __builtin_amdgcn_mfma_f32_16x16x32_bf16(ti, frag_tr(rhs, ostr, 32 * (r >> 1), cb + 16 * x, fr, fq), (f32x4){0.f, 0.f, 0.f, 0.f}, 0, 0, 0);
                    const int mr = (w == 0) ? 1 : ((w < 3) ? 2 : 3), mc = (w == 0) ? 0 : ((w < 3) ? w - 1 : w - 3);
                    if (w < 6 && mr == r) { const f32x4 m = __builtin_amdgcn_mfma_f32_16x16x32_bf16(ti, frag_tr(AB, 72, 32 * (r >> 1), 16 * mc, fr, fq), (f32x4){0.f, 0.f, 0.f, 0.f}, 0, 0, 0);
                        store_ctile_bf16(MM, 72, (r - 1) * 16, 16 * mc, -m, fr, fq); } }
                __syncthreads();
#pragma unroll
                for (int x = 0; x < 2; ++x) { const int c0 = cb + 16 * x;
                    store_ctile_bf16(outp, ostr, 0, c0, tr[0][x], fr, fq);
                    f32x4 acc = __builtin_amdgcn_mfma_f32_16x16x32_bf16(frag_row(MM, 72, 0, 0, fr, fq), frag_tr(outp, ostr, 0, c0, fr, fq), tr[1][x], 0, 0, 0);
                    store_ctile_bf16(outp, ostr, 16, c0, acc, fr, fq);
                    acc = __builtin_amdgcn_mfma_f32_16x16x32_bf16(frag_row(MM + 16 * 72, 72, 0, 0, fr, fq), frag_tr(outp, ostr, 0, c0, fr, fq), tr[2][x], 0, 0, 0);
                    store_ctile_bf16(outp, ostr, 32, c0, acc, fr, fq);
                    acc = __builtin_amdgcn_mfma_f32_16x16x32_bf16(frag_row(MM + 32 * 72, 72, 0, 0, fr, fq), frag_tr(outp, ostr, 0, c0, fr, fq), tr[3][x], 0, 0, 0);
                    acc = __builtin_amdgcn_mfma_f32_16x16x32_bf16(frag_row(MM + 32 * 72, 72, 0, 32, fr, fq), frag_tr(outp, ostr, 32, c0, fr, fq), acc, 0, 0, 0);
                    store_ctile_bf16(outp, ostr, 48, c0, acc, fr, fq); }
            }
            __syncthreads();
            const float gcl = gcs[63];
#ifdef DRYSKIP_D
            if (!dry)
#endif
            {
                const int lt_ = fresh_tid(); const int fr = lt_ & 15, fq = (lt_ & 63) >> 4;
                const int tt = w >> 1;
#pragma unroll
                for (int x = 0; x < 4; ++x) { const int vt = (w & 1) * 4 + x; f32x4 acc = (f32x4){0.f, 0.f, 0.f, 0.f};
#pragma unroll
                    for (int ks = 0; ks < 4; ++ks) acc = __builtin_amdgcn_mfma_f32_16x16x32_bf16(frag_row(W, 136, 16 * tt, 32 * ks, fr, fq), frag_tr(SB, 144, 32 * ks, 16 * vt, fr, fq), acc, 0, 0, 0);
                    f32x4 vnv, vsv;
#pragma unroll
                    for (int j = 0; j < 4; ++j) { const int t = 16 * tt + 4 * fq + j, vx = 16 * vt + fr; const float vn = bf2f(UU[t * 144 + vx]) - acc[j]; vnv[j] = vn; vsv[j] = vn * __expf(gcl - gcs[t]) * rks[t]; }
                    store_ctile_bf16(VN, 144, 16 * tt, 16 * vt, vnv, fr, fq); store_ctile_bf16(UU, 144, 16 * tt, 16 * vt, vsv, fr, fq); asm volatile("" ::: "memory"); }
            }
            __syncthreads();
            f32x4 oacc[4];
            {
                const int lt_ = fresh_tid(); const int fr = lt_ & 15, fq = (lt_ & 63) >> 4;
                const int tt = w >> 1;
#pragma unroll
                for (int x = 0; x < 4; ++x) { const int vt = (w & 1) * 4 + x; f32x4 acc = (f32x4){0.f, 0.f, 0.f, 0.f};
#pragma unroll
                    for (int ks = 0; ks < 4; ++ks) acc = __builtin_amdgcn_mfma_f32_16x16x32_bf16(frag_row(QQ, 136, 16 * tt, 32 * ks, fr, fq), frag_tr(SB, 144, 32 * ks, 16 * vt, fr, fq), acc, 0, 0, 0);
#pragma unroll
                    for (int j = 0; j < 4; ++j) acc[j] *= egs[16 * tt + 4 * fq + j] * rqs[16 * tt + 4 * fq + j];
#pragma unroll
                    for (int ks = 0; ks < 2; ++ks) acc = __builtin_amdgcn_mfma_f32_16x16x32_bf16(frag_row(AT, 72, 16 * tt, 32 * ks, fr, fq), frag_tr(VN, 144, 32 * ks, 16 * vt, fr, fq), acc, 0, 0, 0);
                    oacc[x] = acc; asm volatile("" ::: "memory"); }
                const float egl = __expf(gcl);
                const bf16x8 ka0 = frag_tr(KK, 144, 0, 16 * w, fr, fq), ka1 = frag_tr(KK, 144, 32, 16 * w, fr, fq);
#pragma unroll
                for (int vt = 0; vt < 8; ++vt) { f32x4 a2 = (f32x4){0.f, 0.f, 0.f, 0.f};
                    a2 = __builtin_amdgcn_mfma_f32_16x16x32_bf16(ka0, frag_tr(UU, 144, 0, 16 * vt, fr, fq), a2, 0, 0, 0);
                    a2 = __builtin_amdgcn_mfma_f32_16x16x32_bf16(ka1, frag_tr(UU, 144, 32, 16 * vt, fr, fq), a2, 0, 0, 0);
                    S[vt] = S[vt] * egl + a2; asm volatile("" ::: "memory"); }
            }
            {
                const int lt_ = fresh_tid(); const int fr = lt_ & 15, fq = (lt_ & 63) >> 4;
                const int tt = w >> 1;
#pragma unroll
                for (int x = 0; x < 4; ++x) { const int vt = (w & 1) * 4 + x; store_ctile_bf16(OT, 136, 16 * tt, 16 * vt, oacc[x], fr, fq); }
            }
            zp0 = zz0; zp1 = zz1; trp = trow0;
            __syncthreads();
        }
        __syncthreads();
        {
                const int lt2_ = fresh_tid(); const int r = lt2_ >> 3, seg = lt2_ & 7; const bf16_t* op = OT + r * 136 + seg * 16;
                f32x4 v[4]; float ss = 0.f;
                { const u32x4 q0 = *(const u32x4*)op, q1 = *(const u32x4*)(op + 8);
                  v[0] = (f32x4){__uint_as_float(q0.x << 16), __uint_as_float(q0.x & 0xffff0000u), __uint_as_float(q0.y << 16), __uint_as_float(q0.y & 0xffff0000u)};
                  v[1] = (f32x4){__uint_as_float(q0.z << 16), __uint_as_float(q0.z & 0xffff0000u), __uint_as_float(q0.w << 16), __uint_as_float(q0.w & 0xffff0000u)};
                  v[2] = (f32x4){__uint_as_float(q1.x << 16), __uint_as_float(q1.x & 0xffff0000u), __uint_as_float(q1.y << 16), __uint_as_float(q1.y & 0xffff0000u)};
                  v[3] = (f32x4){__uint_as_float(q1.z << 16), __uint_as_float(q1.z & 0xffff0000u), __uint_as_float(q1.w << 16), __uint_as_float(q1.w & 0xffff0000u)}; }
#pragma unroll
                for (int i = 0; i < 4; ++i) ss += v[i][0] * v[i][0] + v[i][1] * v[i][1] + v[i][2] * v[i][2] + v[i][3] * v[i][3];
                ss += __shfl_xor(ss, 1); ss += __shfl_xor(ss, 2); ss += __shfl_xor(ss, 4);
                const float rn = rsqrtf(ss * (1.f / 128.f) + EPS);
                bf16_t* zp = Zs + (size_t)(trp + r) * 4096 + vh * 128 + seg * 16;
#pragma unroll
                for (int i = 0; i < 2; ++i) { const u32x4 zz = i ? zp1 : zp0; const f32x4 h0 = *(const f32x4*)(HN + seg * 16 + 8 * i), h1 = *(const f32x4*)(HN + seg * 16 + 8 * i + 4);
                    f32x4 o0 = v[2 * i] * rn * h0, o1 = v[2 * i + 1] * rn * h1;
                    o0[0] *= __uint_as_float(zz.x << 16); o0[1] *= __uint_as_float(zz.x & 0xffff0000u); o0[2] *= __uint_as_float(zz.y << 16); o0[3] *= __uint_as_float(zz.y & 0xffff0000u);
                    o1[0] *= __uint_as_float(zz.z << 16); o1[1] *= __uint_as_float(zz.z & 0xffff0000u); o1[2] *= __uint_as_float(zz.w << 16); o1[3] *= __uint_as_float(zz.w & 0xffff0000u);
                    if (!dry) *(u32x4*)(zp + 8 * i) = pack8(o0, o1); }
            }
        __syncthreads();
#undef GD_LOADRAW
    }
}

__device__ __forceinline__ float quad16_max(float x) {
    const auto r = __builtin_amdgcn_permlane32_swap(__float_as_uint(x), __float_as_uint(x), false, false);
    const float m = fmaxf(__uint_as_float(r[0]), __uint_as_float(r[1]));
    const auto q = __builtin_amdgcn_permlane16_swap(__float_as_uint(m), __float_as_uint(m), false, false);
    return fmaxf(__uint_as_float(q[0]), __uint_as_float(q[1]));
}
__device__ __forceinline__ float quad16_sum(float x) {
    const auto r = __builtin_amdgcn_permlane32_swap(__float_as_uint(x), __float_as_uint(x), false, false);
    const float m = __uint_as_float(r[0]) + __uint_as_float(r[1]);
    const auto q = __builtin_amdgcn_permlane16_swap(__float_as_uint(m), __float_as_uint(m), false, false);
    return __uint_as_float(q[0]) + __uint_as_float(q[1]);
}
constexpr int KS_STRIDE = 200, VS_STRIDE = 144;
__device__ __forceinline__ void attn_tile(bf16_t* Ks, bf16_t* Vs, unsigned char* ws, int b, int h, int qt, bool dry) {
    const int tid = fresh_tid(), lane = tid & 63, wv = __builtin_amdgcn_readfirstlane(tid >> 6), fr = lane & 15, fq = lane >> 4;
    const bf16_t* Q = (const bf16_t*)(ws + WS_BIG); const bf16_t* KV = (const bf16_t*)(ws + WS_BIG + 96 * MiB); const bf16_t* KR = (const bf16_t*)(ws + WS_Z + 96 * MiB);
    bf16_t* Zs = (bf16_t*)(ws + WS_Z);
    const int rowA = b * SEQ + qt * 256 + wv * 16 + fr, rowB = rowA + 128;
    bf16x8 qfA[6], qfB[6];
#pragma unroll
    for (int s = 0; s < 6; ++s) { qfA[s] = *(const bf16x8*)(Q + (size_t)rowA * 3072 + h * 192 + 32 * s + 8 * fq); qfB[s] = *(const bf16x8*)(Q + (size_t)rowB * 3072 + h * 192 + 32 * s + 8 * fq); }
    f32x4 accA[8], accB[8];
#pragma unroll
    for (int i = 0; i < 8; ++i) { accA[i] = (f32x4){0.f, 0.f, 0.f, 0.f}; accB[i] = (f32x4){0.f, 0.f, 0.f, 0.f}; }
    float mA = -INFINITY, lA = 0.f, mB = -INFINITY, lB = 0.f;
    const int ntiles = 4 * qt + 4, cA = 4 * qt + (wv >> 2), cB = cA + 2;
    u32x4 pk0, pk1, pv0, pv1, pr0;
    const int lr0 = tid >> 4, lc0 = tid & 15, lr1 = (tid + 512) >> 4, lrr = tid >> 3, lcr = tid & 7;
    {
        const size_t krow0 = (size_t)(b * SEQ);
        pk0 = *(const u32x4*)(KV + (krow0 + lr0) * 4096 + h * 256 + lc0 * 8); pv0 = *(const u32x4*)(KV + (krow0 + lr0) * 4096 + h * 256 + 128 + lc0 * 8);
        pk1 = *(const u32x4*)(KV + (krow0 + lr1) * 4096 + h * 256 + lc0 * 8); pv1 = *(const u32x4*)(KV + (krow0 + lr1) * 4096 + h * 256 + 128 + lc0 * 8);
        pr0 = *(const u32x4*)(KR + (krow0 + lrr) * 64 + lcr * 8);
    }
    for (int kt = 0; kt < ntiles; ++kt) {
        __syncthreads();
        *(u32x4*)(Ks + lr0 * KS_STRIDE + lc0 * 8) = pk0; *(u32x4*)(Vs + lr0 * VS_STRIDE + lc0 * 8) = pv0;
        *(u32x4*)(Ks + lr1 * KS_STRIDE + lc0 * 8) = pk1; *(u32x4*)(Vs + lr1 * VS_STRIDE + lc0 * 8) = pv1;
        *(u32x4*)(Ks + lrr * KS_STRIDE + 128 + lcr * 8) = pr0;
        if (kt + 1 < ntiles) {
            const size_t krow0 = (size_t)(b * SEQ + (kt + 1) * 64);
            pk0 = *(const u32x4*)(KV + (krow0 + lr0) * 4096 + h * 256 + lc0 * 8); pv0 = *(const u32x4*)(KV + (krow0 + lr0) * 4096 + h * 256 + 128 + lc0 * 8);
            pk1 = *(const u32x4*)(KV + (krow0 + lr1) * 4096 + h * 256 + lc0 * 8); pv1 = *(const u32x4*)(KV + (krow0 + lr1) * 4096 + h * 256 + 128 + lc0 * 8);
            pr0 = *(const u32x4*)(KR + (krow0 + lrr) * 64 + lcr * 8);
        }
        __syncthreads();
        if (kt <= cB) {
            const bool doA = (kt <= cA);
            f32x4 sA[4], sB[4];
#pragma unroll
            for (int nt = 0; nt < 4; ++nt) { sA[nt] = (f32x4){0.f, 0.f, 0.f, 0.f}; sB[nt] = (f32x4){0.f, 0.f, 0.f, 0.f};
#pragma unroll
                for (int st = 0; st < 6; ++st) { const bf16x8 kf = *(const bf16x8*)(Ks + (16 * nt + fr) * KS_STRIDE + 32 * st + 8 * fq);
                    sB[nt] = __builtin_amdgcn_mfma_f32_16x16x32_bf16(kf, qfB[st], sB[nt], 0, 0, 0);
                    if (doA) sA[nt] = __builtin_amdgcn_mfma_f32_16x16x32_bf16(kf, qfA[st], sA[nt], 0, 0, 0); } }
            bf16x8 pfA[2], pfB[2];
#define ATT_SOFTMAX(s, mrun, lsum, acc, pf) do { float mx = s[0][0]; \
            _Pragma("unroll") for (int nt = 0; nt < 4; ++nt) _Pragma("unroll") for (int j = 0; j < 4; ++j) mx = fmaxf(mx, s[nt][j]); \
            mx = quad16_max(mx); \
            if (__builtin_amdgcn_ballot_w64(mx > mrun + 8.f) != 0ull) {     \
                const float mnew = fmaxf(mrun, mx), alpha = __builtin_amdgcn_exp2f(mrun - mnew); mrun = mnew; lsum *= alpha; \
                _Pragma("unroll") for (int i = 0; i < 8; ++i) acc[i] *= alpha; } \
            float ps = 0.f; \
            _Pragma("unroll") for (int nt = 0; nt < 4; ++nt) _Pragma("unroll") for (int j = 0; j < 4; ++j) { s[nt][j] = __builtin_amdgcn_exp2f(s[nt][j] - mrun); ps += s[nt][j]; } \
            lsum += ps; \
            _Pragma("unroll") for (int s2 = 0; s2 < 2; ++s2) { const u32x4 w_ = pack8(s[2 * s2], s[2 * s2 + 1]); pf[s2] = __builtin_bit_cast(bf16x8, w_); } } while (0)
            ATT_SOFTMAX(sB, mB, lB, accB, pfB);
            if (doA) ATT_SOFTMAX(sA, mA, lA, accA, pfA);
#undef ATT_SOFTMAX
            const int tq = fr >> 2, tp = fr & 3;
#pragma unroll
            for (int vt = 0; vt < 8; ++vt)
#pragma unroll
                for (int s2 = 0; s2 < 2; ++s2) { const bf16_t* vp = Vs + (32 * s2 + 4 * fq + tq) * VS_STRIDE + 16 * vt + 4 * tp;
                    const s16x4 r0 = tr_read(vp), r1 = tr_read(vp + 16 * VS_STRIDE);
                    const bf16x8 vf = (bf16x8){r0[0], r0[1], r0[2], r0[3], r1[0], r1[1], r1[2], r1[3]};
                    accB[vt] = __builtin_amdgcn_mfma_f32_16x16x32_bf16(vf, pfB[s2], accB[vt], 0, 0, 0);
                    if (doA) accA[vt] = __builtin_amdgcn_mfma_f32_16x16x32_bf16(vf, pfA[s2], accA[vt], 0, 0, 0); }
        }
    }
#define ATT_FINAL(acc, lsum, row) do { const float l_ = quad16_sum(lsum); const float inv = __builtin_amdgcn_rcpf(l_); \
    _Pragma("unroll") for (int vt = 0; vt < 8; ++vt) { bf16_t* zp = Zs + (size_t)(row) * 2048 + h * 128 + 16 * vt + 4 * fq; const u32x2 zz = *(const u32x2*)zp; \
        const float z0 = __uint_as_float(zz.x << 16), z1 = __uint_as_float(zz.x & 0xffff0000u), z2 = __uint_as_float(zz.y << 16), z3 = __uint_as_float(zz.y & 0xffff0000u); \
        u32x2 w_; w_.x = pg8::cvt_pk_bf16(acc[vt][0] * inv * z0, acc[vt][1] * inv * z1); w_.y = pg8::cvt_pk_bf16(acc[vt][2] * inv * z2, acc[vt][3] * inv * z3); if (!dry) *(u32x2*)zp = w_; } } while (0)
    ATT_FINAL(accA, lA, rowA);
    ATT_FINAL(accB, lB, rowB);
#undef ATT_FINAL
}
__device__ __forceinline__ void attn_phase(unsigned char* lds, unsigned char* ws, bool dry) {
    bf16_t* Ks = (bf16_t*)lds; bf16_t* Vs = (bf16_t*)(lds + 64 * KS_STRIDE * 2);
    for (int p = blockIdx.x; p < 512; p += gridDim.x) { const int bh = p >> 2, pr = p & 3;
        attn_tile(Ks, Vs, ws, bh >> 4, bh & 15, 7 - pr, dry);
        attn_tile(Ks, Vs, ws, bh >> 4, bh & 15, pr, dry); }
}

__device__ __forceinline__ void prep_tables(const Params& P) {
    unsigned char* ws = P.ws; const int gt = blockIdx.x * 512 + fresh_tid(), ng = gridDim.x * 512;
    const int* pos = (const int*)P.in[1]; float* COS = (float*)(ws + WS_COS); float* SIN = (float*)(ws + WS_SIN);
    for (int i = gt; i < MTOK * 32; i += ng) { const int row = i >> 5, j = i & 31;
        const float invf = __builtin_amdgcn_exp2f(-(float)j * (13.287712379549449f / 32.f));
        const float ang = (float)pos[row] * invf;
        double t = (double)ang * 0.15915494309189535; t -= floor(t); const float tf = (float)t;
        COS[i] = __builtin_amdgcn_cosf(tf); SIN[i] = __builtin_amdgcn_sinf(tf); }
    const float* lbp = (const float*)P.in[2]; float* LB = (float*)(ws + WS_LB);
    for (int c = gt; c < 2048; c += ng) { const float a0 = lbp[c], a1 = lbp[2048 + c], a2 = lbp[4096 + c], a3 = lbp[6144 + c];
        const float mx = fmaxf(fmaxf(a0, a1), fmaxf(a2, a3)); const float e0 = expf(a0 - mx), e1 = expf(a1 - mx), e2 = expf(a2 - mx), e3 = expf(a3 - mx); const float sm = e0 + e1 + e2 + e3;
        LB[c] = 0.f; LB[2048 + c] = (e1 + e2 + e3) / sm; }
}

#define XB_TMO      128
#define XB_XCNT(j)  (256  + 64 * (j))
#define XB_XSUB(j)  (1280 + 64 * (j))
#define XB_XGEN(j)  (2304 + 64 * (j))
#define XB_TOP      3328
#define XB_TOPGEN   3392
#define XCD_BAR_WORDS 3456
#define XB_SPIN_CAP (1u << 18)
__device__ __forceinline__ unsigned xb_ld(unsigned* p)              { return __hip_atomic_load(p, __ATOMIC_RELAXED, __HIP_MEMORY_SCOPE_AGENT); }
__device__ __forceinline__ unsigned xb_add(unsigned* p, unsigned v) { return __hip_atomic_fetch_add(p, v, __ATOMIC_RELAXED, __HIP_MEMORY_SCOPE_AGENT); }
__device__ __forceinline__ unsigned xb_xcc_id() { return (unsigned)__builtin_amdgcn_s_getreg((3 << 11) | 20) & 0xFu; }
#define XB_SPIN(cond, bar) do { unsigned _sp = 0; while (cond) { __builtin_amdgcn_s_sleep(1); \
    if ((++_sp & 255u) == 0u) { if (xb_ld(&(bar)[XB_TMO])) break; if (_sp > XB_SPIN_CAP) { atomicAdd(&(bar)[XB_TMO], 1u); break; } } } } while (0)

struct XcdBarrier {
    unsigned* bar; unsigned x;
    volatile LAS unsigned* st;
};

__device__ __forceinline__ XcdBarrier xcd_barrier_post(unsigned* bar, volatile LAS unsigned* st) {
    XcdBarrier b; b.bar = bar; b.x = xb_xcc_id(); b.st = st;
    if (threadIdx.x == 0) (void)xb_add(&bar[XB_XCNT(b.x)], 1u);
    return b;
}
__device__ __forceinline__ void xcd_barrier_complete(unsigned* bar, unsigned x, unsigned& nloc, unsigned& nx) {
    const unsigned G = gridDim.x * gridDim.y * gridDim.z;
    unsigned sum, cnt, mine, sp = 0u;
    for (;;) {
        sum = 0u; cnt = 0u; mine = 0u;
#pragma unroll
        for (unsigned j = 0; j < 16; ++j) { const unsigned c = xb_ld(&bar[XB_XCNT(j)]); sum += c; cnt += (c > 0u) ? 1u : 0u; mine = (j == x) ? c : mine; }
        if (sum == G) break;
        __builtin_amdgcn_s_sleep(1);
        if ((++sp & 255u) == 0u) { if (xb_ld(&bar[XB_TMO])) break; if (sp > XB_SPIN_CAP) { atomicAdd(&bar[XB_TMO], 1u); break; } }
    }
    nloc = mine > 0u ? mine : 1u; nx = cnt > 0u ? cnt : 1u;
}

__device__ __forceinline__ void xcd_barrier(const XcdBarrier& b) {
    asm volatile("s_waitcnt vmcnt(0)" ::: "memory");
    __syncthreads();
    if (threadIdx.x == 0) {
        unsigned* bar = b.bar;
        __builtin_amdgcn_s_waitcnt(0);
        unsigned nloc = b.st[0], nx = b.st[1];
        if (nloc == 0u) { xcd_barrier_complete(bar, b.x, nloc, nx); b.st[0] = nloc; b.st[1] = nx; }
        const unsigned old = xb_add(&bar[XB_XSUB(b.x)], 1u);
        const unsigned gen = old / nloc;
        if (old + 1u == (gen + 1u) * nloc) {
            __builtin_amdgcn_fence(__ATOMIC_RELEASE, "agent");
            asm volatile("s_waitcnt vmcnt(0)" ::: "memory");
            const unsigned og = xb_add(&bar[XB_TOP], 1u);
            const unsigned tg = og / nx;
            if (og + 1u == (tg + 1u) * nx) xb_add(&bar[XB_TOPGEN], 1u);
            else XB_SPIN(xb_ld(&bar[XB_TOPGEN]) == tg, bar);
            __builtin_amdgcn_fence(__ATOMIC_ACQUIRE, "agent");
            xb_add(&bar[XB_XGEN(b.x)], 1u);
            asm volatile("s_waitcnt vmcnt(0)" ::: "memory");
        } else {
            XB_SPIN(xb_ld(&bar[XB_XGEN(b.x)]) == gen, bar);
            __builtin_amdgcn_fence(__ATOMIC_ACQUIRE, "agent");
            asm volatile("s_waitcnt vmcnt(0)" ::: "memory");
        }
    }
    __syncthreads();
}


struct CvM { const float* W; int K, Ns, Nd, mode; bf16_t* dst; const float* rs; float cs; };
__device__ __forceinline__ bool cv_get(const Params& P, int cv, int sub, CvM& m) {
#define FIN(i) ((const float*)P.in[i])
    bf16_t* RW = (bf16_t*)(P.ws + WS_RW); bf16_t* U = (bf16_t*)(P.ws + WS_U);
    m.rs = nullptr; m.cs = 1.f; m.mode = MAP_ID;
    if (sub > 0 && cv != 2) return false;
    switch (cv) {
        case 0: m.W = FIN(5);  m.K = 2048; m.Ns = 8192;  m.Nd = 8192;  m.dst = RW; return true;
        case 1: m.W = FIN(7);  m.K = 2048; m.Ns = 2048;  m.Nd = 2048;  m.dst = U;  return true;
        case 2:
            if (sub == 0) { m.W = FIN(10); m.K = 2048; m.Ns = 3136; m.Nd = 3328; m.mode = MAP_MLAIN; m.dst = RW; return true; }
            if (sub == 1) { m.W = FIN(13); m.K = 512; m.Ns = 3072; m.Nd = 3072; m.mode = MAP_UQ; m.dst = RW + (size_t)3328 * 2048; m.rs = FIN(11); m.cs = 0.10411754627697266f;     return true; }
            if (sub == 2) { m.W = FIN(14); m.K = 512; m.Ns = 4096; m.Nd = 4096; m.dst = RW + (size_t)3328 * 2048 + (size_t)3072 * 512; m.rs = FIN(12); return true; }
            return false;
        case 3: m.W = FIN(15); m.K = 2048; m.Ns = 2048;  m.Nd = 2048;  m.dst = U;  return true;
        case 4: m.W = FIN(18); m.K = 2048; m.Ns = 12352; m.Nd = 12544; m.dst = RW; return true;
        case 5: m.W = FIN(23); m.K = 4096; m.Ns = 2048;  m.Nd = 2048;  m.dst = U;  return true;
        case 6: m.W = FIN(26); m.K = 2048; m.Ns = 8192;  m.Nd = 8192;  m.dst = RW; return true;
        case 7: m.W = FIN(28); m.K = 2048; m.Ns = 2048;  m.Nd = 2048;  m.dst = U;  return true;
        default: return false;
    }
}

__global__ void __launch_bounds__(512) trunk_fwd(Params P) {
    extern __shared__ __attribute__((aligned(16))) unsigned char lds[];
    cg::grid_group grid = cg::this_grid();
    unsigned char* ws = P.ws; LAS unsigned char* L3 = (LAS unsigned char*)lds; float* Lf = (float*)lds;
    const int bi = blockIdx.x, nb = gridDim.x;
    bf16_t* RW = (bf16_t*)(ws + WS_RW); bf16_t* U = (bf16_t*)(ws + WS_U);
    const bf16_t* Z0 = (const bf16_t*)(ws + WS_Z); const bf16_t* Z64 = (const bf16_t*)(ws + WS_Z + 64 * MiB); const bf16_t* Z80 = (const bf16_t*)(ws + WS_Z + 80 * MiB);
    const bf16_t* YB = (const bf16_t*)(ws + WS_BIG); const float* LB = (const float*)(ws + WS_LB);
#ifdef PROBE_TA
    unsigned long long* stamps = (unsigned long long*)(lds + LDS_BYTES - 256);
    if (threadIdx.x == 0) stamps[0] = __builtin_amdgcn_s_memrealtime();
#endif
    { if (threadIdx.x < 4) ((LAS unsigned*)(lds + 163072))[threadIdx.x] = 0u; __syncthreads(); }
    XcdBarrier xbar = xcd_barrier_post((unsigned*)(ws + WS_BAR), (volatile LAS unsigned*)(lds + 163072));
    for (int st = P.ph_lo; st < P.ph_hi; ++st) {
        int cv = -1, cvb = -1, rowk = 0, gm = -1, gN = 0, gK = 0, mix = 0; bool sync_after = true, tables = false;
        const bf16_t* r_y = nullptr; const float *r_h = nullptr, *r_post = nullptr, *r_pre = nullptr, *hn = nullptr, *lbp = LB;
        const bf16_t *gA = nullptr, *gB = nullptr;
        switch (st) {
            case 0:  tables = true; rowk = 1; r_h = FIN(0); r_pre = FIN(3); cv = 0; break;
            case 1:  gm = EM_HG; gA = U; gB = RW; gN = 8192; gK = 2048; lbp = LB; break;
            case 2:  cv = 1; cvb = 2; mix = 1; hn = FIN(6); break;
            case 3:  gm = EM_OUT; gA = Z64; gB = U; gN = 2048; gK = 2048; break;
            case 4:  rowk = 1; r_h = FIN(0); r_y = YB; r_post = FIN(4); r_pre = FIN(8); break;
            case 5:  gm = EM_MLAIN; gA = U; gB = RW; gN = 3328; gK = 2048; break;
            case 6:  gm = EM_Q; gA = Z64; gB = RW + (size_t)3328 * 2048; gN = 3072; gK = 512; sync_after = false; break;
            case 7:  gm = EM_KV; gA = Z80; gB = RW + (size_t)3328 * 2048 + (size_t)3072 * 512; gN = 4096; gK = 512; break;
            case 8:  cv = 3; mix = 2; break;
            case 9:  gm = EM_OUT; gA = Z0; gB = U; gN = 2048; gK = 2048; break;
            case 10: rowk = 1; r_h = P.out; r_y = YB; r_post = FIN(9); r_pre = FIN(16); cv = 4; break;
            case 11: gm = EM_GDN; gA = U; gB = RW; gN = 12544; gK = 2048; break;
            case 12: cv = 5; mix = 3; hn = FIN(22); break;
            case 13: gm = EM_OUT; gA = Z0; gB = U; gN = 2048; gK = 4096; break;
            case 14: rowk = 1; r_h = P.out; r_y = YB; r_post = FIN(17); r_pre = FIN(24); cv = 6; break;
            case 15: gm = EM_HG; gA = U; gB = RW; gN = 8192; gK = 2048; lbp = LB + 2048; break;
            case 16: cv = 7; mix = 1; hn = FIN(27); break;
            case 17: gm = EM_OUT; gA = Z64; gB = U; gN = 2048; gK = 2048; break;
            default: rowk = 1; r_h = P.out; r_y = YB; r_post = FIN(25); r_pre = nullptr; break;
        }
        if (tables) prep_tables(P);
        if (rowk) row_phase(r_h, r_y, r_post, r_pre, P.out, U);
        {
            const int cbi = (mix == 1) ? bi - 128 : bi, cnb = (mix == 1) ? nb - 128 : nb;
            if (cbi >= 0 && cnb > 0) {
                for (int pass = 0; pass < 2; ++pass) { const int cvx = pass ? cvb : cv; if (cvx < 0) continue;
                    for (int sub = 0; sub < 3; ++sub) { CvM m; if (!cv_get(P, cvx, sub, m)) break; convert_w(Lf, m.W, m.K, m.Ns, m.dst, m.Nd, m.mode, m.rs, m.cs, cbi, cnb);
#ifdef CONV_REPS
                        for (int r_ = 0; r_ < CONV_REPS; ++r_) convert_w(Lf, m.W, m.K, m.Ns, m.dst, m.Nd, m.mode, m.rs, m.cs, cbi, cnb);
#endif
                    } }
            }
        }
#ifndef GEMM_REPS
#define GEMM_REPS 1
#endif
#ifndef DRY_MIX
#define DRY_MIX 0
#endif
        if (gm >= 0) { Epi E; E.mode = gm; E.ws = ws; E.lb = lbp; E.alog = FIN(20); E.dtb = FIN(21);
            for (int rep = 0; rep < GEMM_REPS; ++rep) {
#ifdef GEMM_DRY_FIRST
                E.mode = (rep == 0) ? -1 : gm;
#endif
                run_gemm(L3, gA, gB, gN, gK, E); if (rep + 1 < GEMM_REPS) grid.sync(); } }
        if (mix) {
            for (int rep = (DRY_MIX == mix ? 0 : 1); rep < 2; ++rep) { const bool dry = (rep == 0);
                if (mix == 1) gla_chunked(lds, ws, hn, dry);
                if (mix == 2) attn_phase(lds, ws, dry);
                if (mix == 3) gdn_chunked(lds, ws, FIN(19), hn, dry);
                if (dry) grid.sync(); }
        }
        if (sync_after && st + 1 < P.ph_hi) { if (st == 0) grid.sync(); else xcd_barrier(xbar); }
#ifdef EXTRA_SYNCS
        for (int e_ = 0; e_ < EXTRA_SYNCS; ++e_) xcd_barrier(xbar);
#endif
#ifdef PROBE_TA
        if (threadIdx.x == 0) stamps[st + 1] = __builtin_amdgcn_s_memrealtime();
#endif
    }
#ifdef PROBE_TA
    grid.sync();
    { const size_t n = (size_t)MTOK * DM; for (size_t i = (size_t)blockIdx.x * 512 + threadIdx.x; i < n; i += (size_t)gridDim.x * 512) P.out[i] = 0.f; }
    grid.sync();
    if (blockIdx.x == 0) { const float ta = (float)(stamps[PROBE_TA + 1] - stamps[0]) * 0.01f, tb = (float)(stamps[PROBE_TB + 1] - stamps[0]) * 0.01f;
        if (threadIdx.x == 0) P.out[0] = ta;
        for (int i = threadIdx.x; i < 1000000; i += 512) P.out[1024 + i] = tb; }
#endif
#undef FIN
}

extern "C" void kernel_launch(void* const* d_in, const int* in_sizes, int n_in, void* d_out, int out_size, void* d_ws, size_t ws_size, hipStream_t stream) {
    static int grid_blocks = 0;
    if (grid_blocks == 0) {
        if (n_in != 29 || ws_size < WS_END) { fprintf(stderr, "kernel_launch: need 29 inputs and %zu bytes of workspace; got %d, %zu\n", (size_t)WS_END, n_in, ws_size); grid_blocks = -1; return; }
        int dev = 0, cus = 0, per_cu = 0;
        hipGetDevice(&dev); hipDeviceGetAttribute(&cus, hipDeviceAttributeMultiprocessorCount, dev);
        if (hipFuncSetAttribute((const void*)trunk_fwd, hipFuncAttributeMaxDynamicSharedMemorySize, LDS_BYTES) != hipSuccess) { fprintf(stderr, "hipFuncSetAttribute failed\n"); grid_blocks = -1; return; }
        if (hipOccupancyMaxActiveBlocksPerMultiprocessor(&per_cu, (const void*)trunk_fwd, 512, LDS_BYTES) != hipSuccess || per_cu < 1) { fprintf(stderr, "occupancy query failed (%d)\n", per_cu); per_cu = 1; }
        (void)hipGetLastError();
        grid_blocks = cus * 1;
    }
    if (grid_blocks < 0) return;
    Params p{};
    for (int i = 0; i < 29; ++i) p.in[i] = d_in[i];
    p.out = (float*)d_out; p.ws = (unsigned char*)d_ws;
#if PER_PHASE_LAUNCH
    for (int ph = 0; ph < NPHASE; ++ph) {
        p.ph_lo = ph; p.ph_hi = ph + 1; void* args[] = {&p};
        hipError_t e = hipLaunchCooperativeKernel((const void*)trunk_fwd, dim3(grid_blocks), dim3(512), args, LDS_BYTES, stream);
        if (e != hipSuccess) { fprintf(stderr, "launch failed: %s\n", hipGetErrorString(e)); break; }
    }
#else
    (void)hipMemsetAsync((unsigned char*)d_ws + WS_BAR, 0, XCD_BAR_WORDS * 4, stream);
    p.ph_lo = 0; p.ph_hi = NPHASE; void* args[] = {&p};
    hipError_t e = hipLaunchCooperativeKernel((const void*)trunk_fwd, dim3(grid_blocks), dim3(512), args, LDS_BYTES, stream);
    if (e != hipSuccess) fprintf(stderr, "cooperative launch failed: %s (grid %d)\n", hipGetErrorString(e), grid_blocks);
#endif
}
```

```cpp
#include <hip/hip_runtime.h>
#include <hip/hip_cooperative_groups.h>
#include <cstdio>
namespace cg = cooperative_groups;
namespace pg8 {
#define PG8_LAS __attribute__((address_space(3)))
typedef unsigned short bf16_t;
typedef short bf16x8 __attribute__((ext_vector_type(8)));
typedef float f32x4 __attribute__((ext_vector_type(4)));
typedef unsigned u32x4 __attribute__((ext_vector_type(4)));
constexpr int BM = 256, BK = 64, HALF = 128, HTB = HALF * BK * 2  , STAGE_BYTES = 8 * HTB, NXCD = 8, WGM = 8;

__host__ __device__ __forceinline__ int lds_byte(int r, int c) { const int st = (r >> 4) * 2 + (c >> 5), rr = r & 15, cc = c & 31, ob = rr * 64 + cc * 2; return st * 1024 + (ob ^ (((ob >> 9) & 1) << 5)); }
__host__ __device__ __forceinline__ void stage_rc(int b, int& R, int& C) { const int st = b / 1024, sb = b % 1024, swz = sb ^ (((sb >> 9) & 1) << 5); R = (st >> 1) * 16 + swz / 64; C = (st & 1) * 32 + (swz % 64) / 2; }
__host__ __device__ __forceinline__ int perm32(int rho) { const int n = rho >> 4, i = rho & 15; return 8 * (i >> 2) + 4 * n + (i & 3); }

struct Unit { int pm, pn; };
struct Gemm { const bf16_t* A; const bf16_t* Bt; int M, N, K; };
struct StaticOrder {
    int nM, nN, nwg, G, c;
    __host__ __device__ void init(int M, int N, int G_, int c_) { nM = M / BM; nN = N / BM; nwg = nM * nN; G = G_; c = c_; }
    __host__ __device__ bool next(int i, Unit& u) const {
        const long L = (long)i * G + c; if (L >= nwg) return false;
        int wgid = (int)L; { const int q = nwg / NXCD, r = nwg % NXCD, xcd = wgid % NXCD, off = wgid / NXCD; wgid = (xcd < r ? xcd * (q + 1) : r * (q + 1) + (xcd - r) * q) + off; }
        const int nig = WGM * nN, gid = wgid / nig, fm = gid * WGM, gsz = (nM - fm) < WGM ? (nM - fm) : WGM;
        u.pm = fm + ((wgid % nig) % gsz); u.pn = (wgid % nig) / gsz; return true;
    }
    __device__ __forceinline__ void a_ready(const Unit&) const {}
    __device__ __forceinline__ void done(const Unit&) const {}
};
__device__ __forceinline__ unsigned cvt_pk_bf16(float lo, float hi) { unsigned r; asm("v_cvt_pk_bf16_f32 %0, %1, %2" : "=v"(r) : "v"(lo), "v"(hi)); return r; }
template <class Epi, class Sched>
__device__ __forceinline__ void gemm_phase(PG8_LAS unsigned char* lds, const Gemm g, const Sched& S, const Epi& E) {
    int tid_l_ = threadIdx.x; asm volatile("" : "+v"(tid_l_)); const int tid = tid_l_, wid = __builtin_amdgcn_readfirstlane(tid >> 6), lane = tid & 63, wr = wid >> 2, wc = wid & 3, fr = lane & 15, fq = lane >> 4;
    const int K = g.K, nt = K / BK;
    unsigned voffA[2], voffB[2];
#pragma unroll
    for (int i = 0; i < 2; ++i) { int R, C; stage_rc(tid * 16 + i * 8192, R, C); const int Rb = Epi::PERM ? ((R & ~31) + perm32(R & 31)) : R;
        voffA[i] = (unsigned)(R * K + C) * 2u; voffB[i] = (unsigned)(Rb * K + C) * 2u; }
    const size_t kstep = (size_t)(BK * 2);
    const size_t hstep = (size_t)HALF * K * 2;
    const size_t tstep = 2 * hstep;
    const unsigned ldsw = (unsigned)wid * 1024u;
    const int aoff = lds_byte(wr * 64 + fr, fq * 8), boff = lds_byte(wc * 32 + fr, fq * 8);
#define PG8_SA(b, h) (((b) * 2 + (h)) * HTB)
#define PG8_SB(b, h) ((4 + (b) * 2 + (h)) * HTB)
#define PG8_STAGE(bufoff, gbase, voff) do { _Pragma("unroll") for (int _i = 0; _i < 2; ++_i) \
        __builtin_amdgcn_global_load_lds((const unsigned*)((const char*)(gbase) + (voff)[_i]), (PG8_LAS unsigned*)(lds + (bufoff) + ldsw + _i * 8192), 16, 0, 0); } while (0)
#define PG8_LDA(dst, b, h) do { _Pragma("unroll") for (int m = 0; m < 4; ++m) _Pragma("unroll") for (int k = 0; k < 2; ++k) dst[m][k] = *(const PG8_LAS bf16x8*)(lds + PG8_SA(b, h) + aoff + m * 2048 + k * 1024); } while (0)
#define PG8_LDB(dst, b, h) do { _Pragma("unroll") for (int n = 0; n < 2; ++n) _Pragma("unroll") for (int k = 0; k < 2; ++k) dst[n][k] = *(const PG8_LAS bf16x8*)(lds + PG8_SB(b, h) + boff + n * 2048 + k * 1024); } while (0)
#define PG8_MMA(ai, bj, At, Bt) do { __builtin_amdgcn_s_setprio(1); _Pragma("unroll") for (int m = 0; m < 4; ++m) _Pragma("unroll") for (int n = 0; n < 2; ++n) _Pragma("unroll") for (int k = 0; k < 2; ++k) \
        acc[ai][bj][m][n] = __builtin_amdgcn_mfma_f32_16x16x32_bf16(Bt[n][k], At[m][k], acc[ai][bj][m][n], 0, 0, 0); __builtin_amdgcn_s_setprio(0); } while (0)
#define PG8_WAIT_V(n) asm volatile("s_waitcnt vmcnt(" #n ")" ::: "memory")
#define PG8_WAIT_L(n) asm volatile("s_waitcnt lgkmcnt(" #n ")" ::: "memory")
#define PG8_BAR __builtin_amdgcn_s_barrier()
#define PG8_SCHED __builtin_amdgcn_sched_barrier(0)
    Unit cur, nxt; int ui = 0;
    if (!S.next(0, cur)) return;
    f32x4 acc[2][2][4][2];
#pragma unroll
    for (int a = 0; a < 2; ++a)
#pragma unroll
        for (int b = 0; b < 2; ++b)
#pragma unroll
            for (int m = 0; m < 4; ++m)
#pragma unroll
                for (int n = 0; n < 2; ++n) acc[a][b][m][n] = (f32x4){0.f, 0.f, 0.f, 0.f};
    bf16x8 At[4][2], B0[2][2], B1[2][2];
    const char* cA = (const char*)g.A + (size_t)cur.pm * tstep; const char* cB = (const char*)g.Bt + (size_t)cur.pn * tstep;
    S.a_ready(cur);
    PG8_STAGE(PG8_SB(0, 0), cB, voffB); PG8_STAGE(PG8_SA(0, 0), cA, voffA); PG8_STAGE(PG8_SB(0, 1), cB + hstep, voffB); PG8_STAGE(PG8_SA(0, 1), cA + hstep, voffA);
    if (wr == 1) PG8_BAR;
    PG8_WAIT_V(4); PG8_BAR;
    PG8_STAGE(PG8_SB(1, 0), cB + kstep, voffB); PG8_STAGE(PG8_SA(1, 0), cA + kstep, voffA); PG8_STAGE(PG8_SB(1, 1), cB + hstep + kstep, voffB);
    PG8_WAIT_V(6); PG8_BAR;
    for (;;) {
        const bool has_next = S.next(ui + 1, nxt);
        const char* nA = has_next ? (const char*)g.A + (size_t)nxt.pm * tstep : cA; const char* nB = has_next ? (const char*)g.Bt + (size_t)nxt.pn * tstep : cB;
        for (int t = 0; t < nt; t += 2) {
            const bool last = (t == nt - 2);
            const char* a1 = cA + (size_t)(t + 1) * kstep;
            const char* a2 = last ? nA : cA + (size_t)(t + 2) * kstep; const char* b2 = last ? nB : cB + (size_t)(t + 2) * kstep;
            const char* a3 = a2 + kstep; const char* b3 = b2 + kstep;
            if (last && has_next) S.a_ready(nxt);
            PG8_LDB(B0, 0, 0); PG8_SCHED; PG8_LDA(At, 0, 0); PG8_STAGE(PG8_SA(1, 1), a1 + hstep, voffA);
            PG8_WAIT_L(8); PG8_BAR; PG8_WAIT_L(0); PG8_MMA(0, 0, At, B0); PG8_BAR; PG8_SCHED;
            PG8_LDB(B1, 0, 1); PG8_STAGE(PG8_SB(0, 0), b2, voffB);
            PG8_BAR; PG8_WAIT_L(0); PG8_MMA(0, 1, At, B1); PG8_BAR;
            PG8_LDA(At, 0, 1); PG8_STAGE(PG8_SA(0, 0), a2, voffA);
            PG8_BAR; PG8_WAIT_L(0); PG8_MMA(1, 0, At, B0); PG8_BAR; PG8_SCHED;
            PG8_STAGE(PG8_SB(0, 1), b2 + hstep, voffB);
            PG8_WAIT_V(6); PG8_BAR; PG8_MMA(1, 1, At, B1); PG8_BAR;
            PG8_LDB(B0, 1, 0); PG8_SCHED; PG8_LDA(At, 1, 0); PG8_STAGE(PG8_SA(0, 1), a2 + hstep, voffA);
            PG8_WAIT_L(8); PG8_BAR; PG8_WAIT_L(0); PG8_MMA(0, 0, At, B0); PG8_BAR; PG8_SCHED;
            PG8_LDB(B1, 1, 1); PG8_STAGE(PG8_SB(1, 0), b3, voffB);
            PG8_BAR; PG8_WAIT_L(0); PG8_MMA(0, 1, At, B1); PG8_BAR;
            PG8_LDA(At, 1, 1); PG8_STAGE(PG8_SA(1, 0), a3, voffA);
            PG8_BAR; PG8_WAIT_L(0); PG8_MMA(1, 0, At, B0); PG8_BAR; PG8_SCHED;
            PG8_STAGE(PG8_SB(1, 1), b3 + hstep, voffB);
            PG8_WAIT_V(6); PG8_BAR; PG8_MMA(1, 1, At, B1); PG8_BAR;
        }
        if constexpr (!Epi::AFTER_DRAIN) { E(acc, cur, wr, wc, fr, fq); S.done(cur); }
        if (!has_next) break;
#pragma unroll
        for (int a = 0; a < 2; ++a)
#pragma unroll
            for (int b = 0; b < 2; ++b)
#pragma unroll
                for (int m = 0; m < 4; ++m)
#pragma unroll
                    for (int n = 0; n < 2; ++n) acc[a][b][m][n] = (f32x4){0.f, 0.f, 0.f, 0.f};
        cur = nxt; cA = nA; cB = nB; ++ui;
    }
    PG8_WAIT_V(0);
    if (wr == 0) PG8_BAR;
    PG8_BAR;
    if constexpr (Epi::AFTER_DRAIN) { E.fused(acc, cur, wr, wc, fr, fq, lds, wid, lane); S.done(cur); }
#undef PG8_SA
#undef PG8_SB
#undef PG8_STAGE
#undef PG8_LDA
#undef PG8_LDB
#undef PG8_MMA
#undef PG8_WAIT_V
#undef PG8_WAIT_L
#undef PG8_BAR
#undef PG8_SCHED
}
}

#ifndef PER_PHASE_LAUNCH
#define PER_PHASE_LAUNCH 0
#endif

#define LAS __attribute__((address_space(3)))
typedef unsigned short bf16_t;
typedef short bf16x8 __attribute__((ext_vector_type(8)));
typedef short s16x4 __attribute__((ext_vector_type(4)));
typedef float f32x4 __attribute__((ext_vector_type(4)));
typedef unsigned u32x4 __attribute__((ext_vector_type(4)));
typedef unsigned u32x2 __attribute__((ext_vector_type(2)));

constexpr int MTOK = 16384, DM = 2048, SEQ = 2048;
constexpr float EPS = 1e-6f;
constexpr size_t MiB = 1ull << 20;
constexpr size_t WS_RW = 0;
constexpr size_t WS_U = 50 * MiB;
constexpr size_t WS_BIG = 114 * MiB;
constexpr size_t WS_Z = 370 * MiB;
constexpr size_t WS_SM = 498 * MiB;
constexpr size_t WS_COS = WS_SM, WS_SIN = WS_SM + 2 * MiB, WS_GD = WS_SM + 4 * MiB, WS_BD = WS_SM + 6 * MiB;
constexpr size_t WS_SSQ = WS_SM + 8 * MiB;
constexpr size_t WS_LB = WS_SM + 9 * MiB;
constexpr size_t WS_BAR = WS_LB + 16384;
constexpr size_t WS_END = WS_SM + 9 * MiB + 65536;
constexpr int LDS_BYTES = 163088;
constexpr int NPHASE = 19;

struct Params { const void* in[29]; float* out; unsigned char* ws; int ph_lo, ph_hi; };

__device__ __forceinline__ int fresh_tid() { int t = threadIdx.x; asm volatile("" : "+v"(t)); return t; }
__device__ __forceinline__ float bf2f(bf16_t v) { return __uint_as_float(((unsigned)v) << 16); }
__device__ __forceinline__ bf16_t f2bf(float f) { return (bf16_t)(pg8::cvt_pk_bf16(f, f) & 0xffffu); }
__device__ __forceinline__ float siluf(float x) { return x * __builtin_amdgcn_rcpf(1.f + __expf(-x)); }
__device__ __forceinline__ float sigmf(float x) { return __builtin_amdgcn_rcpf(1.f + __expf(-x)); }
__device__ __forceinline__ float wave_sum(float v) {
#pragma unroll
    for (int o = 32; o >= 1; o >>= 1) v += __shfl_xor(v, o);
    return v;
}
__device__ __forceinline__ u32x4 pack8(const f32x4 a, const f32x4 b) {
    u32x4 w; w.x = pg8::cvt_pk_bf16(a[0], a[1]); w.y = pg8::cvt_pk_bf16(a[2], a[3]); w.z = pg8::cvt_pk_bf16(b[0], b[1]); w.w = pg8::cvt_pk_bf16(b[2], b[3]); return w;
}

enum { MAP_ID = 0, MAP_MLAIN = 1, MAP_UQ = 2 };
__device__ __forceinline__ int map_src(int mode, int n, int nsrc) {
    if (mode == MAP_MLAIN) { if (n < 1024) return n; if (n < 3072) return n + 64; if (n < 3136) { const int j = n - 3072; return 1024 + (j >> 1) + 32 * (j & 1); } return -1; }
    if (mode == MAP_UQ) { const int hd = n / 192, c = n - hd * 192; if (c < 128) return n; const int j = c - 128; return hd * 192 + 128 + (j >> 1) + 32 * (j & 1); }
    return n < nsrc ? n : -1;
}
__device__ __forceinline__ void convert_w(float* tile, const float* W, int K, int Nsrc, bf16_t* Bt, int Ndst, int mode, const float* rowscale, float cscale, int bi, int nb) {
    const int tid = fresh_tid();
    const int tk = K / 64, nt = tk * (Ndst / 64);
    const int j = tid & 63, i0 = tid >> 6;
    float v[8];
#define CW_LOAD(tt) do { const int n0_ = ((tt) / tk) * 64, k0_ = ((tt) % tk) * 64; const int sc_ = map_src(mode, n0_ + j, Nsrc); \
        _Pragma("unroll") for (int it = 0; it < 8; ++it) { const int k_ = k0_ + i0 + 8 * it; float x_ = 0.f; if (sc_ >= 0) { x_ = W[(size_t)k_ * Nsrc + sc_] * cscale; if (rowscale) x_ *= rowscale[k_]; } v[it] = x_; } } while (0)
    int t = bi;
    if (t < nt) CW_LOAD(t);
    for (; t < nt; t += nb) {
        const int n0 = (t / tk) * 64, k0 = (t % tk) * 64;
        __syncthreads();
#pragma unroll
        for (int it = 0; it < 8; ++it) tile[(i0 + 8 * it) * 65 + j] = v[it];
        if (t + nb < nt) CW_LOAD(t + nb);
        __syncthreads();
        {
            const int n = tid >> 3, kk = (tid & 7) * 8; u32x4 w;
            w.x = pg8::cvt_pk_bf16(tile[(kk + 0) * 65 + n], tile[(kk + 1) * 65 + n]);
            w.y = pg8::cvt_pk_bf16(tile[(kk + 2) * 65 + n], tile[(kk + 3) * 65 + n]);
            w.z = pg8::cvt_pk_bf16(tile[(kk + 4) * 65 + n], tile[(kk + 5) * 65 + n]);
            w.w = pg8::cvt_pk_bf16(tile[(kk + 6) * 65 + n], tile[(kk + 7) * 65 + n]);
            *(u32x4*)(Bt + (size_t)(n0 + n) * K + k0 + kk) = w;
        }
    }
#undef CW_LOAD
    __syncthreads();
}

__device__ __forceinline__ void row_phase(const float* hsrc, const bf16_t* Y, const float* postw, const float* prew, float* hout, bf16_t* U) {
    const int tid_ = fresh_tid(); const int lane = tid_ & 63, gw = blockIdx.x * 8 + (tid_ >> 6), nw = gridDim.x * 8;
    for (int row = gw; row < MTOK; row += nw) {
        f32x4 h[8]; const float* hp = hsrc + (size_t)row * DM + lane * 4;
#pragma unroll
        for (int i = 0; i < 8; ++i) h[i] = *(const f32x4*)(hp + 256 * i);
        if (Y) {
            f32x4 y[8]; const bf16_t* yp = Y + (size_t)row * DM + lane * 4; float ss = 0.f;
#pragma unroll
            for (int i = 0; i < 8; ++i) { const u32x2 yy = *(const u32x2*)(yp + 256 * i); y[i] = (f32x4){__uint_as_float(yy.x << 16), __uint_as_float(yy.x & 0xffff0000u), __uint_as_float(yy.y << 16), __uint_as_float(yy.y & 0xffff0000u)};
                ss += y[i][0] * y[i][0] + y[i][1] * y[i][1] + y[i][2] * y[i][2] + y[i][3] * y[i][3]; }
            ss = wave_sum(ss); const float ry = rsqrtf(ss * (1.f / 2048.f) + EPS);
            float* op = hout + (size_t)row * DM + lane * 4;
#pragma unroll
            for (int i = 0; i < 8; ++i) { const f32x4 pw = *(const f32x4*)(postw + lane * 4 + 256 * i); h[i] += y[i] * ry * pw; *(f32x4*)(op + 256 * i) = h[i]; }
        }
        if (prew) {
            float ss = 0.f;
#pragma unroll
            for (int i = 0; i < 8; ++i) ss += h[i][0] * h[i][0] + h[i][1] * h[i][1] + h[i][2] * h[i][2] + h[i][3] * h[i][3];
            ss = wave_sum(ss); const float r = rsqrtf(ss * (1.f / 2048.f) + EPS);
            bf16_t* up = U + (size_t)row * DM + lane * 4;
#pragma unroll
            for (int i = 0; i < 8; ++i) { const f32x4 pw = *(const f32x4*)(prew + lane * 4 + 256 * i); const f32x4 u = h[i] * r * pw;
                u32x2 w; w.x = pg8::cvt_pk_bf16(u[0], u[1]); w.y = pg8::cvt_pk_bf16(u[2], u[3]); *(u32x2*)(up + 256 * i) = w; }
        }
    }
}

enum { EM_HG = 0, EM_MLAIN = 1, EM_Q = 2, EM_KV = 3, EM_GDN = 4, EM_OUT = 5 };
struct Epi {
    static constexpr bool PERM = true, AFTER_DRAIN = false;
    int mode;
    unsigned char* ws;
    const float* lb;
    const float* alog; const float* dtb;
    __device__ __forceinline__ void operator()(const f32x4 (&acc)[2][2][4][2], const pg8::Unit& u, int wr, int wc, int fr, int fq) const {
        asm volatile("" : "+v"(fr), "+v"(fq));
        const int rowb = u.pm * 256 + wr * 64 + fr, colw = wc * 32 + 8 * fq;
#define EPI_LOOP for (int ai = 0; ai < 2; ++ai) for (int m = 0; m < 4; ++m) { const int row = rowb + ai * 128 + m * 16; (void)row; for (int bj = 0; bj < 2; ++bj) { const int col = colw + bj * 128; (void)col; f32x4 v0 = acc[ai][bj][m][0], v1 = acc[ai][bj][m][1];
#define EPI_END } }
        if (mode == EM_OUT) {
            bf16_t* Y = (bf16_t*)(ws + WS_BIG);
#pragma unroll
            EPI_LOOP *(u32x4*)(Y + (size_t)row * 2048 + u.pn * 256 + col) = pack8(v0, v1); EPI_END
        } else if (mode == EM_KV) {
            bf16_t* KV = (bf16_t*)(ws + WS_BIG + 96 * MiB); const float* ssq = (const float*)(ws + WS_SSQ) + (size_t)MTOK * 8;
#pragma unroll
            for (int ai = 0; ai < 2; ++ai)
#pragma unroll
                for (int m = 0; m < 4; ++m) { const int row = rowb + ai * 128 + m * 16; const f32x4 p0 = *(const f32x4*)(ssq + (size_t)row * 8), p1 = *(const f32x4*)(ssq + (size_t)row * 8 + 4); const float r = rsqrtf((((p0[0] + p0[1]) + (p0[2] + p0[3])) + ((p1[0] + p1[1]) + (p1[2] + p1[3]))) * (1.f / 512.f) + EPS);
#pragma unroll
                    for (int bj = 0; bj < 2; ++bj) { const int col = colw + bj * 128; *(u32x4*)(KV + (size_t)row * 4096 + u.pn * 256 + col) = pack8(acc[ai][bj][m][0] * r, acc[ai][bj][m][1] * r); } }
        } else if (mode == EM_Q) {
            bf16_t* Q = (bf16_t*)(ws + WS_BIG); const float* ssq = (const float*)(ws + WS_SSQ);
            const float* COS = (const float*)(ws + WS_COS); const float* SIN = (const float*)(ws + WS_SIN);
#pragma unroll
            for (int ai = 0; ai < 2; ++ai)
#pragma unroll
                for (int m = 0; m < 4; ++m) { const int row = rowb + ai * 128 + m * 16; const f32x4 p0 = *(const f32x4*)(ssq + (size_t)row * 8), p1 = *(const f32x4*)(ssq + (size_t)row * 8 + 4); const float r = rsqrtf((((p0[0] + p0[1]) + (p0[2] + p0[3])) + ((p1[0] + p1[1]) + (p1[2] + p1[3]))) * (1.f / 512.f) + EPS);
#pragma unroll
                    for (int bj = 0; bj < 2; ++bj) { const int c = u.pn * 256 + colw + bj * 128; const int within = c % 192;
                        f32x4 v0 = acc[ai][bj][m][0] * r, v1 = acc[ai][bj][m][1] * r;
                        if (within >= 128) { const int j0 = (within - 128) >> 1; const f32x4 cs = *(const f32x4*)(COS + (size_t)row * 32 + j0), sn = *(const f32x4*)(SIN + (size_t)row * 32 + j0);
                            const f32x4 a = (f32x4){v0[0], v0[2], v1[0], v1[2]}, b = (f32x4){v0[1], v0[3], v1[1], v1[3]};
                            const f32x4 ra = a * cs - b * sn, rb = b * cs + a * sn;
                            v0 = (f32x4){ra[0], rb[0], ra[1], rb[1]}; v1 = (f32x4){ra[2], rb[2], ra[3], rb[3]}; }
                        *(u32x4*)(Q + (size_t)row * 3072 + c) = pack8(v0, v1); } }
        } else if (mode == EM_MLAIN) {
            if (u.pn < 4) {
                bf16_t* C = (bf16_t*)(ws + WS_Z + (u.pn < 2 ? 64 : 80) * MiB); float* ssq = (float*)(ws + WS_SSQ) + (u.pn < 2 ? (size_t)0 : (size_t)MTOK * 8); const int cb = (u.pn & 1) * 256;
#pragma unroll
                for (int ai = 0; ai < 2; ++ai)
#pragma unroll
                    for (int m = 0; m < 4; ++m) { const int row = rowb + ai * 128 + m * 16; float s = 0.f;
#pragma unroll
                        for (int bj = 0; bj < 2; ++bj) { const int col = colw + bj * 128; const f32x4 v0 = acc[ai][bj][m][0], v1 = acc[ai][bj][m][1];
                            s += v0[0] * v0[0] + v0[1] * v0[1] + v0[2] * v0[2] + v0[3] * v0[3] + v1[0] * v1[0] + v1[1] * v1[1] + v1[2] * v1[2] + v1[3] * v1[3];
                            *(u32x4*)(C + (size_t)row * 512 + cb + col) = pack8(v0, v1); }
                        s += __shfl_xor(s, 16); s += __shfl_xor(s, 32);
                        if (fq == 0) ssq[(size_t)row * 8 + (u.pn & 1) * 4 + wc] = s; }
            } else if (u.pn < 12) {
                bf16_t* Zs = (bf16_t*)(ws + WS_Z); const int cb = (u.pn - 4) * 256;
#pragma unroll
                EPI_LOOP
                    for (int e = 0; e < 4; ++e) { v0[e] = siluf(v0[e]); v1[e] = siluf(v1[e]); }
                    *(u32x4*)(Zs + (size_t)row * 2048 + cb + col) = pack8(v0, v1);
                EPI_END
            } else {
                if (colw < 64) {
                    bf16_t* KR = (bf16_t*)(ws + WS_Z + 96 * MiB); const float* COS = (const float*)(ws + WS_COS); const float* SIN = (const float*)(ws + WS_SIN);
#pragma unroll
                    for (int ai = 0; ai < 2; ++ai)
#pragma unroll
                        for (int m = 0; m < 4; ++m) { const int row = rowb + ai * 128 + m * 16; const int j0 = colw >> 1;
                            const f32x4 v0 = acc[ai][0][m][0], v1 = acc[ai][0][m][1];
                            const f32x4 cs = *(const f32x4*)(COS + (size_t)row * 32 + j0), sn = *(const f32x4*)(SIN + (size_t)row * 32 + j0);
                            const f32x4 a = (f32x4){v0[0], v0[2], v1[0], v1[2]}, b = (f32x4){v0[1], v0[3], v1[1], v1[3]};
                            const f32x4 ra = a * cs - b * sn, rb = b * cs + a * sn;
                            *(u32x4*)(KR + (size_t)row * 64 + colw) = pack8((f32x4){ra[0], rb[0], ra[1], rb[1]}, (f32x4){ra[2], rb[2], ra[3], rb[3]}); }
                }
            }
        } else if (mode == EM_HG) {
            const int region = u.pn >> 3, cb = (u.pn & 7) * 256;
            if (region == 0) {
                bf16_t* Q = (bf16_t*)(ws + WS_BIG);
#pragma unroll
                EPI_LOOP
                    for (int e = 0; e < 4; ++e) { v0[e] = siluf(v0[e]) * 0.08838834764831845f; v1[e] = siluf(v1[e]) * 0.08838834764831845f; }
                    *(u32x4*)(Q + (size_t)row * 2048 + cb + col) = pack8(v0, v1);
                EPI_END
            } else if (region == 1) {
                bf16_t* Kk = (bf16_t*)(ws + WS_BIG + 64 * MiB); float* G = (float*)(ws + WS_BIG + 128 * MiB);
#pragma unroll
                for (int bj = 0; bj < 2; ++bj) { const int col = colw + bj * 128; const f32x4 l0 = *(const f32x4*)(lb + cb + col), l1 = *(const f32x4*)(lb + cb + col + 4);
#pragma unroll
                    for (int ai = 0; ai < 2; ++ai)
#pragma unroll
                        for (int m = 0; m < 4; ++m) { const int row = rowb + ai * 128 + m * 16; const f32x4 v0 = acc[ai][bj][m][0], v1 = acc[ai][bj][m][1]; f32x4 g0, g1, k0, k1;
#pragma unroll
                            for (int e = 0; e < 4; ++e) {
                                { const float f = v0[e], l = l0[e], en = __expf(-fabsf(f)), ls = fminf(f, 0.f) - __logf(1.f + en), sg = __expf(ls);
                                  g0[e] = (l == 0.f) ? ls : __logf(l + (1.f - l) * sg); k0[e] = (1.f - l) * (1.f - sg); }
                                { const float f = v1[e], l = l1[e], en = __expf(-fabsf(f)), ls = fminf(f, 0.f) - __logf(1.f + en), sg = __expf(ls);
                                  g1[e] = (l == 0.f) ? ls : __logf(l + (1.f - l) * sg); k1[e] = (1.f - l) * (1.f - sg); } }
                            float* gp = G + (size_t)row * 2048 + cb + col; *(f32x4*)gp = g0; *(f32x4*)(gp + 4) = g1;
                            *(u32x4*)(Kk + (size_t)row * 2048 + cb + col) = pack8(k0, k1); } }
            } else if (region == 2) {
                bf16_t* V = (bf16_t*)(ws + WS_Z);
#pragma unroll
                EPI_LOOP *(u32x4*)(V + (size_t)row * 2048 + cb + col) = pack8(v0, v1); EPI_END
            } else {
                bf16_t* Zs = (bf16_t*)(ws + WS_Z + 64 * MiB);
#pragma unroll
                EPI_LOOP
                    for (int e = 0; e < 4; ++e) { v0[e] = siluf(v0[e]); v1[e] = siluf(v1[e]); }
                    *(u32x4*)(Zs + (size_t)row * 2048 + cb + col) = pack8(v0, v1);
                EPI_END
            }
        } else if (mode == EM_GDN) {
            if (u.pn < 32) {
                bf16_t* QKV = (bf16_t*)(ws + WS_BIG);
#pragma unroll
                EPI_LOOP *(u32x4*)(QKV + (size_t)row * 8192 + u.pn * 256 + col) = pack8(v0, v1); EPI_END
            } else if (u.pn < 48) {
                bf16_t* Zs = (bf16_t*)(ws + WS_Z); const int cb = (u.pn - 32) * 256;
#pragma unroll
                EPI_LOOP
                    for (int e = 0; e < 4; ++e) { v0[e] = siluf(v0[e]); v1[e] = siluf(v1[e]); }
                    *(u32x4*)(Zs + (size_t)row * 4096 + cb + col) = pack8(v0, v1);
                EPI_END
            } else {
                if (colw < 64) {
                    float* GD = (float*)(ws + WS_GD); float* BD = (float*)(ws + WS_BD);
#pragma unroll
                    for (int ai = 0; ai < 2; ++ai)
#pragma unroll
                        for (int m = 0; m < 4; ++m) { const int row = rowb + ai * 128 + m * 16; f32x4 v0 = acc[ai][0][m][0], v1 = acc[ai][0][m][1];
                            if (colw < 32) {
                                const f32x4 a0 = *(const f32x4*)(alog + colw), a1 = *(const f32x4*)(alog + colw + 4), d0 = *(const f32x4*)(dtb + colw), d1 = *(const f32x4*)(dtb + colw + 4);
#pragma unroll
                                for (int e = 0; e < 4; ++e) {
                                    { const float x = v0[e] + d0[e]; const float sp = fmaxf(x, 0.f) + __logf(1.f + __expf(-fabsf(x))); v0[e] = -__expf(a0[e]) * sp; }
                                    { const float x = v1[e] + d1[e]; const float sp = fmaxf(x, 0.f) + __logf(1.f + __expf(-fabsf(x))); v1[e] = -__expf(a1[e]) * sp; } }
                                float* p = GD + (size_t)row * 32 + colw; *(f32x4*)p = v0; *(f32x4*)(p + 4) = v1;
                            } else {
#pragma unroll
                                for (int e = 0; e < 4; ++e) { v0[e] = sigmf(v0[e]); v1[e] = sigmf(v1[e]); }
                                float* p = BD + (size_t)row * 32 + (colw - 32); *(f32x4*)p = v0; *(f32x4*)(p + 4) = v1;
                            } }
                }
            }
        }
#undef EPI_LOOP
#undef EPI_END
    }
};

__device__ __forceinline__ void run_gemm(LAS unsigned char* lds, const bf16_t* A, const bf16_t* Bt, int N, int K, const Epi E) {
    pg8::Gemm g{A, Bt, MTOK, N, K}; pg8::StaticOrder S; S.init(MTOK, N, (int)gridDim.x, (int)blockIdx.x);
    pg8::gemm_phase<Epi, pg8::StaticOrder>(lds, g, S, E);
    __syncthreads();
}

__device__ __forceinline__ s16x4 tr_read(const bf16_t* p) {
    typedef short v4i16_t __attribute__((ext_vector_type(4)));
    return __builtin_bit_cast(s16x4, __builtin_amdgcn_ds_read_tr16_b64_v4i16((LAS v4i16_t*)p));
}
__device__ __forceinline__ bf16x8 frag_tr(const bf16_t* base, int stride, int k0, int c0, int fr, int fq) {
    const bf16_t* p = base + (k0 + 8 * fq + (fr >> 2)) * stride + c0 + 4 * (fr & 3);
    const s16x4 r0 = tr_read(p), r1 = tr_read(p + 4 * stride);
    return (bf16x8){r0[0], r0[1], r0[2], r0[3], r1[0], r1[1], r1[2], r1[3]};
}
__device__ __forceinline__ bf16x8 frag_row(const bf16_t* base, int stride, int r0, int k0, int fr, int fq) { return *(const bf16x8*)(base + (r0 + fr) * stride + k0 + 8 * fq); }

__device__ __forceinline__ f32x4 quad_t4(const f32x4 a, int q) {
    const bool b0 = q & 1, b1 = q & 2;
    const float s0 = b0 ? a[0] : a[1], s1 = b0 ? a[2] : a[3];
    const float r0 = __builtin_bit_cast(float, __builtin_amdgcn_mov_dpp(__builtin_bit_cast(int, s0), 0xB1, 0xF, 0xF, true));
    const float r1 = __builtin_bit_cast(float, __builtin_amdgcn_mov_dpp(__builtin_bit_cast(int, s1), 0xB1, 0xF, 0xF, true));
    const float c0 = b0 ? r0 : a[0], c1 = b0 ? a[1] : r0, d0 = b0 ? r1 : a[2], d1 = b0 ? a[3] : r1;
    const float t0 = b1 ? c0 : d0, t1 = b1 ? c1 : d1;
    const float u0 = __builtin_bit_cast(float, __builtin_amdgcn_mov_dpp(__builtin_bit_cast(int, t0), 0x4E, 0xF, 0xF, true));
    const float u1 = __builtin_bit_cast(float, __builtin_amdgcn_mov_dpp(__builtin_bit_cast(int, t1), 0x4E, 0xF, 0xF, true));
    return (f32x4){b1 ? u0 : c0, b1 ? u1 : c1, b1 ? d0 : u0, b1 ? d1 : u1};
}
__device__ __forceinline__ void store_ctile_bf16(bf16_t* base, int stride, int row0, int col0, const f32x4 a, int fr, int fq) {
    const f32x4 o = quad_t4(a, fr & 3);
    u32x2 w; w.x = pg8::cvt_pk_bf16(o[0], o[1]); w.y = pg8::cvt_pk_bf16(o[2], o[3]);
    *(u32x2*)(base + (row0 + 4 * fq + (fr & 3)) * stride + col0 + 4 * (fr >> 2)) = w;
}
__device__ __forceinline__ void store_ctile_f32(float* base, int stride, int row0, int col0, const f32x4 a, int fr, int fq) {
    *(f32x4*)(base + (row0 + 4 * fq + (fr & 3)) * stride + col0 + 4 * (fr >> 2)) = quad_t4(a, fr & 3);
}

__device__ __forceinline__ void gla_chunked(unsigned char* lds, unsigned char* ws, const float* hn, bool dry) {
    if (blockIdx.x >= 128) return;
    const int tid = fresh_tid(), lane = tid & 63, w = __builtin_amdgcn_readfirstlane(tid >> 6), fr = lane & 15, fq = lane >> 4;
    const int b = blockIdx.x >> 4, h = blockIdx.x & 15;
    const bf16_t* Q = (const bf16_t*)(ws + WS_BIG); const bf16_t* Kk = (const bf16_t*)(ws + WS_BIG + 64 * MiB); const float* G = (const float*)(ws + WS_BIG + 128 * MiB);
    const bf16_t* V = (const bf16_t*)(ws + WS_Z); bf16_t* Zs = (bf16_t*)(ws + WS_Z + 64 * MiB);
    bf16_t* QD = (bf16_t*)lds; bf16_t* KD = (bf16_t*)(lds + 17408); bf16_t* VV = (bf16_t*)(lds + 35840); bf16_t* PP = (bf16_t*)(lds + 54272);
    bf16_t* SB = (bf16_t*)(lds + 63488); float* OT = (float*)(lds + 104960); float* TOT0 = (float*)(lds + 100352);
    const int c = tid & 127, part = tid >> 7;
    f32x4 S[8];
#pragma unroll
    for (int i = 0; i < 8; ++i) S[i] = (f32x4){0.f, 0.f, 0.f, 0.f};
    float* HN = (float*)(lds + 104448); if (tid < 128) HN[tid] = hn[tid];
    float ng[16]; bf16_t nq[16], nk[16]; u32x4 nv0, nv1;
    {
#pragma unroll
        for (int i = 0; i < 16; ++i) { const size_t gi = (size_t)(b * SEQ + 16 * part + i) * 2048 + h * 128 + c; ng[i] = G[gi]; nq[i] = Q[gi]; nk[i] = Kk[gi]; }
        nv0 = *(const u32x4*)(V + (size_t)(b * SEQ + (tid >> 4)) * 2048 + h * 128 + (tid & 15) * 8); nv1 = *(const u32x4*)(V + (size_t)(b * SEQ + ((tid + 512) >> 4)) * 2048 + h * 128 + (tid & 15) * 8);
    }
    u32x4 zp0 = (u32x4){0u, 0u, 0u, 0u}, zp1 = zp0; int trp = 0;
    for (int ch = 0; ch < 32; ++ch) {
        const int tid = fresh_tid(), lane = tid & 63, fr = lane & 15, fq = lane >> 4, c = tid & 127, part = tid >> 7; (void)lane;
        const int trow0 = b * SEQ + ch * 64;
        float g[16], qv[16], kv[16];
#pragma unroll
        for (int i = 0; i < 16; ++i) { g[i] = ng[i]; qv[i] = bf2f(nq[i]); kv[i] = bf2f(nk[i]); }
        float* TOT = TOT0 + (ch & 1) * 512;
        const u32x4 cv0 = nv0, cv1 = nv1;
        const u32x4 zc0 = *(const u32x4*)(Zs + (size_t)(trow0 + (tid >> 3)) * 2048 + h * 128 + (tid & 7) * 16), zc1 = *(const u32x4*)(Zs + (size_t)(trow0 + (tid >> 3)) * 2048 + h * 128 + (tid & 7) * 16 + 8);
        if (ch + 1 < 32) {
#pragma unroll
            for (int i = 0; i < 16; ++i) { const size_t gi = (size_t)(trow0 + 64 + 16 * part + i) * 2048 + h * 128 + c; ng[i] = G[gi]; nq[i] = Q[gi]; nk[i] = Kk[gi]; }
            nv0 = *(const u32x4*)(V + (size_t)(trow0 + 64 + (tid >> 4)) * 2048 + h * 128 + (tid & 15) * 8); nv1 = *(const u32x4*)(V + (size_t)(trow0 + 64 + ((tid + 512) >> 4)) * 2048 + h * 128 + (tid & 15) * 8);
        }
#pragma unroll
        for (int i = 1; i < 16; ++i) g[i] += g[i - 1];
        TOT[part * 128 + c] = g[15];
        __syncthreads();
        if (ch > 0)
        {
            const int r = tid >> 3, seg = tid & 7; const float* op = OT + r * 132 + seg * 16;
            f32x4 v[4]; float ss = 0.f;
#pragma unroll
            for (int i = 0; i < 4; ++i) { v[i] = *(const f32x4*)(op + 4 * i); ss += v[i][0] * v[i][0] + v[i][1] * v[i][1] + v[i][2] * v[i][2] + v[i][3] * v[i][3]; }
            ss += __shfl_xor(ss, 1); ss += __shfl_xor(ss, 2); ss += __shfl_xor(ss, 4);
            const float rn = rsqrtf(ss * (1.f / 128.f) + EPS);
            bf16_t* zp = Zs + (size_t)(trp + r) * 2048 + h * 128 + seg * 16;
#pragma unroll
            for (int i = 0; i < 2; ++i) { const u32x4 zz = i ? zp1 : zp0; const f32x4 h0 = *(const f32x4*)(HN + seg * 16 + 8 * i), h1 = *(const f32x4*)(HN + seg * 16 + 8 * i + 4);
                f32x4 o0 = v[2 * i] * rn * h0, o1 = v[2 * i + 1] * rn * h1;
                o0[0] *= __uint_as_float(zz.x << 16); o0[1] *= __uint_as_float(zz.x & 0xffff0000u); o0[2] *= __uint_as_float(zz.y << 16); o0[3] *= __uint_as_float(zz.y & 0xffff0000u);
                o1[0] *= __uint_as_float(zz.z << 16); o1[1] *= __uint_as_float(zz.z & 0xffff0000u); o1[2] *= __uint_as_float(zz.w << 16); o1[3] *= __uint_as_float(zz.w & 0xffff0000u);
                if (!dry) *(u32x4*)(zp + 8 * i) = pack8(o0, o1); }
        }
        *(u32x4*)(VV + (tid >> 4) * 144 + (tid & 15) * 8) = cv0; *(u32x4*)(VV + ((tid + 512) >> 4) * 144 + (tid & 15) * 8) = cv1;
#ifdef GLASKIP_B
        if (!dry)
#endif
        {
            const float t0 = TOT[c], t1 = TOT[128 + c], t2 = TOT[256 + c];
            const float off = (part > 0 ? t0 : 0.f) + (part > 1 ? t1 : 0.f) + (part > 2 ? t2 : 0.f), bref = t0 + t1;
#pragma unroll
            for (int i = 0; i < 16; ++i) { const float bt = g[i] + off;
                QD[(16 * part + i) * 136 + c] = f2bf(qv[i] * __expf(fminf(bt - bref, 80.f))); KD[(16 * part + i) * 144 + c] = f2bf(kv[i] * __expf(fminf(bref - bt, 80.f))); }
            { f32x4 er;
#pragma unroll
              for (int j = 0; j < 4; ++j) { const int kk = 16 * w + 4 * fq + j; er[j] = __expf(TOT[kk] + TOT[128 + kk]); }
#pragma unroll
              for (int vt = 0; vt < 8; ++vt) store_ctile_bf16(SB, 144, 16 * w, 16 * vt, S[vt] * er, fr, fq); }
        }
        __syncthreads();
#ifdef GLASKIP_C
        if (!dry)
#endif
        {
            const int tt = w >> 1;
#pragma unroll
            for (int x = 0; x < 2; ++x) { const int st = (w & 1) * 2 + x; f32x4 acc = (f32x4){0.f, 0.f, 0.f, 0.f};
                if (st <= tt) {
#pragma unroll
                    for (int ks = 0; ks < 4; ++ks) acc = __builtin_amdgcn_mfma_f32_16x16x32_bf16(frag_row(QD, 136, 16 * tt, 32 * ks, fr, fq), frag_row(KD, 144, 16 * st, 32 * ks, fr, fq), acc, 0, 0, 0);
                }
#pragma unroll
                for (int j = 0; j < 4; ++j) { const int t = 16 * tt + 4 * fq + j, sx = 16 * st + fr; acc[j] = (st <= tt && sx <= t) ? acc[j] : 0.f; }
                store_ctile_bf16(PP, 72, 16 * tt, 16 * st, acc, fr, fq); }
        }
        __syncthreads();
        f32x4 oacc[4];
#ifdef GLASKIP_D
        if (dry) { oacc[0] = oacc[1] = oacc[2] = oacc[3] = S[0]; } else
#endif
        {
            const int tt = w >> 1;
#pragma unroll
            for (int x = 0; x < 4; ++x) { const int vt = (w & 1) * 4 + x; f32x4 acc = (f32x4){0.f, 0.f, 0.f, 0.f};
#pragma unroll
                for (int ks = 0; ks < 2; ++ks) acc = __builtin_amdgcn_mfma_f32_16x16x32_bf16(frag_row(PP, 72, 16 * tt, 32 * ks, fr, fq), frag_tr(VV, 144, 32 * ks, 16 * vt, fr, fq), acc, 0, 0, 0);
#pragma unroll
                for (int ks = 0; ks < 4; ++ks) acc = __builtin_amdgcn_mfma_f32_16x16x32_bf16(frag_row(QD, 136, 16 * tt, 32 * ks, fr, fq), frag_tr(SB, 144, 32 * ks, 16 * vt, fr, fq), acc, 0, 0, 0);
                oacc[x] = acc; }
            float el[4], e2[4];
#pragma unroll
            for (int j = 0; j < 4; ++j) { const int kk = 16 * w + 4 * fq + j; const float hi = TOT[256 + kk] + TOT[384 + kk]; e2[j] = __expf(hi); el[j] = __expf(TOT[kk] + TOT[128 + kk] + hi); }
            const bf16x8 ka0 = frag_tr(KD, 144, 0, 16 * w, fr, fq), ka1 = frag_tr(KD, 144, 32, 16 * w, fr, fq);
#pragma unroll
            for (int vt = 0; vt < 8; ++vt) { f32x4 a2 = (f32x4){0.f, 0.f, 0.f, 0.f};
                a2 = __builtin_amdgcn_mfma_f32_16x16x32_bf16(ka0, frag_tr(VV, 144, 0, 16 * vt, fr, fq), a2, 0, 0, 0);
                a2 = __builtin_amdgcn_mfma_f32_16x16x32_bf16(ka1, frag_tr(VV, 144, 32, 16 * vt, fr, fq), a2, 0, 0, 0);
#pragma unroll
                for (int j = 0; j < 4; ++j) S[vt][j] = el[j] * S[vt][j] + e2[j] * a2[j]; }
        }
        {
            const int tt = w >> 1;
#pragma unroll
            for (int x = 0; x < 4; ++x) { const int vt = (w & 1) * 4 + x; store_ctile_f32(OT, 132, 16 * tt, 16 * vt, oacc[x], fr, fq); }
        }
        zp0 = zc0; zp1 = zc1; trp = trow0;
    }
    __syncthreads();
        {
            const int r = tid >> 3, seg = tid & 7; const float* op = OT + r * 132 + seg * 16;
            f32x4 v[4]; float ss = 0.f;
#pragma unroll
            for (int i = 0; i < 4; ++i) { v[i] = *(const f32x4*)(op + 4 * i); ss += v[i][0] * v[i][0] + v[i][1] * v[i][1] + v[i][2] * v[i][2] + v[i][3] * v[i][3]; }
            ss += __shfl_xor(ss, 1); ss += __shfl_xor(ss, 2); ss += __shfl_xor(ss, 4);
            const float rn = rsqrtf(ss * (1.f / 128.f) + EPS);
            bf16_t* zp = Zs + (size_t)(trp + r) * 2048 + h * 128 + seg * 16;
#pragma unroll
            for (int i = 0; i < 2; ++i) { const u32x4 zz = i ? zp1 : zp0; const f32x4 h0 = *(const f32x4*)(HN + seg * 16 + 8 * i), h1 = *(const f32x4*)(HN + seg * 16 + 8 * i + 4);
                f32x4 o0 = v[2 * i] * rn * h0, o1 = v[2 * i + 1] * rn * h1;
                o0[0] *= __uint_as_float(zz.x << 16); o0[1] *= __uint_as_float(zz.x & 0xffff0000u); o0[2] *= __uint_as_float(zz.y << 16); o0[3] *= __uint_as_float(zz.y & 0xffff0000u);
                o1[0] *= __uint_as_float(zz.z << 16); o1[1] *= __uint_as_float(zz.z & 0xffff0000u); o1[2] *= __uint_as_float(zz.w << 16); o1[3] *= __uint_as_float(zz.w & 0xffff0000u);
                if (!dry) *(u32x4*)(zp + 8 * i) = pack8(o0, o1); }
        }
}


constexpr int GD_KK = 0, GD_QQ = 18432, GD_VN = 35840, GD_SB = 54272, GD_AW = 91136, GD_AT = 108544, GD_UU = 117760, GD_MM = 136192, GD_W = 143104, GD_SM = 160512, GD_HN = 162560, GD_END = 163072;
constexpr int GD_AB = GD_AW + 4096, GD_TI = GD_AW + 13312;
constexpr int GD_RAW = GD_AW;
__device__ __forceinline__ void gdn_chunked(unsigned char* lds, unsigned char* ws, const float* cw, const float* hn, bool dry) {
    const int w = __builtin_amdgcn_readfirstlane(fresh_tid() >> 6);
    const bf16_t* QKV = (const bf16_t*)(ws + WS_BIG); bf16_t* Zs = (bf16_t*)(ws + WS_Z); const float* GDp = (const float*)(ws + WS_GD); const float* BDp = (const float*)(ws + WS_BD);
    bf16_t* KK = (bf16_t*)(lds + GD_KK); bf16_t* QQ = (bf16_t*)(lds + GD_QQ); float* AW = (float*)(lds + GD_AW); bf16_t* W = (bf16_t*)(lds + GD_W); bf16_t* AT = (bf16_t*)(lds + GD_AT);
    bf16_t* UU = (bf16_t*)(lds + GD_UU); bf16_t* VN = (bf16_t*)(lds + GD_VN); bf16_t* SB = (bf16_t*)(lds + GD_SB); bf16_t* OT = (bf16_t*)(lds + GD_W); bf16_t* RAW = (bf16_t*)(lds + GD_RAW); bf16_t* AB = (bf16_t*)(lds + GD_AB); bf16_t* TI = (bf16_t*)(lds + GD_TI); bf16_t* MM = (bf16_t*)(lds + GD_MM);
    float* gcs = (float*)(lds + GD_SM); float* egs = gcs + 64; float* bts = gcs + 128; float* nk2 = gcs + 192; float* nq2 = gcs + 256; float* rks = gcs + 320; float* rqs = gcs + 384;
    float* HN = (float*)(lds + GD_HN); { const int t_ = fresh_tid(); if (t_ < 128) HN[t_] = hn[t_]; }
    for (int item_ = blockIdx.x; item_ < 256; item_ += gridDim.x) {
        const int item = (gridDim.x == 256) ? ((item_ & 7) * 32 + (item_ >> 3)) : item_;
        const int b = item >> 5, vh = item & 31, hq = vh >> 1;
        f32x4 S[8];
#pragma unroll
        for (int i = 0; i < 8; ++i) S[i] = (f32x4){0.f, 0.f, 0.f, 0.f};
        const int c = fresh_tid() & 127;
        const float wq0 = cw[hq * 128 + c], wq1 = cw[8192 + hq * 128 + c], wq2 = cw[16384 + hq * 128 + c], wq3 = cw[24576 + hq * 128 + c];
        const float wk0 = cw[2048 + hq * 128 + c], wk1 = cw[8192 + 2048 + hq * 128 + c], wk2 = cw[16384 + 2048 + hq * 128 + c], wk3 = cw[24576 + 2048 + hq * 128 + c];
        const float wv0 = cw[4096 + vh * 128 + c], wv1 = cw[8192 + 4096 + vh * 128 + c], wv2 = cw[16384 + 4096 + vh * 128 + c], wv3 = cw[24576 + 4096 + vh * 128 + c];
        u32x4 praw[7];
#define GD_LOADRAW(chn) do { _Pragma("unroll") for (int i = 0; i < 7; ++i) { const int p = ptid + 512 * i; praw[i] = (u32x4){0u, 0u, 0u, 0u}; \
            if (p < 3216) { const int r = p / 48, k = p - r * 48; const int tl = (chn) * 64 + r - 3; const int chb = (k < 16) ? hq * 128 + k * 8 : ((k < 32) ? 2048 + hq * 128 + (k - 16) * 8 : 4096 + vh * 128 + (k - 32) * 8); \
                if (tl >= 0) praw[i] = *(const u32x4*)(QKV + (size_t)(b * SEQ + tl) * 8192 + chb); } } } while (0)
        { const int ptid = fresh_tid(); GD_LOADRAW(0); }
        float pgd = GDp[(size_t)(b * SEQ + (fresh_tid() & 63)) * 32 + vh], pbd = BDp[(size_t)(b * SEQ + (fresh_tid() & 63)) * 32 + vh];
        u32x4 zp0 = (u32x4){0u, 0u, 0u, 0u}, zp1 = zp0; int trp = 0;
        for (int ch = 0; ch < 32; ++ch) {
            const int tid = fresh_tid(), lane = tid & 63, c = tid & 127, part = tid >> 7;
            const int trow0 = b * SEQ + ch * 64;
#pragma unroll
            for (int i = 0; i < 7; ++i) { const int p = tid + 512 * i; if (p < 3216) *(u32x4*)(RAW + p * 8) = praw[i]; }
            const u32x4 zz0 = *(const u32x4*)(Zs + (size_t)(trow0 + (tid >> 3)) * 4096 + vh * 128 + (tid & 7) * 16), zz1 = *(const u32x4*)(Zs + (size_t)(trow0 + (tid >> 3)) * 4096 + vh * 128 + (tid & 7) * 16 + 8);
            if (w == 0) {
                float gsum = pgd;
#define GD_DPP(x, ctrl, rmask) __builtin_bit_cast(float, __builtin_amdgcn_update_dpp(0, __builtin_bit_cast(int, x), ctrl, rmask, 0xF, false))
                gsum += GD_DPP(gsum, 0x111, 0xF); gsum += GD_DPP(gsum, 0x112, 0xF); gsum += GD_DPP(gsum, 0x114, 0xF); gsum += GD_DPP(gsum, 0x118, 0xF);
                gsum += GD_DPP(gsum, 0x142, 0xA); gsum += GD_DPP(gsum, 0x143, 0xC);
#undef GD_DPP
                gcs[lane] = gsum; egs[lane] = __expf(gsum); bts[lane] = pbd;
            }
            if (ch + 1 < 32) { pgd = GDp[(size_t)(trow0 + 64 + lane) * 32 + vh]; pbd = BDp[(size_t)(trow0 + 64 + lane) * 32 + vh]; }
            { const int lt_ = fresh_tid(); const int fr = lt_ & 15, fq = (lt_ & 63) >> 4;
#pragma unroll
              for (int vt = 0; vt < 8; ++vt) store_ctile_bf16(SB, 144, 16 * w, 16 * vt, S[vt], fr, fq); }
            __syncthreads();
            if (ch > 0)
            {
                const int lt2_ = fresh_tid(); const int r = lt2_ >> 3, seg = lt2_ & 7; const bf16_t* op = OT + r * 136 + seg * 16;
                f32x4 v[4]; float ss = 0.f;
                { const u32x4 q0 = *(const u32x4*)op, q1 = *(const u32x4*)(op + 8);
                  v[0] = (f32x4){__uint_as_float(q0.x << 16), __uint_as_float(q0.x & 0xffff0000u), __uint_as_float(q0.y << 16), __uint_as_float(q0.y & 0xffff0000u)};
                  v[1] = (f32x4){__uint_as_float(q0.z << 16), __uint_as_float(q0.z & 0xffff0000u), __uint_as_float(q0.w << 16), __uint_as_float(q0.w & 0xffff0000u)};
                  v[2] = (f32x4){__uint_as_float(q1.x << 16), __uint_as_float(q1.x & 0xffff0000u), __uint_as_float(q1.y << 16), __uint_as_float(q1.y & 0xffff0000u)};
                  v[3] = (f32x4){__uint_as_float(q1.z << 16), __uint_as_float(q1.z & 0xffff0000u), __uint_as_float(q1.w << 16), __uint_as_float(q1.w & 0xffff0000u)}; }
#pragma unroll
                for (int i = 0; i < 4; ++i) ss += v[i][0] * v[i][0] + v[i][1] * v[i][1] + v[i][2] * v[i][2] + v[i][3] * v[i][3];
                ss += __shfl_xor(ss, 1); ss += __shfl_xor(ss, 2); ss += __shfl_xor(ss, 4);
                const float rn = rsqrtf(ss * (1.f / 128.f) + EPS);
                bf16_t* zp = Zs + (size_t)(trp + r) * 4096 + vh * 128 + seg * 16;
#pragma unroll
                for (int i = 0; i < 2; ++i) { const u32x4 zz = i ? zp1 : zp0; const f32x4 h0 = *(const f32x4*)(HN + seg * 16 + 8 * i), h1 = *(const f32x4*)(HN + seg * 16 + 8 * i + 4);
                    f32x4 o0 = v[2 * i] * rn * h0, o1 = v[2 * i + 1] * rn * h1;
                    o0[0] *= __uint_as_float(zz.x << 16); o0[1] *= __uint_as_float(zz.x & 0xffff0000u); o0[2] *= __uint_as_float(zz.y << 16); o0[3] *= __uint_as_float(zz.y & 0xffff0000u);
                    o1[0] *= __uint_as_float(zz.z << 16); o1[1] *= __uint_as_float(zz.z & 0xffff0000u); o1[2] *= __uint_as_float(zz.w << 16); o1[3] *= __uint_as_float(zz.w & 0xffff0000u);
                    if (!dry) *(u32x4*)(zp + 8 * i) = pack8(o0, o1); }
            }
            if (ch + 1 < 32) { const int ptid = tid; GD_LOADRAW(ch + 1); }
#ifdef DRYSKIP_CONV
            if (!dry)
#endif
            {
                const bf16_t* rp = RAW + (16 * part) * 384 + c;
                float x0, x1, x2;
#define GD_CONV(off, w0, w1, w2, w3, STORE) \
                x0 = bf2f(rp[off]); x1 = bf2f(rp[384 + off]); x2 = bf2f(rp[768 + off]); \
                _Pragma("unroll") for (int i = 0; i < 16; ++i) { const float x3 = bf2f(rp[(i + 3) * 384 + off]); const float y = siluf(w0 * x0 + w1 * x1 + w2 * x2 + w3 * x3); const int t = 16 * part + i; STORE; x0 = x1; x1 = x2; x2 = x3; }
                GD_CONV(0, wq0, wq1, wq2, wq3, QQ[t * 136 + c] = f2bf(y))
                GD_CONV(128, wk0, wk1, wk2, wk3, KK[t * 144 + c] = f2bf(y))
                GD_CONV(256, wv0, wv1, wv2, wv3, VN[t * 144 + c] = f2bf(y * bts[t]))
#undef GD_CONV
            }
            __syncthreads();
            f32x4 ak[2], aq[2];
            {
                const int lt_ = fresh_tid(); const int fr = lt_ & 15, fq = (lt_ & 63) >> 4;
                const int tt = w >> 1;
#pragma unroll
                for (int x = 0; x < 2; ++x) { const int st = (w & 1) * 2 + x; f32x4 a1 = (f32x4){0.f, 0.f, 0.f, 0.f}, a2 = (f32x4){0.f, 0.f, 0.f, 0.f};
                    if (st <= tt) {
#pragma unroll
                        for (int ks = 0; ks < 4; ++ks) { const bf16x8 kb = frag_row(KK, 144, 16 * st, 32 * ks, fr, fq);
                            a1 = __builtin_amdgcn_mfma_f32_16x16x32_bf16(frag_row(KK, 144, 16 * tt, 32 * ks, fr, fq), kb, a1, 0, 0, 0);
                            a2 = __builtin_amdgcn_mfma_f32_16x16x32_bf16(frag_row(QQ, 136, 16 * tt, 32 * ks, fr, fq), kb, a2, 0, 0, 0); }
                    }
                    if (st == tt) { f32x4 a3 = (f32x4){0.f, 0.f, 0.f, 0.f};
#pragma unroll
                        for (int ks = 0; ks < 4; ++ks) { const bf16x8 qa = frag_row(QQ, 136, 16 * tt, 32 * ks, fr, fq); a3 = __builtin_amdgcn_mfma_f32_16x16x32_bf16(qa, qa, a3, 0, 0, 0); }
#pragma unroll
                        for (int j = 0; j < 4; ++j) if (4 * fq + j == fr) { nk2[16 * tt + fr] = a1[j]; nq2[16 * tt + fr] = a3[j]; } }
                    ak[x] = a1; aq[x] = a2; }
            }
            __syncthreads();
            {
                const int lt_ = fresh_tid(); const int fr = lt_ & 15, fq = (lt_ & 63) >> 4;
                const int tt = w >> 1;
                if (lt_ < 64) { rks[lt_] = rsqrtf(nk2[lt_] + EPS); rqs[lt_] = rsqrtf(nq2[lt_] + EPS) * 0.08838834764831845f; }
#pragma unroll
                for (int x = 0; x < 2; ++x) { const int st = (w & 1) * 2 + x; f32x4 av, tv;
#pragma unroll
                    for (int j = 0; j < 4; ++j) { const int t = 16 * tt + 4 * fq + j, sx = 16 * st + fr; const float dec = __expf(fminf(gcs[t] - gcs[sx], 0.f));
                        const float rkt = rsqrtf(nk2[t] + EPS), rks_ = rsqrtf(nk2[sx] + EPS), rqt = rsqrtf(nq2[t] + EPS) * 0.08838834764831845f;
                        av[j] = (st <= tt && sx < t) ? bts[t] * ak[x][j] * rkt * rks_ * dec : 0.f;
                        tv[j] = (st <= tt && sx <= t) ? aq[x][j] * rqt * rks_ * dec : 0.f; }
                    if (st == tt) store_ctile_f32(AW, 16, 16 * tt, 0, av, fr, fq);
                    if (st <= tt) store_ctile_bf16(AB, 72, 16 * tt, 16 * st, av, fr, fq);
                    store_ctile_bf16(AT, 72, 16 * tt, 16 * st, tv, fr, fq); }
                if (w == 0 || w == 2 || w == 5 || w == 7) {
                    const int l = lt_ & 63, c = l & 15;
                    float Ar[16], T[16];
#pragma unroll
                    for (int i = 0; i < 16; ++i) { Ar[i] = AW[(16 * tt + i) * 16 + c]; T[i] = (i == c) ? 1.f : 0.f; }
#pragma unroll
                    for (int i = 1; i < 16; ++i)
#pragma unroll
                        for (int j = 0; j < i; ++j) { const float sv = __builtin_bit_cast(float, __builtin_amdgcn_readlane(__builtin_bit_cast(int, Ar[i]), j)); T[i] -= sv * T[j]; }
                    if (l < 32) {
#pragma unroll
                        for (int i = 0; i < 16; ++i) TI[(tt * 16 + i) * 32 + l] = f2bf(((l >> 4) == (tt & 1)) ? T[i] : 0.f);
                    }
                }
            }
            {
                const int lt_ = fresh_tid();
#pragma unroll
                for (int i = 0; i < 16; ++i) { const int e = lt_ + 512 * i, t = e >> 7, k = e & 127; W[t * 136 + k] = f2bf(bf2f(KK[t * 144 + k]) * (bts[t] * egs[t] * rsqrtf(nk2[t] + EPS))); }
                { const int which = lt_ >> 8, r = (lt_ >> 4) & 15, ci = lt_ & 15; if (which == 0) MM[r * 72 + 16 + ci] = (bf16_t)0; else MM[(32 + r) * 72 + 48 + ci] = (bf16_t)0; }
            }
            __syncthreads();
#ifdef DRYSKIP_SOLVE
            if (!dry)
#endif
            {
                const int lt_ = fresh_tid(); const int fr = lt_ & 15, fq = (lt_ & 63) >> 4;
                const bf16_t* rhs = (w < 4) ? VN : W; bf16_t* outp = (w < 4) ? UU : W; const int ostr = (w < 4) ? 144 : 136; const int cb = 32 * (w & 3);
                f32x4 tr[4][2];
#pragma unroll
                for (int r = 0; r < 4; ++r) { const bf16x8 ti = frag_row(TI + r * 512, 32, 0, 0, fr, fq);
#pragma unroll
                    for (int x = 0; x < 2; ++x) tr[r][x] = __builtin_amdgcn_mfma_f32_16x16x32_bf16(ti, frag_tr(rhs, ostr, 32 * (r >> 1), cb + 16 * x, fr, fq), (f32x4){0.f, 0.f, 0.f, 0.f}, 0, 0, 0);
                    const int mr = (w == 0) ? 1 : ((w < 3) ? 2 : 3), mc = (w == 0) ? 0 : ((w < 3) ? w - 1 : w - 3);
                    if (w < 6 && mr == r) { const f32x4 m = __builtin_amdgcn_mfma_f32_16x16x32_bf16(ti, frag_tr(AB, 72, 32 * (r >> 1), 16 * mc, fr, fq), (f32x4){0.f, 0.f, 0.f, 0.f}, 0, 0, 0);
                        store_ctile_bf16(MM, 72, (r - 1) * 16, 16 * mc, -m, fr, fq); } }
                __syncthreads();
#pragma unroll
                for (int x = 0; x < 2; ++x) { const int c0 = cb + 16 * x;
                    store_ctile_bf16(outp, ostr, 0, c0, tr[0][x], fr, fq);
                    f32x4 acc = __builtin_amdgcn_mfma_f32_16x16x32_bf16(frag_row(MM, 72, 0, 0, fr, fq), frag_tr(outp, ostr, 0, c0, fr, fq), tr[1][x], 0, 0, 0);
                    store_ctile_bf16(outp, ostr, 16, c0, acc, fr, fq);
                    acc = __builtin_amdgcn_mfma_f32_16x16x32_bf16(frag_row(MM + 16 * 72, 72, 0, 0, fr, fq), frag_tr(outp, ostr, 0, c0, fr, fq), tr[2][x], 0, 0, 0);
                    store_ctile_bf16(outp, ostr, 32, c0, acc, fr, fq);
                    acc = __builtin_amdgcn_mfma_f32_16x16x32_bf16(frag_row(MM + 32 * 72, 72, 0, 0, fr, fq), frag_tr(outp, ostr, 0, c0, fr, fq), tr[3][x], 0, 0, 0);
                    acc = __builtin_amdgcn_mfma_f32_16x16x32_bf16(frag_row(MM + 32 * 72, 72, 0, 32, fr, fq), frag_tr(outp, ostr, 32, c0, fr, fq), acc, 0, 0, 0);
                    store_ctile_bf16(outp, ostr, 48, c0, acc, fr, fq); }
            }
            __syncthreads();
            const float gcl = gcs[63];
#ifdef DRYSKIP_D
            if (!dry)
#endif
            {
                const int lt_ = fresh_tid(); const int fr = lt_ & 15, fq = (lt_ & 63) >> 4;
                const int tt = w >> 1;
#pragma unroll
                for (int x = 0; x < 4; ++x) { const int vt = (w & 1) * 4 + x; f32x4 acc = (f32x4){0.f, 0.f, 0.f, 0.f};
#pragma unroll
                    for (int ks = 0; ks < 4; ++ks) acc = __builtin_amdgcn_mfma_f32_16x16x32_bf16(frag_row(W, 136, 16 * tt, 32 * ks, fr, fq), frag_tr(SB, 144, 32 * ks, 16 * vt, fr, fq), acc, 0, 0, 0);
                    f32x4 vnv, vsv;
#pragma unroll
                    for (int j = 0; j < 4; ++j) { const int t = 16 * tt + 4 * fq + j, vx = 16 * vt + fr; const float vn = bf2f(UU[t * 144 + vx]) - acc[j]; vnv[j] = vn; vsv[j] = vn * __expf(gcl - gcs[t]) * rks[t]; }
                    store_ctile_bf16(VN, 144, 16 * tt, 16 * vt, vnv, fr, fq); store_ctile_bf16(UU, 144, 16 * tt, 16 * vt, vsv, fr, fq); asm volatile("" ::: "memory"); }
            }
            __syncthreads();
            f32x4 oacc[4];
            {
                const int lt_ = fresh_tid(); const int fr = lt_ & 15, fq = (lt_ & 63) >> 4;
                const int tt = w >> 1;
#pragma unroll
                for (int x = 0; x < 4; ++x) { const int vt = (w & 1) * 4 + x; f32x4 acc = (f32x4){0.f, 0.f, 0.f, 0.f};
#pragma unroll
                    for (int ks = 0; ks < 4; ++ks) acc = __builtin_amdgcn_mfma_f32_16x16x32_bf16(frag_row(QQ, 136, 16 * tt, 32 * ks, fr, fq), frag_tr(SB, 144, 32 * ks, 16 * vt, fr, fq), acc, 0, 0, 0);
#pragma unroll
                    for (int j = 0; j < 4; ++j) acc[j] *= egs[16 * tt + 4 * fq + j] * rqs[16 * tt + 4 * fq + j];
#pragma unroll
                    for (int ks = 0; ks < 2; ++ks) acc = __builtin_amdgcn_mfma_f32_16x16x32_bf16(frag_row(AT, 72, 16 * tt, 32 * ks, fr, fq), frag_tr(VN, 144, 32 * ks, 16 * vt, fr, fq), acc, 0, 0, 0);
                    oacc[x] = acc; asm volatile("" ::: "memory"); }
                const float egl = __expf(gcl);
                const bf16x8 ka0 = frag_tr(KK, 144, 0, 16 * w, fr, fq), ka1 = frag_tr(KK, 144, 32, 16 * w, fr, fq);
#pragma unroll
                for (int vt = 0; vt < 8; ++vt) { f32x4 a2 = (f32x4){0.f, 0.f, 0.f, 0.f};
                    a2 = __builtin_amdgcn_mfma_f32_16x16x32_bf16(ka0, frag_tr(UU, 144, 0, 16 * vt, fr, fq), a2, 0, 0, 0);
                    a2 = __builtin_amdgcn_mfma_f32_16x16x32_bf16(ka1, frag_tr(UU, 144, 32, 16 * vt, fr, fq), a2, 0, 0, 0);
                    S[vt] = S[vt] * egl + a2; asm volatile("" ::: "memory"); }
            }
            {
                const int lt_ = fresh_tid(); const int fr = lt_ & 15, fq = (lt_ & 63) >> 4;
                const int tt = w >> 1;
#pragma unroll
                for (int x = 0; x < 4; ++x) { const int vt = (w & 1) * 4 + x; store_ctile_bf16(OT, 136, 16 * tt, 16 * vt, oacc[x], fr, fq); }
            }
            zp0 = zz0; zp1 = zz1; trp = trow0;
            __syncthreads();
        }
        __syncthreads();
        {
                const int lt2_ = fresh_tid(); const int r = lt2_ >> 3, seg = lt2_ & 7; const bf16_t* op = OT + r * 136 + seg * 16;
                f32x4 v[4]; float ss = 0.f;
                { const u32x4 q0 = *(const u32x4*)op, q1 = *(const u32x4*)(op + 8);
                  v[0] = (f32x4){__uint_as_float(q0.x << 16), __uint_as_float(q0.x & 0xffff0000u), __uint_as_float(q0.y << 16), __uint_as_float(q0.y & 0xffff0000u)};
                  v[1] = (f32x4){__uint_as_float(q0.z << 16), __uint_as_float(q0.z & 0xffff0000u), __uint_as_float(q0.w << 16), __uint_as_float(q0.w & 0xffff0000u)};
                  v[2] = (f32x4){__uint_as_float(q1.x << 16), __uint_as_float(q1.x & 0xffff0000u), __uint_as_float(q1.y << 16), __uint_as_float(q1.y & 0xffff0000u)};
                  v[3] = (f32x4){__uint_as_float(q1.z << 16), __uint_as_float(q1.z & 0xffff0000u), __uint_as_float(q1.w << 16), __uint_as_float(q1.w & 0xffff0000u)}; }
#pragma unroll
                for (int i = 0; i < 4; ++i) ss += v[i][0] * v[i][0] + v[i][1] * v[i][1] + v[i][2] * v[i][2] + v[i][3] * v[i][3];
                ss += __shfl_xor(ss, 1); ss += __shfl_xor(ss, 2); ss += __shfl_xor(ss, 4);
                const float rn = rsqrtf(ss * (1.f / 128.f) + EPS);
                bf16_t* zp = Zs + (size_t)(trp + r) * 4096 + vh * 128 + seg * 16;
#pragma unroll
                for (int i = 0; i < 2; ++i) { const u32x4 zz = i ? zp1 : zp0; const f32x4 h0 = *(const f32x4*)(HN + seg * 16 + 8 * i), h1 = *(const f32x4*)(HN + seg * 16 + 8 * i + 4);
                    f32x4 o0 = v[2 * i] * rn * h0, o1 = v[2 * i + 1] * rn * h1;
                    o0[0] *= __uint_as_float(zz.x << 16); o0[1] *= __uint_as_float(zz.x & 0xffff0000u); o0[2] *= __uint_as_float(zz.y << 16); o0[3] *= __uint_as_float(zz.y & 0xffff0000u);
                    o1[0] *= __uint_as_float(zz.z << 16); o1[1] *= __uint_as_float(zz.z & 0xffff0000u); o1[2] *= __uint_as_float(zz.w << 16); o1[3] *= __uint_as_float(zz.w & 0xffff0000u);
                    if (!dry) *(u32x4*)(zp + 8 * i) = pack8(o0, o1); }
            }
        __syncthreads();
#undef GD_LOADRAW
    }
}

__device__ __forceinline__ float quad16_max(float x) {
    const auto r = __builtin_amdgcn_permlane32_swap(__float_as_uint(x), __float_as_uint(x), false, false);
    const float m = fmaxf(__uint_as_float(r[0]), __uint_as_float(r[1]));
    const auto q = __builtin_amdgcn_permlane16_swap(__float_as_uint(m), __float_as_uint(m), false, false);
    return fmaxf(__uint_as_float(q[0]), __uint_as_float(q[1]));
}
__device__ __forceinline__ float quad16_sum(float x) {
    const auto r = __builtin_amdgcn_permlane32_swap(__float_as_uint(x), __float_as_uint(x), false, false);
    const float m = __uint_as_float(r[0]) + __uint_as_float(r[1]);
    const auto q = __builtin_amdgcn_permlane16_swap(__float_as_uint(m), __float_as_uint(m), false, false);
    return __uint_as_float(q[0]) + __uint_as_float(q[1]);
}
constexpr int KS_STRIDE = 200, VS_STRIDE = 144;
__device__ __forceinline__ void attn_tile(bf16_t* Ks, bf16_t* Vs, unsigned char* ws, int b, int h, int qt, bool dry) {
    const int tid = fresh_tid(), lane = tid & 63, wv = __builtin_amdgcn_readfirstlane(tid >> 6), fr = lane & 15, fq = lane >> 4;
    const bf16_t* Q = (const bf16_t*)(ws + WS_BIG); const bf16_t* KV = (const bf16_t*)(ws + WS_BIG + 96 * MiB); const bf16_t* KR = (const bf16_t*)(ws + WS_Z + 96 * MiB);
    bf16_t* Zs = (bf16_t*)(ws + WS_Z);
    const int rowA = b * SEQ + qt * 256 + wv * 16 + fr, rowB = rowA + 128;
    bf16x8 qfA[6], qfB[6];
#pragma unroll
    for (int s = 0; s < 6; ++s) { qfA[s] = *(const bf16x8*)(Q + (size_t)rowA * 3072 + h * 192 + 32 * s + 8 * fq); qfB[s] = *(const bf16x8*)(Q + (size_t)rowB * 3072 + h * 192 + 32 * s + 8 * fq); }
    f32x4 accA[8], accB[8];
#pragma unroll
    for (int i = 0; i < 8; ++i) { accA[i] = (f32x4){0.f, 0.f, 0.f, 0.f}; accB[i] = (f32x4){0.f, 0.f, 0.f, 0.f}; }
    float mA = -INFINITY, lA = 0.f, mB = -INFINITY, lB = 0.f;
    const int ntiles = 4 * qt + 4, cA = 4 * qt + (wv >> 2), cB = cA + 2;
    u32x4 pk0, pk1, pv0, pv1, pr0;
    const int lr0 = tid >> 4, lc0 = tid & 15, lr1 = (tid + 512) >> 4, lrr = tid >> 3, lcr = tid & 7;
    {
        const size_t krow0 = (size_t)(b * SEQ);
        pk0 = *(const u32x4*)(KV + (krow0 + lr0) * 4096 + h * 256 + lc0 * 8); pv0 = *(const u32x4*)(KV + (krow0 + lr0) * 4096 + h * 256 + 128 + lc0 * 8);
        pk1 = *(const u32x4*)(KV + (krow0 + lr1) * 4096 + h * 256 + lc0 * 8); pv1 = *(const u32x4*)(KV + (krow0 + lr1) * 4096 + h * 256 + 128 + lc0 * 8);
        pr0 = *(const u32x4*)(KR + (krow0 + lrr) * 64 + lcr * 8);
    }
    for (int kt = 0; kt < ntiles; ++kt) {
        __syncthreads();
        *(u32x4*)(Ks + lr0 * KS_STRIDE + lc0 * 8) = pk0; *(u32x4*)(Vs + lr0 * VS_STRIDE + lc0 * 8) = pv0;
        *(u32x4*)(Ks + lr1 * KS_STRIDE + lc0 * 8) = pk1; *(u32x4*)(Vs + lr1 * VS_STRIDE + lc0 * 8) = pv1;
        *(u32x4*)(Ks + lrr * KS_STRIDE + 128 + lcr * 8) = pr0;
        if (kt + 1 < ntiles) {
            const size_t krow0 = (size_t)(b * SEQ + (kt + 1) * 64);
            pk0 = *(const u32x4*)(KV + (krow0 + lr0) * 4096 + h * 256 + lc0 * 8); pv0 = *(const u32x4*)(KV + (krow0 + lr0) * 4096 + h * 256 + 128 + lc0 * 8);
            pk1 = *(const u32x4*)(KV + (krow0 + lr1) * 4096 + h * 256 + lc0 * 8); pv1 = *(const u32x4*)(KV + (krow0 + lr1) * 4096 + h * 256 + 128 + lc0 * 8);
            pr0 = *(const u32x4*)(KR + (krow0 + lrr) * 64 + lcr * 8);
        }
        __syncthreads();
        if (kt <= cB) {
            const bool doA = (kt <= cA);
            f32x4 sA[4], sB[4];
#pragma unroll
            for (int nt = 0; nt < 4; ++nt) { sA[nt] = (f32x4){0.f, 0.f, 0.f, 0.f}; sB[nt] = (f32x4){0.f, 0.f, 0.f, 0.f};
#pragma unroll
                for (int st = 0; st < 6; ++st) { const bf16x8 kf = *(const bf16x8*)(Ks + (16 * nt + fr) * KS_STRIDE + 32 * st + 8 * fq);
                    sB[nt] = __builtin_amdgcn_mfma_f32_16x16x32_bf16(kf, qfB[st], sB[nt], 0, 0, 0);
                    if (doA) sA[nt] = __builtin_amdgcn_mfma_f32_16x16x32_bf16(kf, qfA[st], sA[nt], 0, 0, 0); } }
            bf16x8 pfA[2], pfB[2];
#define ATT_SOFTMAX(s, mrun, lsum, acc, pf) do { float mx = s[0][0]; \
            _Pragma("unroll") for (int nt = 0; nt < 4; ++nt) _Pragma("unroll") for (int j = 0; j < 4; ++j) mx = fmaxf(mx, s[nt][j]); \
            mx = quad16_max(mx); \
            if (__builtin_amdgcn_ballot_w64(mx > mrun + 8.f) != 0ull) {     \
                const float mnew = fmaxf(mrun, mx), alpha = __builtin_amdgcn_exp2f(mrun - mnew); mrun = mnew; lsum *= alpha; \
                _Pragma("unroll") for (int i = 0; i < 8; ++i) acc[i] *= alpha; } \
            float ps = 0.f; \
            _Pragma("unroll") for (int nt = 0; nt < 4; ++nt) _Pragma("unroll") for (int j = 0; j < 4; ++j) { s[nt][j] = __builtin_amdgcn_exp2f(s[nt][j] - mrun); ps += s[nt][j]; } \
            lsum += ps; \
            _Pragma("unroll") for (int s2 = 0; s2 < 2; ++s2) { const u32x4 w_ = pack8(s[2 * s2], s[2 * s2 + 1]); pf[s2] = __builtin_bit_cast(bf16x8, w_); } } while (0)
            ATT_SOFTMAX(sB, mB, lB, accB, pfB);
            if (doA) ATT_SOFTMAX(sA, mA, lA, accA, pfA);
#undef ATT_SOFTMAX
            const int tq = fr >> 2, tp = fr & 3;
#pragma unroll
            for (int vt = 0; vt < 8; ++vt)
#pragma unroll
                for (int s2 = 0; s2 < 2; ++s2) { const bf16_t* vp = Vs + (32 * s2 + 4 * fq + tq) * VS_STRIDE + 16 * vt + 4 * tp;
                    const s16x4 r0 = tr_read(vp), r1 = tr_read(vp + 16 * VS_STRIDE);
                    const bf16x8 vf = (bf16x8){r0[0], r0[1], r0[2], r0[3], r1[0], r1[1], r1[2], r1[3]};
                    accB[vt] = __builtin_amdgcn_mfma_f32_16x16x32_bf16(vf, pfB[s2], accB[vt], 0, 0, 0);
                    if (doA) accA[vt] = __builtin_amdgcn_mfma_f32_16x16x32_bf16(vf, pfA[s2], accA[vt], 0, 0, 0); }
        }
    }
#define ATT_FINAL(acc, lsum, row) do { const float l_ = quad16_sum(lsum); const float inv = __builtin_amdgcn_rcpf(l_); \
    _Pragma("unroll") for (int vt = 0; vt < 8; ++vt) { bf16_t* zp = Zs + (size_t)(row) * 2048 + h * 128 + 16 * vt + 4 * fq; const u32x2 zz = *(const u32x2*)zp; \
        const float z0 = __uint_as_float(zz.x << 16), z1 = __uint_as_float(zz.x & 0xffff0000u), z2 = __uint_as_float(zz.y << 16), z3 = __uint_as_float(zz.y & 0xffff0000u); \
        u32x2 w_; w_.x = pg8::cvt_pk_bf16(acc[vt][0] * inv * z0, acc[vt][1] * inv * z1); w_.y = pg8::cvt_pk_bf16(acc[vt][2] * inv * z2, acc[vt][3] * inv * z3); if (!dry) *(u32x2*)zp = w_; } } while (0)
    ATT_FINAL(accA, lA, rowA);
    ATT_FINAL(accB, lB, rowB);
#undef ATT_FINAL
}
__device__ __forceinline__ void attn_phase(unsigned char* lds, unsigned char* ws, bool dry) {
    bf16_t* Ks = (bf16_t*)lds; bf16_t* Vs = (bf16_t*)(lds + 64 * KS_STRIDE * 2);
    for (int p_ = blockIdx.x; p_ < 512; p_ += gridDim.x) { const int p = (gridDim.x == 256) ? ((p_ & 7) * 64 + (p_ >> 3)) : p_;
        const int bh = p >> 2, pr = p & 3;
        attn_tile(Ks, Vs, ws, bh >> 4, bh & 15, 7 - pr, dry);
        attn_tile(Ks, Vs, ws, bh >> 4, bh & 15, pr, dry); }
}

__device__ __forceinline__ void prep_tables(const Params& P) {
    unsigned char* ws = P.ws; const int gt = blockIdx.x * 512 + fresh_tid(), ng = gridDim.x * 512;
    const int* pos = (const int*)P.in[1]; float* COS = (float*)(ws + WS_COS); float* SIN = (float*)(ws + WS_SIN);
    for (int i = gt; i < MTOK * 32; i += ng) { const int row = i >> 5, j = i & 31;
        const float invf = __builtin_amdgcn_exp2f(-(float)j * (13.287712379549449f / 32.f));
        const float ang = (float)pos[row] * invf;
        double t = (double)ang * 0.15915494309189535; t -= floor(t); const float tf = (float)t;
        COS[i] = __builtin_amdgcn_cosf(tf); SIN[i] = __builtin_amdgcn_sinf(tf); }
    const float* lbp = (const float*)P.in[2]; float* LB = (float*)(ws + WS_LB);
    for (int c = gt; c < 2048; c += ng) { const float a0 = lbp[c], a1 = lbp[2048 + c], a2 = lbp[4096 + c], a3 = lbp[6144 + c];
        const float mx = fmaxf(fmaxf(a0, a1), fmaxf(a2, a3)); const float e0 = expf(a0 - mx), e1 = expf(a1 - mx), e2 = expf(a2 - mx), e3 = expf(a3 - mx); const float sm = e0 + e1 + e2 + e3;
        LB[c] = 0.f; LB[2048 + c] = (e1 + e2 + e3) / sm; }
}

#define XB_TMO      128
#define XB_XCNT(j)  (256  + 64 * (j))
#define XB_XSUB(j)  (1280 + 64 * (j))
#define XB_XGEN(j)  (2304 + 64 * (j))
#define XB_TOP      3328
#define XB_TOPGEN   3392
#define XCD_BAR_WORDS 3456
#define XB_SPIN_CAP (1u << 18)
__device__ __forceinline__ unsigned xb_ld(unsigned* p)              { return __hip_atomic_load(p, __ATOMIC_RELAXED, __HIP_MEMORY_SCOPE_AGENT); }
__device__ __forceinline__ unsigned xb_add(unsigned* p, unsigned v) { return __hip_atomic_fetch_add(p, v, __ATOMIC_RELAXED, __HIP_MEMORY_SCOPE_AGENT); }
__device__ __forceinline__ unsigned xb_xcc_id() { return (unsigned)__builtin_amdgcn_s_getreg((3 << 11) | 20) & 0xFu; }
#define XB_SPIN(cond, bar) do { unsigned _sp = 0; while (cond) { __builtin_amdgcn_s_sleep(1); \
    if ((++_sp & 255u) == 0u) { if (xb_ld(&(bar)[XB_TMO])) break; if (_sp > XB_SPIN_CAP) { atomicAdd(&(bar)[XB_TMO], 1u); break; } } } } while (0)

struct XcdBarrier {
    unsigned* bar; unsigned x;
    volatile LAS unsigned* st;
};

__device__ __forceinline__ XcdBarrier xcd_barrier_post(unsigned* bar, volatile LAS unsigned* st) {
    XcdBarrier b; b.bar = bar; b.x = xb_xcc_id(); b.st = st;
    if (threadIdx.x == 0) (void)xb_add(&bar[XB_XCNT(b.x)], 1u);
    return b;
}
__device__ __forceinline__ void xcd_barrier_complete(unsigned* bar, unsigned x, unsigned& nloc, unsigned& nx) {
    const unsigned G = gridDim.x * gridDim.y * gridDim.z;
    unsigned sum, cnt, mine, sp = 0u;
    for (;;) {
        sum = 0u; cnt = 0u; mine = 0u;
#pragma unroll
        for (unsigned j = 0; j < 16; ++j) { const unsigned c = xb_ld(&bar[XB_XCNT(j)]); sum += c; cnt += (c > 0u) ? 1u : 0u; mine = (j == x) ? c : mine; }
        if (sum == G) break;
        __builtin_amdgcn_s_sleep(1);
        if ((++sp & 255u) == 0u) { if (xb_ld(&bar[XB_TMO])) break; if (sp > XB_SPIN_CAP) { atomicAdd(&bar[XB_TMO], 1u); break; } }
    }
    nloc = mine > 0u ? mine : 1u; nx = cnt > 0u ? cnt : 1u;
}

__device__ __forceinline__ void xcd_barrier(const XcdBarrier& b) {
    asm volatile("s_waitcnt vmcnt(0)" ::: "memory");
    __syncthreads();
    if (threadIdx.x == 0) {
        unsigned* bar = b.bar;
        __builtin_amdgcn_s_waitcnt(0);
        unsigned nloc = b.st[0], nx = b.st[1];
        if (nloc == 0u) { xcd_barrier_complete(bar, b.x, nloc, nx); b.st[0] = nloc; b.st[1] = nx; }
        const unsigned old = xb_add(&bar[XB_XSUB(b.x)], 1u);
        const unsigned gen = old / nloc;
        if (old + 1u == (gen + 1u) * nloc) {
            __builtin_amdgcn_fence(__ATOMIC_RELEASE, "agent");
            asm volatile("s_waitcnt vmcnt(0)" ::: "memory");
            const unsigned og = xb_add(&bar[XB_TOP], 1u);
            const unsigned tg = og / nx;
            if (og + 1u == (tg + 1u) * nx) xb_add(&bar[XB_TOPGEN], 1u);
            else XB_SPIN(xb_ld(&bar[XB_TOPGEN]) == tg, bar);
            __builtin_amdgcn_fence(__ATOMIC_ACQUIRE, "agent");
            xb_add(&bar[XB_XGEN(b.x)], 1u);
            asm volatile("s_waitcnt vmcnt(0)" ::: "memory");
        } else {
            XB_SPIN(xb_ld(&bar[XB_XGEN(b.x)]) == gen, bar);
            __builtin_amdgcn_fence(__ATOMIC_ACQUIRE, "agent");
            asm volatile("s_waitcnt vmcnt(0)" ::: "memory");
        }
    }
    __syncthreads();
}


struct CvM { const float* W; int K, Ns, Nd, mode; bf16_t* dst; const float* rs; float cs; };
__device__ __forceinline__ bool cv_get(const Params& P, int cv, int sub, CvM& m) {
#define FIN(i) ((const float*)P.in[i])
    bf16_t* RW = (bf16_t*)(P.ws + WS_RW); bf16_t* U = (bf16_t*)(P.ws + WS_U);
    m.rs = nullptr; m.cs = 1.f; m.mode = MAP_ID;
    if (sub > 0 && cv != 2) return false;
    switch (cv) {
        case 0: m.W = FIN(5);  m.K = 2048; m.Ns = 8192;  m.Nd = 8192;  m.dst = RW; return true;
        case 1: m.W = FIN(7);  m.K = 2048; m.Ns = 2048;  m.Nd = 2048;  m.dst = U;  return true;
        case 2:
            if (sub == 0) { m.W = FIN(10); m.K = 2048; m.Ns = 3136; m.Nd = 3328; m.mode = MAP_MLAIN; m.dst = RW; return true; }
            if (sub == 1) { m.W = FIN(13); m.K = 512; m.Ns = 3072; m.Nd = 3072; m.mode = MAP_UQ; m.dst = RW + (size_t)3328 * 2048; m.rs = FIN(11); m.cs = 0.10411754627697266f;     return true; }
            if (sub == 2) { m.W = FIN(14); m.K = 512; m.Ns = 4096; m.Nd = 4096; m.dst = RW + (size_t)3328 * 2048 + (size_t)3072 * 512; m.rs = FIN(12); return true; }
            return false;
        case 3: m.W = FIN(15); m.K = 2048; m.Ns = 2048;  m.Nd = 2048;  m.dst = U;  return true;
        case 4: m.W = FIN(18); m.K = 2048; m.Ns = 12352; m.Nd = 12544; m.dst = RW; return true;
        case 5: m.W = FIN(23); m.K = 4096; m.Ns = 2048;  m.Nd = 2048;  m.dst = U;  return true;
        case 6: m.W = FIN(26); m.K = 2048; m.Ns = 8192;  m.Nd = 8192;  m.dst = RW; return true;
        case 7: m.W = FIN(28); m.K = 2048; m.Ns = 2048;  m.Nd = 2048;  m.dst = U;  return true;
        default: return false;
    }
}

__global__ void __launch_bounds__(512) trunk_fwd(Params P) {
    extern __shared__ __attribute__((aligned(16))) unsigned char lds[];
    cg::grid_group grid = cg::this_grid();
    unsigned char* ws = P.ws; LAS unsigned char* L3 = (LAS unsigned char*)lds; float* Lf = (float*)lds;
    const int bi = blockIdx.x, nb = gridDim.x;
    bf16_t* RW = (bf16_t*)(ws + WS_RW); bf16_t* U = (bf16_t*)(ws + WS_U);
    const bf16_t* Z0 = (const bf16_t*)(ws + WS_Z); const bf16_t* Z64 = (const bf16_t*)(ws + WS_Z + 64 * MiB); const bf16_t* Z80 = (const bf16_t*)(ws + WS_Z + 80 * MiB);
    const bf16_t* YB = (const bf16_t*)(ws + WS_BIG); const float* LB = (const float*)(ws + WS_LB);
#ifdef PROBE_TA
    unsigned long long* stamps = (unsigned long long*)(lds + LDS_BYTES - 256);
    if (threadIdx.x == 0) stamps[0] = __builtin_amdgcn_s_memrealtime();
#endif
    { if (threadIdx.x < 4) ((LAS unsigned*)(lds + 163072))[threadIdx.x] = 0u; __syncthreads(); }
    XcdBarrier xbar = xcd_barrier_post((unsigned*)(ws + WS_BAR), (volatile LAS unsigned*)(lds + 163072));
    for (int st = P.ph_lo; st < P.ph_hi; ++st) {
        int cv = -1, cvb = -1, rowk = 0, gm = -1, gN = 0, gK = 0, mix = 0; bool sync_after = true, tables = false;
        const bf16_t* r_y = nullptr; const float *r_h = nullptr, *r_post = nullptr, *r_pre = nullptr, *hn = nullptr, *lbp = LB;
        const bf16_t *gA = nullptr, *gB = nullptr;
        switch (st) {
            case 0:  tables = true; rowk = 1; r_h = FIN(0); r_pre = FIN(3); cv = 0; break;
            case 1:  gm = EM_HG; gA = U; gB = RW; gN = 8192; gK = 2048; lbp = LB; break;
            case 2:  cv = 1; cvb = 2; mix = 1; hn = FIN(6); break;
            case 3:  gm = EM_OUT; gA = Z64; gB = U; gN = 2048; gK = 2048; break;
            case 4:  rowk = 1; r_h = FIN(0); r_y = YB; r_post = FIN(4); r_pre = FIN(8); break;
            case 5:  gm = EM_MLAIN; gA = U; gB = RW; gN = 3328; gK = 2048; break;
            case 6:  gm = EM_Q; gA = Z64; gB = RW + (size_t)3328 * 2048; gN = 3072; gK = 512; sync_after = false; break;
            case 7:  gm = EM_KV; gA = Z80; gB = RW + (size_t)3328 * 2048 + (size_t)3072 * 512; gN = 4096; gK = 512; break;
            case 8:  cv = 3; mix = 2; break;
            case 9:  gm = EM_OUT; gA = Z0; gB = U; gN = 2048; gK = 2048; break;
            case 10: rowk = 1; r_h = P.out; r_y = YB; r_post = FIN(9); r_pre = FIN(16); cv = 4; break;
            case 11: gm = EM_GDN; gA = U; gB = RW; gN = 12544; gK = 2048; break;
            case 12: cv = 5; mix = 3; hn = FIN(22); break;
            case 13: gm = EM_OUT; gA = Z0; gB = U; gN = 2048; gK = 4096; break;
            case 14: rowk = 1; r_h = P.out; r_y = YB; r_post = FIN(17); r_pre = FIN(24); cv = 6; break;
            case 15: gm = EM_HG; gA = U; gB = RW; gN = 8192; gK = 2048; lbp = LB + 2048; break;
            case 16: cv = 7; mix = 1; hn = FIN(27); break;
            case 17: gm = EM_OUT; gA = Z64; gB = U; gN = 2048; gK = 2048; break;
            default: rowk = 1; r_h = P.out; r_y = YB; r_post = FIN(25); r_pre = nullptr; break;
        }
        if (tables) prep_tables(P);
        if (rowk) row_phase(r_h, r_y, r_post, r_pre, P.out, U);
        {
            const int cbi = (mix == 1) ? bi - 128 : bi, cnb = (mix == 1) ? nb - 128 : nb;
            if (cbi >= 0 && cnb > 0) {
                for (int pass = 0; pass < 2; ++pass) { const int cvx = pass ? cvb : cv; if (cvx < 0) continue;
                    for (int sub = 0; sub < 3; ++sub) { CvM m; if (!cv_get(P, cvx, sub, m)) break; convert_w(Lf, m.W, m.K, m.Ns, m.dst, m.Nd, m.mode, m.rs, m.cs, cbi, cnb);
#ifdef CONV_REPS
                        for (int r_ = 0; r_ < CONV_REPS; ++r_) convert_w(Lf, m.W, m.K, m.Ns, m.dst, m.Nd, m.mode, m.rs, m.cs, cbi, cnb);
#endif
                    } }
            }
        }
#ifndef GEMM_REPS
#define GEMM_REPS 1
#endif
#ifndef DRY_MIX
#define DRY_MIX 0
#endif
        if (gm >= 0) { Epi E; E.mode = gm; E.ws = ws; E.lb = lbp; E.alog = FIN(20); E.dtb = FIN(21);
            for (int rep = 0; rep < GEMM_REPS; ++rep) {
#ifdef GEMM_DRY_FIRST
                E.mode = (rep == 0) ? -1 : gm;
#endif
                run_gemm(L3, gA, gB, gN, gK, E); if (rep + 1 < GEMM_REPS) grid.sync(); } }
        if (mix) {
            for (int rep = (DRY_MIX == mix ? 0 : 1); rep < 2; ++rep) { const bool dry = (rep == 0);
                if (mix == 1) gla_chunked(lds, ws, hn, dry);
                if (mix == 2) attn_phase(lds, ws, dry);
                if (mix == 3) gdn_chunked(lds, ws, FIN(19), hn, dry);
                if (dry) grid.sync(); }
        }
        if (sync_after && st + 1 < P.ph_hi) { if (st == 0) grid.sync(); else xcd_barrier(xbar); }
#ifdef EXTRA_SYNCS
        for (int e_ = 0; e_ < EXTRA_SYNCS; ++e_) xcd_barrier(xbar);
#endif
#ifdef PROBE_TA
        if (threadIdx.x == 0) stamps[st + 1] = __builtin_amdgcn_s_memrealtime();
#endif
    }
#ifdef PROBE_TA
    grid.sync();
    { const size_t n = (size_t)MTOK * DM; for (size_t i = (size_t)blockIdx.x * 512 + threadIdx.x; i < n; i += (size_t)gridDim.x * 512) P.out[i] = 0.f; }
    grid.sync();
    if (blockIdx.x == 0) { const float ta = (float)(stamps[PROBE_TA + 1] - stamps[0]) * 0.01f, tb = (float)(stamps[PROBE_TB + 1] - stamps[0]) * 0.01f;
        if (threadIdx.x == 0) P.out[0] = ta;
        for (int i = threadIdx.x; i < 1000000; i += 512) P.out[1024 + i] = tb; }
#endif
#undef FIN
}

extern "C" void kernel_launch(void* const* d_in, const int* in_sizes, int n_in, void* d_out, int out_size, void* d_ws, size_t ws_size, hipStream_t stream) {
    static int grid_blocks = 0;
    if (grid_blocks == 0) {
        if (n_in != 29 || ws_size < WS_END) { fprintf(stderr, "kernel_launch: need 29 inputs and %zu bytes of workspace; got %d, %zu\n", (size_t)WS_END, n_in, ws_size); grid_blocks = -1; return; }
        int dev = 0, cus = 0, per_cu = 0;
        hipGetDevice(&dev); hipDeviceGetAttribute(&cus, hipDeviceAttributeMultiprocessorCount, dev);
        if (hipFuncSetAttribute((const void*)trunk_fwd, hipFuncAttributeMaxDynamicSharedMemorySize, LDS_BYTES) != hipSuccess) { fprintf(stderr, "hipFuncSetAttribute failed\n"); grid_blocks = -1; return; }
        if (hipOccupancyMaxActiveBlocksPerMultiprocessor(&per_cu, (const void*)trunk_fwd, 512, LDS_BYTES) != hipSuccess || per_cu < 1) { fprintf(stderr, "occupancy query failed (%d)\n", per_cu); per_cu = 1; }
        (void)hipGetLastError();
        grid_blocks = cus * 1;
    }
    if (grid_blocks < 0) return;
    Params p{};
    for (int i = 0; i < 29; ++i) p.in[i] = d_in[i];
    p.out = (float*)d_out; p.ws = (unsigned char*)d_ws;
#if PER_PHASE_LAUNCH
    for (int ph = 0; ph < NPHASE; ++ph) {
        p.ph_lo = ph; p.ph_hi = ph + 1; void* args[] = {&p};
        hipError_t e = hipLaunchCooperativeKernel((const void*)trunk_fwd, dim3(grid_blocks), dim3(512), args, LDS_BYTES, stream);
        if (e != hipSuccess) { fprintf(stderr, "launch failed: %s\n", hipGetErrorString(e)); break; }
    }
#else
    (void)hipMemsetAsync((unsigned char*)d_ws + WS_BAR, 0, XCD_BAR_WORDS * 4, stream);
    p.ph_lo = 0; p.ph_hi = NPHASE; void* args[] = {&p};
    hipError_t e = hipLaunchCooperativeKernel((const void*)trunk_fwd, dim3(grid_blocks), dim3(512), args, LDS_BYTES, stream);
    if (e != hipSuccess) fprintf(stderr, "cooperative launch failed: %s (grid %d)\n", hipGetErrorString(e), grid_blocks);
#endif
}
```
